# Optimizing an MI355X kernel written in HIP

```python
import jax, jax.numpy as jnp
from jax import lax
import numpy as np

D_MODEL = 1024
BATCH = 2
SEQ = 8192
DEPTH = 2

HEAD_DIM = 64
RET_H = (3 * D_MODEL // 8) // HEAD_DIM
RET_W = RET_H * HEAD_DIM
RET_CHUNK = 128
ROPE_BASE = 10000.0
RWKV_H = (3 * D_MODEL // 8) // HEAD_DIM
RWKV_W = RWKV_H * HEAD_DIM
RWKV_W_LORA = 64
RWKV_A_LORA = 64
RWKV_G_LORA = 128
RWKV_GN_EPS = 64e-5
LRU_H = (D_MODEL // 4) // HEAD_DIM
LRU_W = LRU_H * HEAD_DIM
LRU_CONV = 4
LRU_C = 8.0
MIX_W = RET_W + RWKV_W + LRU_W
RET_SLAB = 4 * RET_W
RWKV_SLAB = 3 * RWKV_W + RWKV_W_LORA + RWKV_A_LORA + RWKV_G_LORA
LRU_SLAB = 2 * LRU_W
IN_W = RET_SLAB + RWKV_SLAB + LRU_SLAB
N_GROUPS = 4
EXPERTS_PER_GROUP = 8
N_EXPERTS = N_GROUPS * EXPERTS_PER_GROUP
TOPK_IN_GROUP = 2
D_EXPERT = D_MODEL // 2
MOE_BLOCK = 256
LN_EPS = 1e-5

kernel_name = "hybrid_ret_rwkv7_rglru_hmoe_deepnorm"


def layer_norm(x, g, b):
    xf = x.astype(jnp.float32)
    mu = jnp.mean(xf, -1, keepdims=True)
    var = jnp.mean(jnp.square(xf - mu), -1, keepdims=True)
    return ((xf - mu) * lax.rsqrt(var + LN_EPS) * g + b).astype(x.dtype)


def head_norm(y, eps):
    mu = jnp.mean(y, -1, keepdims=True)
    var = jnp.mean(jnp.square(y - mu), -1, keepdims=True)
    return (y - mu) * lax.rsqrt(var + eps)


def rotary(t):
    S, Dh = t.shape[1], t.shape[-1]
    inv = 1.0 / (ROPE_BASE ** (jnp.arange(0, Dh, 2, dtype=jnp.float32) / Dh))
    ang = jnp.arange(S, dtype=jnp.float32)[:, None] * inv[None, :]
    cos = jnp.cos(ang)[None, :, None, :]
    sin = jnp.sin(ang)[None, :, None, :]
    t1, t2 = t[..., : Dh // 2], t[..., Dh // 2 :]
    return jnp.concatenate([t1 * cos - t2 * sin, t1 * sin + t2 * cos], axis=-1)


def retention_chunkwise(q, k, v):
    B, S, H, Dh = q.shape
    C = RET_CHUNK
    nc = S // C
    log_g = jnp.log1p(-jnp.exp2(-5.0 - jnp.arange(H, dtype=jnp.float32)))
    pos = jnp.arange(C, dtype=jnp.float32)
    diff = pos[:, None] - pos[None, :]
    causal = diff >= 0
    d_intra = jnp.where(causal[None], jnp.exp(jnp.where(causal, diff, 0.0)[None] * log_g[:, None, None]), 0.0)
    qc = q.reshape(B, nc, C, H, Dh)
    kc = k.reshape(B, nc, C, H, Dh)
    vc = v.reshape(B, nc, C, H, Dh)
    scores = jnp.einsum('bnchd,bnmhd->bnhcm', qc, kc) * d_intra[None, None]
    intra = jnp.einsum('bnhcm,bnmhd->bnchd', scores, vc)
    k_w = jnp.exp((C - 1.0 - pos)[:, None] * log_g[None, :])
    chunk_kv = jnp.einsum('bnchd,bnche->nbhde', kc * k_w[:, :, None], vc)
    g_chunk = jnp.exp(C * log_g)[None, :, None, None]

    def step(state, kv):
        return state * g_chunk + kv, state

    _, prev = lax.scan(step, jnp.zeros((B, H, Dh, Dh), jnp.float32), chunk_kv)
    q_w = jnp.exp((pos + 1.0)[:, None] * log_g[None, :])
    cross = jnp.einsum('bnchd,nbhde->bnche', qc * q_w[:, :, None], prev)
    return (intra + cross).reshape(B, S, H, Dh)


def rwkv7_recurrence(r, w, k, v, kk, a):
    B, S, H, N = r.shape

    def step(state, inp):
        r_t, w_t, k_t, v_t, kk_t, a_t = inp
        sa = jnp.einsum('bhvk,bhk->bhv', state, -kk_t)
        state = (state * w_t[:, :, None, :] + sa[..., None] * (kk_t * a_t)[:, :, None, :]
                 + v_t[..., None] * k_t[:, :, None, :])
        return state, jnp.einsum('bhvk,bhk->bhv', state, r_t)

    xs = tuple(jnp.swapaxes(t, 0, 1) for t in (r, w, k, v, kk, a))
    _, y = lax.scan(step, jnp.zeros((B, H, N, N), jnp.float32), xs)
    return jnp.swapaxes(y, 0, 1)


def token_shift_mix(p, mu):
    prev = jnp.pad(p, ((0, 0), (1, 0), (0, 0)))[:, :-1]
    return p + (prev - p) * mu


def hybrid_mixer(h, w_in, w_out, rwkv_mu, rwkv_w0, rwkv_w2, rwkv_a0, rwkv_a2, rwkv_g2, rwkv_k_k, rwkv_k_a,
                 rwkv_r_k, rwkv_gn_g, rwkv_gn_b, lru_conv_w, lru_conv_b, lru_wa, lru_ba, lru_wx, lru_bx, lru_lambda):
    B, S, _ = h.shape
    f32 = jnp.float32
    proj = h @ w_in
    p_ret, p_rwkv, p_lru = jnp.split(proj, [RET_SLAB, RET_SLAB + RWKV_SLAB], axis=-1)

    q, k, v, g_ret = jnp.split(p_ret.astype(f32), 4, axis=-1)
    q = rotary(q.reshape(B, S, RET_H, HEAD_DIM))
    k = rotary(k.reshape(B, S, RET_H, HEAD_DIM)) * (HEAD_DIM ** -0.5)
    v = v.reshape(B, S, RET_H, HEAD_DIM)
    y_ret = head_norm(retention_chunkwise(q, k, v), LN_EPS).reshape(B, S, RET_W) * jax.nn.silu(g_ret)

    z = token_shift_mix(p_rwkv.astype(f32), rwkv_mu)
    cuts = [RWKV_W, 2 * RWKV_W, 3 * RWKV_W, 3 * RWKV_W + RWKV_W_LORA, 3 * RWKV_W + RWKV_W_LORA + RWKV_A_LORA]
    r, kr, vr, wl, al, gl = jnp.split(z, cuts, axis=-1)
    w_log = -jax.nn.softplus(-(rwkv_w0 + jnp.tanh(wl) @ rwkv_w2)) - 0.5
    decay = jnp.exp(-jnp.exp(w_log))
    a = jax.nn.sigmoid(rwkv_a0 + al @ rwkv_a2)
    g_rw = jax.nn.sigmoid(gl) @ rwkv_g2
    hs = lambda t: t.reshape(B, S, RWKV_H, HEAD_DIM)
    kk = hs(kr * rwkv_k_k)
    kk = kk / jnp.maximum(jnp.sqrt(jnp.sum(kk * kk, -1, keepdims=True)), 1e-12)
    kr = kr * (1.0 + (a - 1.0) * rwkv_k_a)
    r_h, k_h, v_h = hs(r), hs(kr), hs(vr)
    y = rwkv7_recurrence(r_h, hs(decay), k_h, v_h, kk, hs(a))
    y = head_norm(y, RWKV_GN_EPS).reshape(B, S, RWKV_W) * rwkv_gn_g + rwkv_gn_b
    bonus = (jnp.sum(r_h * k_h * rwkv_r_k, -1, keepdims=True) * v_h).reshape(B, S, RWKV_W)
    y_rwkv = (y + bonus) * g_rw

    xl, gate = jnp.split(p_lru.astype(f32), 2, axis=-1)
    xl = lax.conv_general_dilated(xl, lru_conv_w.astype(f32)[:, None, :], (1,), [(LRU_CONV - 1, 0)],
                                  dimension_numbers=('NWC', 'WIO', 'NWC'), feature_group_count=LRU_W) + lru_conv_b
    xb = xl.reshape(B, S, LRU_H, HEAD_DIM)
    r_gate = jax.nn.sigmoid(jnp.einsum('bshi,hij->bshj', xb, lru_wa).reshape(B, S, LRU_W) + lru_ba)
    i_gate = jax.nn.sigmoid(jnp.einsum('bshi,hij->bshj', xb, lru_wx).reshape(B, S, LRU_W) + lru_bx)
    log_a = -LRU_C * r_gate * jax.nn.softplus(-lru_lambda)
    a_t = jnp.exp(log_a)
    b_t = jnp.sqrt(-jnp.expm1(2.0 * log_a)) * (i_gate * xl)
    _, h_lru = lax.associative_scan(lambda c1, c2: (c1[0] * c2[0], c2[0] * c1[1] + c2[1]), (a_t, b_t), axis=1)
    y_lru = h_lru * jax.nn.gelu(gate)

    y_cat = jnp.concatenate([y_ret, y_rwkv, y_lru], axis=-1).astype(h.dtype)
    return y_cat @ w_out


def hier_moe(x, moe_wg, moe_bg, moe_we, moe_be, moe_w_gate, moe_w_up, moe_w_down):
    B, S, D = x.shape
    T = B * S
    f32 = jnp.float32
    xf = x.reshape(T, D)
    gl = (xf @ moe_wg).astype(f32) + moe_bg
    pg = jax.nn.softmax(gl, axis=-1)
    g_sel = jnp.argmax(gl, axis=-1)
    g_gate = jnp.take_along_axis(pg, g_sel[:, None], axis=1)[:, 0]
    el = ((xf @ moe_we).astype(f32) + moe_be).reshape(T, N_GROUPS, EXPERTS_PER_GROUP)
    el = jnp.take_along_axis(el, g_sel[:, None, None], axis=1)[:, 0]
    top_p, top_i = lax.top_k(jax.nn.softmax(el, axis=-1), TOPK_IN_GROUP)
    top_p = top_p / jnp.sum(top_p, -1, keepdims=True)
    weights = g_gate[:, None] * top_p
    experts = g_sel[:, None] * EXPERTS_PER_GROUP + top_i

    A = T * TOPK_IN_GROUP
    e_flat = experts.reshape(A)
    t_flat = jnp.repeat(jnp.arange(T, dtype=jnp.int32), TOPK_IN_GROUP)
    w_flat = weights.reshape(A)
    order = jnp.argsort(e_flat)
    e_s, t_s, w_s = e_flat[order], t_flat[order], w_flat[order]
    counts = jnp.bincount(e_flat, length=N_EXPERTS)
    starts = jnp.cumsum(counts) - counts
    padded = ((counts + MOE_BLOCK - 1) // MOE_BLOCK) * MOE_BLOCK
    pends = jnp.cumsum(padded)
    pstarts = pends - padded
    dest = pstarts[e_s] + (jnp.arange(A) - starts[e_s])
    n_blocks = -(-A // MOE_BLOCK) + N_EXPERTS
    P = n_blocks * MOE_BLOCK
    slot_tok = jnp.full((P,), T, jnp.int32).at[dest].set(t_s.astype(jnp.int32))
    slot_w = jnp.zeros((P,), x.dtype).at[dest].set(w_s.astype(x.dtype))
    block_exp = jnp.minimum(jnp.searchsorted(pends, jnp.arange(n_blocks) * MOE_BLOCK, side='right'), N_EXPERTS - 1)
    x_pad = jnp.concatenate([xf, jnp.zeros((1, D), x.dtype)], axis=0)
    xb = x_pad[slot_tok].reshape(n_blocks, MOE_BLOCK, D)

    def expert_block(args):
        xblk, e = args
        hid = jax.nn.silu(xblk @ moe_w_gate[e]) * (xblk @ moe_w_up[e])
        return hid @ moe_w_down[e]

    yb = lax.map(expert_block, (xb, block_exp)).reshape(P, D)
    y = jnp.zeros((T + 1, D), x.dtype).at[slot_tok].add(yb * slot_w[:, None])[:T]
    return y.reshape(B, S, D)


def setup_inputs(seed: int = 0) -> dict:
    key = jax.random.key(seed)
    ks = iter(jax.random.split(key, 40))
    L, D = DEPTH, D_MODEL
    f32 = jnp.float32
    beta = (8.0 * DEPTH) ** -0.25

    def nrm(shape, scale):
        return scale * jax.random.normal(next(ks), shape, f32)

    def uni(shape, lo, hi):
        return jax.random.uniform(next(ks), shape, f32, lo, hi)

    x = nrm((BATCH, SEQ, D), 1.0)
    ln_in_g = 1.0 + nrm((D,), 0.02)
    ln_in_b = nrm((D,), 0.02)
    w_in = nrm((L, D, IN_W), D ** -0.5)
    w_out = nrm((L, MIX_W, D), beta * MIX_W ** -0.5)
    rwkv_mu = uni((L, RWKV_SLAB), 0.0, 1.0)
    rwkv_w0 = uni((L, RWKV_W), -6.0, 1.0)
    rwkv_w2 = nrm((L, RWKV_W_LORA, RWKV_W), 0.1 * RWKV_W_LORA ** -0.5)
    rwkv_a0 = nrm((L, RWKV_W), 0.1)
    rwkv_a2 = nrm((L, RWKV_A_LORA, RWKV_W), 0.1 * RWKV_A_LORA ** -0.5)
    rwkv_g2 = nrm((L, RWKV_G_LORA, RWKV_W), RWKV_G_LORA ** -0.5)
    rwkv_k_k = 0.85 + nrm((L, RWKV_W), 0.05)
    rwkv_k_a = 1.0 + nrm((L, RWKV_W), 0.05)
    rwkv_r_k = nrm((L, RWKV_H, HEAD_DIM), 0.1)
    rwkv_gn_g = 1.0 + nrm((L, RWKV_W), 0.02)
    rwkv_gn_b = nrm((L, RWKV_W), 0.02)
    lru_conv_w = nrm((L, LRU_CONV, LRU_W), LRU_CONV ** -0.5)
    lru_conv_b = nrm((L, LRU_W), 0.02)
    lru_wa = nrm((L, LRU_H, HEAD_DIM, HEAD_DIM), HEAD_DIM ** -0.5)
    lru_ba = nrm((L, LRU_W), 0.02)
    lru_wx = nrm((L, LRU_H, HEAD_DIM, HEAD_DIM), HEAD_DIM ** -0.5)
    lru_bx = nrm((L, LRU_W), 0.02)
    a_init = uni((L, LRU_W), 0.9, 0.999)
    s = a_init ** (1.0 / LRU_C)
    lru_lambda = jnp.log(s) - jnp.log1p(-s)
    ln1_g = 1.0 + nrm((L, D), 0.02)
    ln1_b = nrm((L, D), 0.02)
    moe_wg = nrm((L, D, N_GROUPS), D ** -0.5)
    moe_bg = nrm((L, N_GROUPS), 0.01)
    moe_we = nrm((L, D, N_EXPERTS), D ** -0.5)
    moe_be = nrm((L, N_EXPERTS), 0.01)
    moe_w_gate = nrm((L, N_EXPERTS, D, D_EXPERT), D ** -0.5)
    moe_w_up = nrm((L, N_EXPERTS, D, D_EXPERT), D ** -0.5)
    moe_w_down = nrm((L, N_EXPERTS, D_EXPERT, D), beta * D_EXPERT ** -0.5)
    ln2_g = 1.0 + nrm((L, D), 0.02)
    ln2_b = nrm((L, D), 0.02)
    return {"x": x, "ln_in_g": ln_in_g, "ln_in_b": ln_in_b, "w_in": w_in, "w_out": w_out,
            "rwkv_mu": rwkv_mu, "rwkv_w0": rwkv_w0, "rwkv_w2": rwkv_w2, "rwkv_a0": rwkv_a0,
            "rwkv_a2": rwkv_a2, "rwkv_g2": rwkv_g2, "rwkv_k_k": rwkv_k_k, "rwkv_k_a": rwkv_k_a,
            "rwkv_r_k": rwkv_r_k, "rwkv_gn_g": rwkv_gn_g, "rwkv_gn_b": rwkv_gn_b,
            "lru_conv_w": lru_conv_w, "lru_conv_b": lru_conv_b, "lru_wa": lru_wa, "lru_ba": lru_ba,
            "lru_wx": lru_wx, "lru_bx": lru_bx, "lru_lambda": lru_lambda, "ln1_g": ln1_g, "ln1_b": ln1_b,
            "moe_wg": moe_wg, "moe_bg": moe_bg, "moe_we": moe_we, "moe_be": moe_be,
            "moe_w_gate": moe_w_gate, "moe_w_up": moe_w_up, "moe_w_down": moe_w_down,
            "ln2_g": ln2_g, "ln2_b": ln2_b}


def reference(x, ln_in_g, ln_in_b, w_in, w_out, rwkv_mu, rwkv_w0, rwkv_w2, rwkv_a0, rwkv_a2, rwkv_g2,
              rwkv_k_k, rwkv_k_a, rwkv_r_k, rwkv_gn_g, rwkv_gn_b, lru_conv_w, lru_conv_b, lru_wa, lru_ba,
              lru_wx, lru_bx, lru_lambda, ln1_g, ln1_b, moe_wg, moe_bg, moe_we, moe_be, moe_w_gate,
              moe_w_up, moe_w_down, ln2_g, ln2_b):
    alpha = (2.0 * DEPTH) ** 0.25
    h = layer_norm(x, ln_in_g, ln_in_b)
    for l in range(DEPTH):
        mix = hybrid_mixer(h, w_in[l], w_out[l], rwkv_mu[l], rwkv_w0[l], rwkv_w2[l], rwkv_a0[l], rwkv_a2[l],
                           rwkv_g2[l], rwkv_k_k[l], rwkv_k_a[l], rwkv_r_k[l], rwkv_gn_g[l], rwkv_gn_b[l],
                           lru_conv_w[l], lru_conv_b[l], lru_wa[l], lru_ba[l], lru_wx[l], lru_bx[l], lru_lambda[l])
        h = layer_norm(alpha * h + mix.astype(h.dtype), ln1_g[l], ln1_b[l])
        ffn = hier_moe(h, moe_wg[l], moe_bg[l], moe_we[l], moe_be[l], moe_w_gate[l], moe_w_up[l], moe_w_down[l])
        h = layer_norm(alpha * h + ffn.astype(h.dtype), ln2_g[l], ln2_b[l])
    return h
```

```cpp
#include <hip/hip_runtime.h>
#include <hip/hip_cooperative_groups.h>
#include <cstdio>
#include <cstdint>

#define DEVI __device__ __forceinline__

constexpr int D = 1024, NBATCH = 2, S = 8192, T = NBATCH * S;
constexpr int INW = 3456;
constexpr int C_RWKV = 1536, C_LRU = 2944;
constexpr int RW = 384;
constexpr int RWSLAB = 1408;
constexpr int LW = 256;
constexpr int NE = 32, DE = 512;
constexpr int NT = 256;
constexpr float ALPHA = 1.4142135623730951f;
constexpr float LN_EPS = 1e-5f;

constexpr size_t al256(size_t x) { return (x + 255) & ~(size_t)255; }
constexpr size_t WS_PROJ = 0;
constexpr size_t SZ_PROJ = (size_t)T * INW * 4;
constexpr size_t WS_YCAT = al256(WS_PROJ + SZ_PROJ);
constexpr size_t SZ_TD = (size_t)T * D * 4;
constexpr size_t WS_RW = al256(WS_YCAT + SZ_TD);
constexpr size_t SZ_RW1 = (size_t)T * RW * 4;
constexpr size_t WS_LA = al256(WS_RW + 6 * SZ_RW1);
constexpr size_t SZ_L1 = (size_t)T * LW * 4;
constexpr size_t WS_LB = al256(WS_LA + SZ_L1);
constexpr size_t WS_KV = al256(WS_LB + SZ_L1);
constexpr size_t SZ_KV = (size_t)NBATCH * 64 * 6 * 4096 * 4;
constexpr size_t WS_LC = al256(WS_KV + SZ_KV);
constexpr size_t SZ_LC1 = (size_t)NBATCH * 64 * LW * 4;
constexpr size_t WS_CNT = al256(WS_LC + 3 * SZ_LC1);
constexpr size_t WS_LIST = al256(WS_CNT + 256);
constexpr size_t WS_TINFO = al256(WS_LIST + (size_t)NE * T * 4);
constexpr size_t WS_TW = al256(WS_TINFO + (size_t)T * 16);
constexpr size_t WS_END = al256(WS_TW + (size_t)T * 8);
constexpr size_t WS_MIX = WS_RW;
constexpr size_t WS_HID = WS_PROJ;
constexpr size_t WS_OUT2 = WS_PROJ + (size_t)2 * T * DE * 4;
static_assert(WS_OUT2 + (size_t)2 * T * D * 4 <= WS_PROJ + SZ_PROJ, "moe buffers fit in PROJ");

struct P {
    const float* in[34];
    float* out;
    char* ws;
};

enum { I_X = 0, I_LNG, I_LNB, I_WIN, I_WOUT, I_MU, I_W0, I_W2, I_A0, I_A2, I_G2, I_KK, I_KA, I_RK, I_GNG, I_GNB,
       I_CW, I_CB, I_WA, I_BA, I_WX, I_BX, I_LAM, I_LN1G, I_LN1B, I_MWG, I_MBG, I_MWE, I_MBE, I_MG, I_MU_, I_MD, I_LN2G, I_LN2B };

DEVI float wave_sum(float v) {
#pragma unroll
    for (int o = 1; o < 64; o <<= 1) v += __shfl_xor(v, o);
    return v;
}
DEVI float sigmoidf_(float x) { return 1.f / (1.f + expf(-x)); }
DEVI float siluf_(float x) { return x / (1.f + expf(-x)); }
DEVI float softplusf_(float x) { return fmaxf(x, 0.f) + log1pf(expf(-fabsf(x))); }
DEVI float gelu_tanh(float x) { return 0.5f * x * (1.f + tanhf(0.7978845608028654f * (x + 0.044715f * x * x * x))); }
__device__ const double LOGG[6] = {-0.0317486983145803, -0.015748356968139168, -0.007843177461025893,
                                   -0.003913899321136329, -0.0019550348358033506, -0.0009770396478266127};

DEVI void rope_sincos(int s, int i, float& sn, float& cs) {
    double inv = 1.0;
    for (int q = 0; q < i; ++q) inv *= 0.7498942093324559;
    const double ang = (double)s * inv;
    const double n = rint(ang * 0.6366197723675814);
    const double r = fma(-n, 1.5707963267948966, ang);
    const int q = (int)(((long long)n) & 3);
    const double r2 = r * r;
    const double sp = r * (1.0 + r2 * (-1.0 / 6 + r2 * (1.0 / 120 + r2 * (-1.0 / 5040 + r2 * (1.0 / 362880 + r2 * (-1.0 / 39916800))))));
    const double cp = 1.0 + r2 * (-0.5 + r2 * (1.0 / 24 + r2 * (-1.0 / 720 + r2 * (1.0 / 40320 + r2 * (-1.0 / 3628800 + r2 * (1.0 / 479001600))))));
    double s_, c_;
    if (q == 0) { s_ = sp; c_ = cp; } else if (q == 1) { s_ = cp; c_ = -sp; } else if (q == 2) { s_ = -sp; c_ = -cp; } else { s_ = -cp; c_ = sp; }
    sn = (float)s_; cs = (float)c_;
}

DEVI void ln_row(const float* a, float alpha, const float* m, const float* o0, float w0, const float* o1, float w1,
                 const float* g, const float* bb, float4 (&v)[4], int lane) {
    float s = 0.f;
#pragma unroll
    for (int j = 0; j < 4; ++j) {
        const int e = (j * 64 + lane) * 4;
        float4 x = *(const float4*)(a + e);
        x.x *= alpha; x.y *= alpha; x.z *= alpha; x.w *= alpha;
        if (m) { const float4 y = *(const float4*)(m + e); x.x += y.x; x.y += y.y; x.z += y.z; x.w += y.w; }
        if (o0) {
            const float4 y0 = *(const float4*)(o0 + e); const float4 y1 = *(const float4*)(o1 + e);
            x.x += w0 * y0.x + w1 * y1.x; x.y += w0 * y0.y + w1 * y1.y; x.z += w0 * y0.z + w1 * y1.z; x.w += w0 * y0.w + w1 * y1.w;
        }
        v[j] = x; s += (x.x + x.y) + (x.z + x.w);
    }
    const float mean = wave_sum(s) * (1.f / D);
    float q = 0.f;
#pragma unroll
    for (int j = 0; j < 4; ++j) {
        v[j].x -= mean; v[j].y -= mean; v[j].z -= mean; v[j].w -= mean;
        q += (v[j].x * v[j].x + v[j].y * v[j].y) + (v[j].z * v[j].z + v[j].w * v[j].w);
    }
    const float rstd = 1.f / sqrtf(wave_sum(q) * (1.f / D) + LN_EPS);
#pragma unroll
    for (int j = 0; j < 4; ++j) {
        const int e = (j * 64 + lane) * 4;
        const float4 gg = *(const float4*)(g + e); const float4 b4 = *(const float4*)(bb + e);
        v[j].x = v[j].x * rstd * gg.x + b4.x; v[j].y = v[j].y * rstd * gg.y + b4.y;
        v[j].z = v[j].z * rstd * gg.z + b4.z; v[j].w = v[j].w * rstd * gg.w + b4.w;
    }
}
DEVI void store_row(float* o, const float4 (&v)[4], int lane) {
#pragma unroll
    for (int j = 0; j < 4; ++j) *(float4*)(o + (j * 64 + lane) * 4) = v[j];
}

__device__ void ph_ln_in(const P& p) {
    const int tid = threadIdx.x, lane = tid & 63;
    const int gw = (blockIdx.x * NT + tid) >> 6, nw = gridDim.x * (NT / 64);
    if (blockIdx.x == 0 && tid < 64) ((int*)(p.ws + WS_CNT))[tid] = 0;
    for (int row = gw; row < T; row += nw) {
        float4 v[4];
        ln_row(p.in[I_X] + (size_t)row * D, 1.f, nullptr, nullptr, 0.f, nullptr, 0.f, p.in[I_LNG], p.in[I_LNB], v, lane);
        store_row(p.out + (size_t)row * D, v, lane);
    }
}

template <int MODE>
DEVI void gemm_tile(float* sm, const float* A, int lda, const int* rowidx, int mvalid,
                    const float* B0, const float* B1, int ldb, int K, float* C, int ldc) {
    const int tid = threadIdx.x, ty = tid >> 4, tx = tid & 15;
    float (*As)[68] = (float (*)[68])sm;
    float (*Bs)[68] = (float (*)[68])(sm + 16 * 68);
    float (*Bs1)[68] = (float (*)[68])(sm + 32 * 68);
    const int ar = tid >> 2, ak = (tid & 3) * 4;
    const int bk = tid >> 4, bn = (tid & 15) * 4;
    const float* arow = nullptr;
    if (ar < mvalid) arow = A + (size_t)(rowidx ? rowidx[ar] : ar) * lda;
    float acc[4][4], acc1[4][4];
#pragma unroll
    for (int i = 0; i < 4; ++i)
#pragma unroll
        for (int j = 0; j < 4; ++j) { acc[i][j] = 0.f; acc1[i][j] = 0.f; }
    for (int k0 = 0; k0 < K; k0 += 16) {
        float4 av = make_float4(0.f, 0.f, 0.f, 0.f);
        if (arow) av = *(const float4*)(arow + k0 + ak);
        const float4 bv = *(const float4*)(B0 + (size_t)(k0 + bk) * ldb + bn);
        float4 bv1 = make_float4(0.f, 0.f, 0.f, 0.f);
        if (MODE == 1) bv1 = *(const float4*)(B1 + (size_t)(k0 + bk) * ldb + bn);
        __syncthreads();
        As[ak + 0][ar] = av.x; As[ak + 1][ar] = av.y; As[ak + 2][ar] = av.z; As[ak + 3][ar] = av.w;
        *(float4*)&Bs[bk][bn] = bv;
        if (MODE == 1) *(float4*)&Bs1[bk][bn] = bv1;
        __syncthreads();
#pragma unroll
        for (int kk = 0; kk < 16; ++kk) {
            const float4 a4 = *(const float4*)&As[kk][ty * 4];
            const float4 b4 = *(const float4*)&Bs[kk][tx * 4];
            const float a[4] = {a4.x, a4.y, a4.z, a4.w};
            const float b[4] = {b4.x, b4.y, b4.z, b4.w};
#pragma unroll
            for (int i = 0; i < 4; ++i)
#pragma unroll
                for (int j = 0; j < 4; ++j) acc[i][j] += a[i] * b[j];
            if (MODE == 1) {
                const float4 c4 = *(const float4*)&Bs1[kk][tx * 4];
                const float c[4] = {c4.x, c4.y, c4.z, c4.w};
#pragma unroll
                for (int i = 0; i < 4; ++i)
#pragma unroll
                    for (int j = 0; j < 4; ++j) acc1[i][j] += a[i] * c[j];
            }
        }
    }
#pragma unroll
    for (int i = 0; i < 4; ++i) {
        const int r = ty * 4 + i;
        if (r < mvalid) {
            float4 o;
            if (MODE == 1) {
                o.x = siluf_(acc[i][0]) * acc1[i][0]; o.y = siluf_(acc[i][1]) * acc1[i][1];
                o.z = siluf_(acc[i][2]) * acc1[i][2]; o.w = siluf_(acc[i][3]) * acc1[i][3];
            } else { o.x = acc[i][0]; o.y = acc[i][1]; o.z = acc[i][2]; o.w = acc[i][3]; }
            *(float4*)(C + (size_t)r * ldc + tx * 4) = o;
        }
    }
}

__device__ void ph_gemm_dense(float* sm, const float* A, const float* B, float* C, int M, int N, int K) {
    const int tn = N / 64, tiles = (M / 64) * tn;
    for (int q = blockIdx.x; q < tiles; q += gridDim.x) {
        const int mi = q / tn, ni = q % tn;
        gemm_tile<0>(sm, A + (size_t)mi * 64 * K, K, nullptr, 64, B + ni * 64, nullptr, N, K, C + (size_t)mi * 64 * N + ni * 64, N);
    }
}

__device__ void ph_rotary(const P& p) {
    float* proj = (float*)(p.ws + WS_PROJ);
    const size_t total = (size_t)T * 384;
    for (size_t idx = (size_t)blockIdx.x * NT + threadIdx.x; idx < total; idx += (size_t)gridDim.x * NT) {
        const int t = (int)(idx / 384), rem = (int)(idx % 384), hh = rem >> 5, i = rem & 31;
        const int s = t & (S - 1);
        float sn, cs; rope_sincos(s, i, sn, cs);
        float* q = proj + (size_t)t * INW + hh * 64 + i;
        const float x1 = q[0], x2 = q[32];
        const float sc = hh >= 6 ? 0.125f : 1.f;
        q[0] = (x1 * cs - x2 * sn) * sc;
        q[32] = (x1 * sn + x2 * cs) * sc;
    }
}

__device__ void ph_ret_kv(const P& p, float* sm) {
    const float* proj = (const float*)(p.ws + WS_PROJ);
    float* kv = (float*)(p.ws + WS_KV);
    const int tid = threadIdx.x;
    float* ks = sm;
    float* vs = sm + 4096;
    for (int item = blockIdx.x; item < NBATCH * 64 * 6; item += gridDim.x) {
        const int h = item % 6, n = (item / 6) % 64, b = item / 384;
        const float logg = (float)LOGG[h];
        const int d = tid >> 2, e0 = (tid & 3) * 16;
        float acc[16];
#pragma unroll
        for (int j = 0; j < 16; ++j) acc[j] = 0.f;
        for (int half = 0; half < 2; ++half) {
            __syncthreads();
            for (int i = tid; i < 1024; i += NT) {
                const int c = i >> 4, d4 = (i & 15) * 4;
                const size_t tok = (size_t)b * S + n * 128 + half * 64 + c;
                const float w = expf((float)(127 - (half * 64 + c)) * logg);
                float4 kx = *(const float4*)(proj + tok * INW + 384 + h * 64 + d4);
                kx.x *= w; kx.y *= w; kx.z *= w; kx.w *= w;
                *(float4*)(ks + c * 64 + d4) = kx;
                *(float4*)(vs + c * 64 + d4) = *(const float4*)(proj + tok * INW + 768 + h * 64 + d4);
            }
            __syncthreads();
            for (int c = 0; c < 64; ++c) {
                const float kd = ks[c * 64 + d];
#pragma unroll
                for (int j = 0; j < 16; ++j) acc[j] += kd * vs[c * 64 + e0 + j];
            }
        }
        float* o = kv + (size_t)item * 4096 + d * 64 + e0;
#pragma unroll
        for (int j = 0; j < 16; ++j) o[j] = acc[j];
    }
}

__device__ void ph_ret_scan(const P& p) {
    float* kv = (float*)(p.ws + WS_KV);
    const int total = NBATCH * 6 * 4096;
    for (int idx = blockIdx.x * NT + threadIdx.x; idx < total; idx += gridDim.x * NT) {
        const int de = idx & 4095, bh = idx >> 12, h = bh % 6, b = bh / 6;
        const float g = expf(128.f * (float)LOGG[h]);
        float st = 0.f;
        for (int n = 0; n < 64; ++n) {
            float* ptr = kv + ((size_t)((b * 64 + n) * 6 + h)) * 4096 + de;
            const float x = *ptr;
            *ptr = st;
            st = st * g + x;
        }
    }
}

__device__ void ph_ret_out(const P& p, float* sm) {
    const float* proj = (const float*)(p.ws + WS_PROJ);
    const float* kv = (const float*)(p.ws + WS_KV);
    float* ycat = (float*)(p.ws + WS_YCAT);
    const int tid = threadIdx.x;
    float* ks = sm;
    float* vs = sm + 4096;
    for (int item = blockIdx.x; item < NBATCH * 64 * 6; item += gridDim.x) {
        const int h = item % 6, n = (item / 6) % 64, b = item / 384;
        const float logg = (float)LOGG[h];
        const int c = tid >> 1, eh = tid & 1;
        const size_t tok = (size_t)b * S + n * 128 + c;
        float q[64];
#pragma unroll
        for (int j = 0; j < 16; ++j) {
            const float4 x = *(const float4*)(proj + tok * INW + h * 64 + j * 4);
            q[j * 4] = x.x; q[j * 4 + 1] = x.y; q[j * 4 + 2] = x.z; q[j * 4 + 3] = x.w;
        }
        float acc[32];
#pragma unroll
        for (int j = 0; j < 32; ++j) acc[j] = 0.f;
        for (int half = 0; half < 2; ++half) {
            __syncthreads();
            for (int i = tid; i < 1024; i += NT) {
                const int cc = i >> 4, d4 = (i & 15) * 4;
                const size_t tk = (size_t)b * S + n * 128 + half * 64 + cc;
                *(float4*)(ks + cc * 64 + d4) = *(const float4*)(proj + tk * INW + 384 + h * 64 + d4);
                *(float4*)(vs + cc * 64 + d4) = *(const float4*)(proj + tk * INW + 768 + h * 64 + d4);
            }
            __syncthreads();
            for (int ml = 0; ml < 64; ++ml) {
                const int m = half * 64 + ml;
                if (m <= c) {
                    float sc = 0.f;
#pragma unroll
                    for (int dd = 0; dd < 64; ++dd) sc += q[dd] * ks[ml * 64 + dd];
                    sc *= expf((float)(c - m) * logg);
#pragma unroll
                    for (int j = 0; j < 32; ++j) acc[j] += sc * vs[ml * 64 + eh * 32 + j];
                }
            }
        }
        const float qw = expf((float)(c + 1) * logg);
        const float* prev = kv + (size_t)item * 4096;
#pragma unroll
        for (int dd = 0; dd < 64; ++dd) {
            const float qd = q[dd] * qw;
#pragma unroll
            for (int j = 0; j < 32; ++j) acc[j] += qd * prev[dd * 64 + eh * 32 + j];
        }
        float s = 0.f;
#pragma unroll
        for (int j = 0; j < 32; ++j) s += acc[j];
        s += __shfl_xor(s, 1);
        const float mean = s * (1.f / 64.f);
        float v2 = 0.f;
#pragma unroll
        for (int j = 0; j < 32; ++j) { acc[j] -= mean; v2 += acc[j] * acc[j]; }
        v2 += __shfl_xor(v2, 1);
        const float rstd = 1.f / sqrtf(v2 * (1.f / 64.f) + LN_EPS);
        const float* gr = proj + tok * INW + 1152 + h * 64 + eh * 32;
        float* o = ycat + tok * D + h * 64 + eh * 32;
#pragma unroll
        for (int j = 0; j < 32; ++j) o[j] = acc[j] * rstd * siluf_(gr[j]);
    }
}

__device__ void ph_rwkv_prep(const P& p, int l, float* sm) {
    const float* proj = (const float*)(p.ws + WS_PROJ);
    float* rw = (float*)(p.ws + WS_RW);
    const size_t A1 = (size_t)T * RW;
    const float* mu = p.in[I_MU] + l * RWSLAB;
    const float* w0 = p.in[I_W0] + l * RW; const float* w2 = p.in[I_W2] + (size_t)l * 64 * RW;
    const float* a0 = p.in[I_A0] + l * RW; const float* a2 = p.in[I_A2] + (size_t)l * 64 * RW;
    const float* k_k = p.in[I_KK] + l * RW; const float* k_a = p.in[I_KA] + l * RW;
    const int tid = threadIdx.x;
    float* zs = sm;
    for (int t = blockIdx.x; t < T; t += gridDim.x) {
        __syncthreads();
        const int s = t & (S - 1);
        const float* pc = proj + (size_t)t * INW + C_RWKV;
        for (int i = tid; i < 1280; i += NT) {
            const float c = pc[i];
            const float pv = s > 0 ? pc[i - INW] : 0.f;
            float z = c + (pv - c) * mu[i];
            if (i >= 1152 && i < 1216) z = tanhf(z);
            zs[i] = z;
        }
        __syncthreads();
        for (int c = tid; c < RW; c += NT) {
            float u = w0[c], av = a0[c];
            for (int j = 0; j < 64; ++j) { u += zs[1152 + j] * w2[j * RW + c]; av += zs[1216 + j] * a2[j * RW + c]; }
            const float wl = -softplusf_(-u) - 0.5f;
            const float dec = expf(-expf(wl));
            av = sigmoidf_(av);
            const float kr = zs[384 + c];
            const float kkv = kr * k_k[c];
            const float n2 = wave_sum(kkv * kkv);
            const float kk = kkv / fmaxf(sqrtf(n2), 1e-12f);
            const float kmod = kr * (1.f + (av - 1.f) * k_a[c]);
            const size_t o = (size_t)t * RW + c;
            rw[0 * A1 + o] = kk; rw[1 * A1 + o] = dec; rw[2 * A1 + o] = -kk * av;
            rw[3 * A1 + o] = kmod; rw[4 * A1 + o] = zs[c]; rw[5 * A1 + o] = zs[768 + c];
        }
    }
}

__device__ void ph_rwkv_scan(const P& p, float* sm) {
    const float* rw = (const float*)(p.ws + WS_RW);
    const size_t A1 = (size_t)T * RW;
    float* ycat = (float*)(p.ws + WS_YCAT);
    const int tid = threadIdx.x, lane = tid & 63, wv = tid >> 6;
    const int rl = wv * 4 + (lane >> 4), kq = lane & 15;
    float* smV = sm + 5 * 2048;
    float* smY = smV + 512;
    for (int item = blockIdx.x; item < 48; item += gridDim.x) {
        const int bh = item >> 2, rg = item & 3, b = bh / 6, h = bh % 6;
        float s0 = 0.f, s1 = 0.f, s2 = 0.f, s3 = 0.f;
        for (int t0 = 0; t0 < S; t0 += 32) {
            __syncthreads();
            for (int a = 0; a < 5; ++a) {
                const float* src = rw + a * A1;
                for (int i = tid; i < 512; i += NT) {
                    const int tt = i >> 4, k4 = (i & 15) * 4;
                    *(float4*)(sm + a * 2048 + tt * 64 + k4) = *(const float4*)(src + ((size_t)b * S + t0 + tt) * RW + h * 64 + k4);
                }
            }
            for (int i = tid; i < 512; i += NT) {
                const int tt = i >> 4, r = i & 15;
                smV[i] = rw[5 * A1 + ((size_t)b * S + t0 + tt) * RW + h * 64 + rg * 16 + r];
            }
            __syncthreads();
            for (int tt = 0; tt < 32; ++tt) {
                const float4 kk = *(const float4*)(sm + 0 * 2048 + tt * 64 + kq * 4);
                const float4 w = *(const float4*)(sm + 1 * 2048 + tt * 64 + kq * 4);
                const float4 nb = *(const float4*)(sm + 2 * 2048 + tt * 64 + kq * 4);
                const float4 k = *(const float4*)(sm + 3 * 2048 + tt * 64 + kq * 4);
                const float4 r = *(const float4*)(sm + 4 * 2048 + tt * 64 + kq * 4);
                const float vv = smV[tt * 16 + rl];
                float d = (s0 * kk.x + s1 * kk.y) + (s2 * kk.z + s3 * kk.w);
                d += __shfl_xor(d, 1); d += __shfl_xor(d, 2); d += __shfl_xor(d, 4); d += __shfl_xor(d, 8);
                s0 = s0 * w.x + d * nb.x + vv * k.x;
                s1 = s1 * w.y + d * nb.y + vv * k.y;
                s2 = s2 * w.z + d * nb.z + vv * k.z;
                s3 = s3 * w.w + d * nb.w + vv * k.w;
                float y = (s0 * r.x + s1 * r.y) + (s2 * r.z + s3 * r.w);
                y += __shfl_xor(y, 1); y += __shfl_xor(y, 2); y += __shfl_xor(y, 4); y += __shfl_xor(y, 8);
                if (kq == 0) smY[tt * 16 + rl] = y;
            }
            __syncthreads();
            for (int i = tid; i < 512; i += NT) {
                const int tt = i >> 4, r = i & 15;
                ycat[((size_t)b * S + t0 + tt) * D + 384 + h * 64 + rg * 16 + r] = smY[i];
            }
        }
    }
}

__device__ void ph_rwkv_post(const P& p, int l, float* sm) {
    const float* proj = (const float*)(p.ws + WS_PROJ);
    const float* rw = (const float*)(p.ws + WS_RW);
    const size_t A1 = (size_t)T * RW;
    float* ycat = (float*)(p.ws + WS_YCAT);
    const float* mu = p.in[I_MU] + l * RWSLAB;
    const float* g2 = p.in[I_G2] + (size_t)l * 128 * RW;
    const float* r_k = p.in[I_RK] + l * RW;
    const float* gng = p.in[I_GNG] + l * RW; const float* gnb = p.in[I_GNB] + l * RW;
    const int tid = threadIdx.x;
    float* zs = sm;
    for (int t = blockIdx.x; t < T; t += gridDim.x) {
        __syncthreads();
        const int s = t & (S - 1);
        const float* pc = proj + (size_t)t * INW + C_RWKV;
        if (tid < 128) {
            const int i = 1280 + tid;
            const float c = pc[i];
            const float pv = s > 0 ? pc[i - INW] : 0.f;
            zs[tid] = sigmoidf_(c + (pv - c) * mu[i]);
        }
        __syncthreads();
        for (int c = tid; c < RW; c += NT) {
            const size_t o = (size_t)t * RW + c;
            float* yp = ycat + (size_t)t * D + 384 + c;
            const float y = *yp;
            const float mean = wave_sum(y) * (1.f / 64.f);
            const float dv = y - mean;
            const float var = wave_sum(dv * dv) * (1.f / 64.f);
            const float yn = dv * (1.f / sqrtf(var + 64e-5f)) * gng[c] + gnb[c];
            const float r = rw[4 * A1 + o], k = rw[3 * A1 + o], v = rw[5 * A1 + o];
            const float bonus = wave_sum(r * k * r_k[c]) * v;
            float g = 0.f;
            for (int j = 0; j < 128; ++j) g += zs[j] * g2[j * RW + c];
            *yp = (yn + bonus) * g;
        }
    }
}

__device__ void ph_lru_prep(const P& p, int l, float* sm) {
    const float* proj = (const float*)(p.ws + WS_PROJ);
    float* la = (float*)(p.ws + WS_LA); float* lb = (float*)(p.ws + WS_LB);
    const float* cw = p.in[I_CW] + l * 4 * LW; const float* cb = p.in[I_CB] + l * LW;
    const float* wa = p.in[I_WA] + (size_t)l * 4 * 4096; const float* ba = p.in[I_BA] + l * LW;
    const float* wx = p.in[I_WX] + (size_t)l * 4 * 4096; const float* bx = p.in[I_BX] + l * LW;
    const float* lam = p.in[I_LAM] + l * LW;
    const int c = threadIdx.x;
    float* xs = sm;
    for (int t = blockIdx.x; t < T; t += gridDim.x) {
        __syncthreads();
        const int s = t & (S - 1);
        float xc = cb[c];
#pragma unroll
        for (int j = 0; j < 4; ++j) {
            const int sj = s - 3 + j;
            if (sj >= 0) xc += cw[j * LW + c] * proj[(size_t)(t - 3 + j) * INW + C_LRU + c];
        }
        xs[c] = xc;
        __syncthreads();
        const int h = c >> 6, jj = c & 63;
        float ra = ba[c], ia = bx[c];
        for (int i = 0; i < 64; ++i) {
            const float xv = xs[h * 64 + i];
            ra += xv * wa[(h * 64 + i) * 64 + jj];
            ia += xv * wx[(h * 64 + i) * 64 + jj];
        }
        const float r = sigmoidf_(ra), ig = sigmoidf_(ia);
        const float lga = -8.f * r * softplusf_(-lam[c]);
        la[(size_t)t * LW + c] = expf(lga);
        lb[(size_t)t * LW + c] = sqrtf(-expm1f(2.f * lga)) * (ig * xc);
    }
}
__device__ void ph_lru_local(const P& p) {
    const float* la = (const float*)(p.ws + WS_LA); const float* lb = (const float*)(p.ws + WS_LB);
    float* ca = (float*)(p.ws + WS_LC); float* cb = ca + NBATCH * 64 * LW;
    for (int idx = blockIdx.x * NT + threadIdx.x; idx < NBATCH * 64 * LW; idx += gridDim.x * NT) {
        const int c = idx & 255, n = (idx >> 8) & 63, b = idx >> 14;
        float A = 1.f, Bv = 0.f;
        for (int i = 0; i < 128; ++i) {
            const size_t o = ((size_t)b * S + n * 128 + i) * LW + c;
            const float a = la[o];
            A *= a; Bv = a * Bv + lb[o];
        }
        ca[idx] = A; cb[idx] = Bv;
    }
}
__device__ void ph_lru_carry(const P& p) {
    const float* ca = (const float*)(p.ws + WS_LC); const float* cb = ca + NBATCH * 64 * LW;
    float* hin = (float*)(p.ws + WS_LC) + 2 * NBATCH * 64 * LW;
    for (int idx = blockIdx.x * NT + threadIdx.x; idx < NBATCH * LW; idx += gridDim.x * NT) {
        const int c = idx & 255, b = idx >> 8;
        float h = 0.f;
        for (int n = 0; n < 64; ++n) {
            const int o = (b * 64 + n) * LW + c;
            hin[o] = h;
            h = ca[o] * h + cb[o];
        }
    }
}
__device__ void ph_lru_out(const P& p) {
    const float* proj = (const float*)(p.ws + WS_PROJ);
    const float* la = (const float*)(p.ws + WS_LA); const float* lb = (const float*)(p.ws + WS_LB);
    const float* hin = (const float*)(p.ws + WS_LC) + 2 * NBATCH * 64 * LW;
    float* ycat = (float*)(p.ws + WS_YCAT);
    for (int idx = blockIdx.x * NT + threadIdx.x; idx < NBATCH * 64 * LW; idx += gridDim.x * NT) {
        const int c = idx & 255, n = (idx >> 8) & 63, b = idx >> 14;
        float h = hin[idx];
        for (int i = 0; i < 128; ++i) {
            const size_t tok = (size_t)b * S + n * 128 + i;
            h = la[tok * LW + c] * h + lb[tok * LW + c];
            ycat[tok * D + 768 + c] = h * gelu_tanh(proj[tok * INW + C_LRU + 256 + c]);
        }
    }
}

__device__ void ph_ln1_router(const P& p, int l) {
    const float* mix = (const float*)(p.ws + WS_MIX);
    float* x1 = (float*)(p.ws + WS_YCAT);
    int* cnt = (int*)(p.ws + WS_CNT) + l * NE;
    int* list = (int*)(p.ws + WS_LIST);
    int* tinfo = (int*)(p.ws + WS_TINFO);
    float* tw = (float*)(p.ws + WS_TW);
    const float* wg = p.in[I_MWG] + (size_t)l * D * 4; const float* bg = p.in[I_MBG] + l * 4;
    const float* we = p.in[I_MWE] + (size_t)l * D * NE; const float* be = p.in[I_MBE] + l * NE;
    const int tid = threadIdx.x, lane = tid & 63;
    const int gw = (blockIdx.x * NT + tid) >> 6, nw = gridDim.x * (NT / 64);
    for (int row = gw; row < T; row += nw) {
        float4 v[4];
        ln_row(p.out + (size_t)row * D, ALPHA, mix + (size_t)row * D, nullptr, 0.f, nullptr, 0.f,
               p.in[I_LN1G] + l * D, p.in[I_LN1B] + l * D, v, lane);
        store_row(x1 + (size_t)row * D, v, lane);
        float lg[4] = {0.f, 0.f, 0.f, 0.f};
        float le[NE];
#pragma unroll
        for (int o = 0; o < NE; ++o) le[o] = 0.f;
#pragma unroll
        for (int j = 0; j < 4; ++j) {
            const float xv[4] = {v[j].x, v[j].y, v[j].z, v[j].w};
#pragma unroll
            for (int c = 0; c < 4; ++c) {
                const int e = (j * 64 + lane) * 4 + c;
                const float4 g4 = *(const float4*)(wg + (size_t)e * 4);
                lg[0] += xv[c] * g4.x; lg[1] += xv[c] * g4.y; lg[2] += xv[c] * g4.z; lg[3] += xv[c] * g4.w;
#pragma unroll
                for (int o4 = 0; o4 < 8; ++o4) {
                    const float4 w4 = *(const float4*)(we + (size_t)e * NE + o4 * 4);
                    le[o4 * 4] += xv[c] * w4.x; le[o4 * 4 + 1] += xv[c] * w4.y; le[o4 * 4 + 2] += xv[c] * w4.z; le[o4 * 4 + 3] += xv[c] * w4.w;
                }
            }
        }
#pragma unroll
        for (int g = 0; g < 4; ++g) lg[g] = wave_sum(lg[g]) + bg[g];
#pragma unroll
        for (int o = 0; o < NE; ++o) le[o] = wave_sum(le[o]) + be[o];
        int gs = 0; float gm = lg[0];
#pragma unroll
        for (int g = 1; g < 4; ++g) if (lg[g] > gm) { gm = lg[g]; gs = g; }
        float den = 0.f;
#pragma unroll
        for (int g = 0; g < 4; ++g) den += expf(lg[g] - gm);
        const float ggate = 1.f / den;
        float el[8];
#pragma unroll
        for (int j = 0; j < 8; ++j) {
            float x = le[j];
#pragma unroll
            for (int g = 1; g < 4; ++g) x = (gs == g) ? le[g * 8 + j] : x;
            el[j] = x;
        }
        int i1 = 0; float m1 = el[0];
#pragma unroll
        for (int j = 1; j < 8; ++j) if (el[j] > m1) { m1 = el[j]; i1 = j; }
        int i2 = -1; float m2 = -3.0e38f;
#pragma unroll
        for (int j = 0; j < 8; ++j) if (j != i1 && el[j] > m2) { m2 = el[j]; i2 = j; }
        const float p2 = expf(m2 - m1);
        const float wt1 = ggate / (1.f + p2), wt2 = ggate * p2 / (1.f + p2);
        if (lane == 0) {
            const int e1 = gs * 8 + i1, e2 = gs * 8 + i2;
            const int pos1 = atomicAdd(&cnt[e1], 1);
            const int pos2 = atomicAdd(&cnt[e2], 1);
            list[(size_t)e1 * T + pos1] = row;
            list[(size_t)e2 * T + pos2] = row;
            tinfo[row * 4 + 0] = e1; tinfo[row * 4 + 1] = pos1; tinfo[row * 4 + 2] = e2; tinfo[row * 4 + 3] = pos2;
            tw[row * 2 + 0] = wt1; tw[row * 2 + 1] = wt2;
        }
    }
}

__device__ void ph_moe(const P& p, int l, float* sm, int which) {
    const int* cnt = (const int*)(p.ws + WS_CNT) + l * NE;
    const int* list = (const int*)(p.ws + WS_LIST);
    const float* x1 = (const float*)(p.ws + WS_YCAT);
    float* hid = (float*)(p.ws + WS_HID);
    float* out2 = (float*)(p.ws + WS_OUT2);
    const int tn = which == 0 ? DE / 64 : D / 64;
    int q = blockIdx.x;
    int tbase = 0, off = 0;
    for (int e = 0; e < NE; ++e) {
        const int ne = cnt[e];
        const int tiles = ((ne + 63) / 64) * tn;
        while (q < tbase + tiles) {
            const int lt = q - tbase, mi = lt / tn, ni = lt % tn;
            const int mvalid = min(64, ne - mi * 64);
            if (which == 0) {
                const float* Bg = p.in[I_MG] + ((size_t)(l * NE + e)) * D * DE + ni * 64;
                const float* Bu = p.in[I_MU_] + ((size_t)(l * NE + e)) * D * DE + ni * 64;
                gemm_tile<1>(sm, x1, D, list + (size_t)e * T + mi * 64, mvalid, Bg, Bu, DE, D,
                             hid + (size_t)(off + mi * 64) * DE + ni * 64, DE);
            } else {
                const float* Bd = p.in[I_MD] + ((size_t)(l * NE + e)) * DE * D + ni * 64;
                gemm_tile<2>(sm, hid + (size_t)(off + mi * 64) * DE, DE, nullptr, mvalid, Bd, nullptr, D, DE,
                             out2 + (size_t)(off + mi * 64) * D + ni * 64, D);
            }
            q += gridDim.x;
        }
        tbase += tiles; off += ne;
    }
}

__device__ void ph_ln2(const P& p, int l, float* sm) {
    const int* cnt = (const int*)(p.ws + WS_CNT) + l * NE;
    const int* tinfo = (const int*)(p.ws + WS_TINFO);
    const float* tw = (const float*)(p.ws + WS_TW);
    const float* x1 = (const float*)(p.ws + WS_YCAT);
    const float* out2 = (const float*)(p.ws + WS_OUT2);
    int* offs = (int*)sm;
    const int tid = threadIdx.x, lane = tid & 63;
    if (tid == 0) { int o = 0; for (int e = 0; e < NE; ++e) { offs[e] = o; o += cnt[e]; } }
    __syncthreads();
    const int gw = (blockIdx.x * NT + tid) >> 6, nw = gridDim.x * (NT / 64);
    for (int row = gw; row < T; row += nw) {
        const int e1 = tinfo[row * 4], p1 = tinfo[row * 4 + 1], e2 = tinfo[row * 4 + 2], p2 = tinfo[row * 4 + 3];
        const float* o0 = out2 + (size_t)(offs[e1] + p1) * D;
        const float* o1 = out2 + (size_t)(offs[e2] + p2) * D;
        float4 v[4];
        ln_row(x1 + (size_t)row * D, ALPHA, nullptr, o0, tw[row * 2], o1, tw[row * 2 + 1],
               p.in[I_LN2G] + l * D, p.in[I_LN2B] + l * D, v, lane);
        store_row(p.out + (size_t)row * D, v, lane);
    }
}

enum { PH_LNIN = 0, PH_INPROJ, PH_ROTARY, PH_RETKV, PH_RETSCAN, PH_RETOUT, PH_RWPREP, PH_RWSCAN, PH_RWPOST,
       PH_LRUPREP, PH_LRULOCAL, PH_LRUCARRY, PH_LRUOUT, PH_OUTPROJ, PH_LN1, PH_MOE1, PH_MOE2, PH_LN2 };

__device__ void run_phase(const P& p, int ph, int l, float* sm) {
    switch (ph) {
        case PH_LNIN: ph_ln_in(p); break;
        case PH_INPROJ: ph_gemm_dense(sm, p.out, p.in[I_WIN] + (size_t)l * D * INW, (float*)(p.ws + WS_PROJ), T, INW, D); break;
        case PH_ROTARY: ph_rotary(p); break;
        case PH_RETKV: ph_ret_kv(p, sm); break;
        case PH_RETSCAN: ph_ret_scan(p); break;
        case PH_RETOUT: ph_ret_out(p, sm); break;
        case PH_RWPREP: ph_rwkv_prep(p, l, sm); break;
        case PH_RWSCAN: ph_rwkv_scan(p, sm); break;
        case PH_RWPOST: ph_rwkv_post(p, l, sm); break;
        case PH_LRUPREP: ph_lru_prep(p, l, sm); break;
        case PH_LRULOCAL: ph_lru_local(p); break;
        case PH_LRUCARRY: ph_lru_carry(p); break;
        case PH_LRUOUT: ph_lru_out(p); break;
        case PH_OUTPROJ: ph_gemm_dense(sm, (const float*)(p.ws + WS_YCAT), p.in[I_WOUT] + (size_t)l * D * D, (float*)(p.ws + WS_MIX), T, D, D); break;
        case PH_LN1: ph_ln1_router(p, l); break;
        case PH_MOE1: ph_moe(p, l, sm, 0); break;
        case PH_MOE2: ph_moe(p, l, sm, 1); break;
        case PH_LN2: ph_ln2(p, l, sm); break;
    }
}

__global__ void __launch_bounds__(NT) k_phase(P p, int ph, int l) {
    __shared__ __attribute__((aligned(16))) float sm[12288];
    run_phase(p, ph, l, sm);
}

extern "C" void kernel_launch(void* const* d_in, const int* in_sizes, int n_in, void* d_out, int out_size,
                              void* d_ws, size_t ws_size, hipStream_t stream) {
    if (n_in != 34 || ws_size < WS_END) { fprintf(stderr, "kernel_launch: bad args n_in=%d ws=%zu need %zu\n", n_in, ws_size, (size_t)WS_END); return; }
    P p{};
    for (int i = 0; i < 34; ++i) p.in[i] = (const float*)d_in[i];
    p.out = (float*)d_out; p.ws = (char*)d_ws;
    const int G = 2048;
    auto L = [&](int ph, int l, int grid) { hipLaunchKernelGGL(k_phase, dim3(grid), dim3(NT), 0, stream, p, ph, l); };
    L(PH_LNIN, 0, G);
    for (int l = 0; l < 2; ++l) {
        L(PH_INPROJ, l, G);
        L(PH_ROTARY, l, G);
        L(PH_RETKV, l, 768);
        L(PH_RETSCAN, l, 192);
        L(PH_RETOUT, l, 768);
        L(PH_RWPREP, l, G);
        L(PH_RWSCAN, l, 48);
        L(PH_RWPOST, l, G);
        L(PH_LRUPREP, l, G);
        L(PH_LRULOCAL, l, 128);
        L(PH_LRUCARRY, l, 2);
        L(PH_LRUOUT, l, 128);
        L(PH_OUTPROJ, l, G);
        L(PH_LN1, l, G);
        L(PH_MOE1, l, G);
        L(PH_MOE2, l, G);
        L(PH_LN2, l, G);
    }
}
```

```cpp
#include <hip/hip_runtime.h>
#include <cstdio>
#include <cstdint>

#define DEVI __device__ __forceinline__

constexpr int D = 1024, NBATCH = 2, S = 8192, T = NBATCH * S;
constexpr int INW = 3456;
constexpr int C_RWKV = 1536, C_LRU = 2944;
constexpr int RW = 384;
constexpr int RWSLAB = 1408;
constexpr int LW = 256;
constexpr int NE = 32, DE = 512;
constexpr int NT = 256;
constexpr float ALPHA = 1.4142135623730951f;
constexpr float LN_EPS = 1e-5f;

constexpr size_t al256(size_t x) { return (x + 255) & ~(size_t)255; }
constexpr size_t WS_WINT = 0;
constexpr size_t WS_WOUTT = al256(WS_WINT + (size_t)2 * INW * D * 2);
constexpr size_t WS_WGUT = al256(WS_WOUTT + (size_t)2 * D * D * 2);
constexpr size_t WS_WDT = al256(WS_WGUT + (size_t)NE * 1024 * D * 2);
constexpr size_t WS_ROPE = al256(WS_WDT + (size_t)NE * D * DE * 2);
constexpr size_t WS_HB = al256(WS_ROPE + (size_t)S * 32 * 8);
constexpr size_t WS_PROJ = al256(WS_HB + (size_t)T * D * 2);
constexpr size_t SZ_PROJ = (size_t)T * INW * 2;
constexpr size_t WS_YCAT = al256(WS_PROJ + SZ_PROJ);
constexpr size_t WS_RW = al256(WS_YCAT + (size_t)T * D * 2);
constexpr size_t SZ_RW1 = (size_t)T * RW * 4;
constexpr size_t WS_RWY = al256(WS_RW + 4 * SZ_RW1);
constexpr size_t WS_LA = al256(WS_RWY + SZ_RW1);
constexpr size_t SZ_L1 = (size_t)T * LW * 4;
constexpr size_t WS_LB = al256(WS_LA + SZ_L1);
constexpr size_t WS_KV = al256(WS_LB + SZ_L1);
constexpr size_t SZ_KV = (size_t)NBATCH * 64 * 6 * 4096 * 4;
constexpr size_t WS_PQ = al256(WS_KV + SZ_KV);
constexpr size_t WS_S0 = al256(WS_PQ + (size_t)12 * 64 * 2 * 4096 * 4);
constexpr size_t WS_RS = al256(WS_S0 + (size_t)12 * 64 * 4096 * 4);
constexpr size_t WS_LC = al256(WS_RS + (size_t)T * 6 * 4);
constexpr size_t SZ_LC1 = (size_t)NBATCH * 128 * LW * 4;
constexpr size_t WS_CTL = al256(WS_LC + 3 * SZ_LC1);
constexpr size_t WS_BAR = WS_CTL;
constexpr size_t WS_CNT = WS_CTL + 16384;
constexpr size_t CTL_BYTES = 16384 + 256;
constexpr size_t WS_LIST = al256(WS_CNT + 256);
constexpr size_t WS_TINFO = al256(WS_LIST + (size_t)NE * T * 4);
constexpr size_t WS_TW = al256(WS_TINFO + (size_t)T * 16);
constexpr size_t WS_END = al256(WS_TW + (size_t)T * 8);
constexpr size_t WS_MIX = WS_RW;
constexpr size_t WS_OUT2 = WS_RW;
constexpr size_t WS_X1 = WS_PROJ;
constexpr size_t WS_X1B = WS_PROJ + (size_t)T * D * 4;
constexpr size_t WS_HID = WS_RW + (size_t)2 * T * D * 2;
static_assert(WS_X1B + (size_t)T * D * 2 <= WS_PROJ + SZ_PROJ, "X1/X1b fit in PROJ");
constexpr size_t WS_PT = WS_RW + 3 * SZ_RW1;
static_assert(WS_OUT2 + (size_t)2 * T * D * 4 <= WS_KV, "OUT2 fits in RW..LB");
static_assert(WS_HID + (size_t)2 * T * DE * 2 <= WS_RW + 4 * SZ_RW1, "HID fits in RW");
static_assert(WS_END <= (size_t)536870912, "workspace budget");

typedef unsigned short bf16_t;
typedef short bf16x8 __attribute__((ext_vector_type(8)));
typedef float f32x4 __attribute__((ext_vector_type(4)));
typedef unsigned u32x2 __attribute__((ext_vector_type(2)));
typedef unsigned u32x4 __attribute__((ext_vector_type(4)));
#define LAS __attribute__((address_space(3)))

struct P {
    const float* in[34];
    float* out;
    char* ws;
};

DEVI char* ows(const P& p) { size_t z = 0; asm volatile("" : "+s"(z)); return p.ws + z; }
enum { I_X = 0, I_LNG, I_LNB, I_WIN, I_WOUT, I_MU, I_W0, I_W2, I_A0, I_A2, I_G2, I_KK, I_KA, I_RK, I_GNG, I_GNB,
       I_CW, I_CB, I_WA, I_BA, I_WX, I_BX, I_LAM, I_LN1G, I_LN1B, I_MWG, I_MBG, I_MWE, I_MBE, I_MG, I_MU_, I_MD, I_LN2G, I_LN2B };

DEVI int otid() { int t = threadIdx.x; asm volatile("" : "+v"(t)); return t; }
DEVI int obid() { int b = blockIdx.x; asm volatile("" : "+s"(b)); return b; }
struct P;
template <int CTRL> DEVI float dpp_mov(float v) { return __builtin_bit_cast(float, __builtin_amdgcn_update_dpp(0, __builtin_bit_cast(int, v), CTRL, 0xF, 0xF, true)); }
DEVI float red16(float x) {
    x += dpp_mov<0xB1>(x);
    x += dpp_mov<0x4E>(x);
    x += dpp_mov<0x141>(x);
    x += dpp_mov<0x140>(x);
    return x;
}
DEVI float wave_sum(float v) {
    v = red16(v);
    const float r0 = __builtin_bit_cast(float, __builtin_amdgcn_readlane(__builtin_bit_cast(int, v), 0));
    const float r1 = __builtin_bit_cast(float, __builtin_amdgcn_readlane(__builtin_bit_cast(int, v), 16));
    const float r2 = __builtin_bit_cast(float, __builtin_amdgcn_readlane(__builtin_bit_cast(int, v), 32));
    const float r3 = __builtin_bit_cast(float, __builtin_amdgcn_readlane(__builtin_bit_cast(int, v), 48));
    return (r0 + r1) + (r2 + r3);
}
DEVI float fexp(float x) { return __builtin_amdgcn_exp2f(x * 1.4426950408889634f); }
DEVI float frcp(float x) { return __builtin_amdgcn_rcpf(x); }
DEVI float sigmoidf_(float x) { return frcp(1.f + fexp(-x)); }
DEVI float siluf_(float x) { return x * frcp(1.f + fexp(-x)); }
DEVI float softplusf_(float x) { return fmaxf(x, 0.f) + __builtin_amdgcn_logf(1.f + fexp(-fabsf(x))) * 0.6931471805599453f; }
DEVI float ftanh(float x) { const float e = fexp(-2.f * fabsf(x)); const float t = (1.f - e) * frcp(1.f + e); return x < 0.f ? -t : t; }
DEVI float gelu_tanh(float x) { return 0.5f * x * (1.f + ftanh(0.7978845608028654f * (x + 0.044715f * x * x * x))); }
typedef __bf16 bf16v2 __attribute__((ext_vector_type(2)));
typedef float f32v2 __attribute__((ext_vector_type(2)));
DEVI unsigned pk2(float lo, float hi) { const f32v2 f = {lo, hi}; return __builtin_bit_cast(unsigned, __builtin_convertvector(f, bf16v2)); }
DEVI unsigned f2bf(float f) { return pk2(f, 0.f) & 0xffffu; }
DEVI float bf2f(bf16_t x) { return __uint_as_float((unsigned)x << 16); }
DEVI float bflo(unsigned u) { return __uint_as_float(u << 16); }
DEVI float bfhi(unsigned u) { return __uint_as_float(u & 0xffff0000u); }
__device__ const double LOGG[6] = {-0.0317486983145803, -0.015748356968139168, -0.007843177461025893,
                                   -0.003913899321136329, -0.0019550348358033506, -0.0009770396478266127};

DEVI void rope_sincos(int s, int i, float& sn, float& cs) {
    double inv = 1.0;
    for (int q = 0; q < i; ++q) inv *= 0.7498942093324559;
    const double ang = (double)s * inv;
    const double n = rint(ang * 0.6366197723675814);
    const double r = fma(-n, 1.5707963267948966, ang);
    const int q = (int)(((long long)n) & 3);
    const double r2 = r * r;
    const double sp = r * (1.0 + r2 * (-1.0 / 6 + r2 * (1.0 / 120 + r2 * (-1.0 / 5040 + r2 * (1.0 / 362880 + r2 * (-1.0 / 39916800))))));
    const double cp = 1.0 + r2 * (-0.5 + r2 * (1.0 / 24 + r2 * (-1.0 / 720 + r2 * (1.0 / 40320 + r2 * (-1.0 / 3628800 + r2 * (1.0 / 479001600))))));
    double s_, c_;
    if (q == 0) { s_ = sp; c_ = cp; } else if (q == 1) { s_ = cp; c_ = -sp; } else if (q == 2) { s_ = -sp; c_ = -cp; } else { s_ = -cp; c_ = sp; }
    sn = (float)s_; cs = (float)c_;
}

DEVI float4 ld4bf(const bf16_t* p) { const u32x2 u = *(const u32x2*)p; return make_float4(bflo(u.x), bfhi(u.x), bflo(u.y), bfhi(u.y)); }
template <bool ABF>
DEVI void ln_row(const void* a, float alpha, const bf16_t* m, const bf16_t* o0, float w0, const bf16_t* o1, float w1,
                 const float* g, const float* bb, float4 (&v)[4], int lane) {
    float s = 0.f;
#pragma unroll
    for (int j = 0; j < 4; ++j) {
        const int e = (j * 64 + lane) * 4;
        float4 x = ABF ? ld4bf((const bf16_t*)a + e) : *(const float4*)((const float*)a + e);
        x.x *= alpha; x.y *= alpha; x.z *= alpha; x.w *= alpha;
        if (m) { const float4 y = ld4bf(m + e); x.x += y.x; x.y += y.y; x.z += y.z; x.w += y.w; }
        if (o0) {
            const float4 y0 = ld4bf(o0 + e); const float4 y1 = ld4bf(o1 + e);
            x.x += w0 * y0.x + w1 * y1.x; x.y += w0 * y0.y + w1 * y1.y; x.z += w0 * y0.z + w1 * y1.z; x.w += w0 * y0.w + w1 * y1.w;
        }
        v[j] = x; s += (x.x + x.y) + (x.z + x.w);
    }
    const float mean = wave_sum(s) * (1.f / D);
    float q = 0.f;
#pragma unroll
    for (int j = 0; j < 4; ++j) {
        v[j].x -= mean; v[j].y -= mean; v[j].z -= mean; v[j].w -= mean;
        q += (v[j].x * v[j].x + v[j].y * v[j].y) + (v[j].z * v[j].z + v[j].w * v[j].w);
    }
    const float rstd = 1.f / sqrtf(wave_sum(q) * (1.f / D) + LN_EPS);
#pragma unroll
    for (int j = 0; j < 4; ++j) {
        const int e = (j * 64 + lane) * 4;
        const float4 gg = *(const float4*)(g + e); const float4 b4 = *(const float4*)(bb + e);
        v[j].x = v[j].x * rstd * gg.x + b4.x; v[j].y = v[j].y * rstd * gg.y + b4.y;
        v[j].z = v[j].z * rstd * gg.z + b4.z; v[j].w = v[j].w * rstd * gg.w + b4.w;
    }
}
DEVI void store_row(float* o, const float4 (&v)[4], int lane) {
#pragma unroll
    for (int j = 0; j < 4; ++j) *(float4*)(o + (j * 64 + lane) * 4) = v[j];
}

DEVI void store_row_bf(bf16_t* o, const float4 (&v)[4], int lane) {
#pragma unroll
    for (int j = 0; j < 4; ++j) { u32x2 w; w.x = pk2(v[j].x, v[j].y); w.y = pk2(v[j].z, v[j].w); *(u32x2*)(o + (j * 64 + lane) * 4) = w; }
}

DEVI void ph_ln_in(const P& p) {
    const int tid = otid(), lane = tid & 63;
    const int gw = (obid() * NT + tid) >> 6, nw = gridDim.x * (NT / 64);
    char* ws = ows(p);
    bf16_t* hb = (bf16_t*)(ws + WS_HB);
    for (int row = gw; row < T; row += nw) {
        float4 v[4];
        ln_row<false>(p.in[I_X] + (size_t)row * D, 1.f, nullptr, nullptr, 0.f, nullptr, 0.f, p.in[I_LNG], p.in[I_LNB], v, lane);
        store_row_bf(hb + (size_t)row * D, v, lane);
    }
    float2* rope = (float2*)(ws + WS_ROPE);
    for (int idx = obid() * NT + tid; idx < S * 32; idx += gridDim.x * NT) {
        float sn, cs; rope_sincos(idx >> 5, idx & 31, sn, cs);
        rope[idx] = make_float2(cs, sn);
    }
}

DEVI void tr_tile(float* sm, const float* W, int N, int k0, int n0, bf16_t* dst, int K, int map) {
    const int tid = otid();
    __syncthreads();
    float4 v[8];
#pragma unroll
    for (int i = 0; i < 8; ++i) {
        const int k = (tid >> 4) + i * 16, n4 = (tid & 15) * 4;
        v[i] = *(const float4*)(W + (size_t)(k0 + k) * N + n0 + n4);
    }
#pragma unroll
    for (int i = 0; i < 8; ++i) {
        const int k = (tid >> 4) + i * 16, n4 = (tid & 15) * 4;
        sm[k * 65 + n4] = v[i].x; sm[k * 65 + n4 + 1] = v[i].y; sm[k * 65 + n4 + 2] = v[i].z; sm[k * 65 + n4 + 3] = v[i].w;
    }
    __syncthreads();
    const int nl = tid >> 2, kq = (tid & 3) * 32;
    const int n = n0 + nl;
    const int row = map == 0 ? n : (64 * (n >> 5) + (n & 31) + (map == 2 ? 32 : 0));
    const float* c = sm + kq * 65 + nl;
    bf16_t* d = dst + (size_t)row * K + k0 + kq;
#pragma unroll
    for (int g = 0; g < 4; ++g) {
        u32x4 o;
        o.x = pk2(c[(g * 8 + 0) * 65], c[(g * 8 + 1) * 65]); o.y = pk2(c[(g * 8 + 2) * 65], c[(g * 8 + 3) * 65]);
        o.z = pk2(c[(g * 8 + 4) * 65], c[(g * 8 + 5) * 65]); o.w = pk2(c[(g * 8 + 6) * 65], c[(g * 8 + 7) * 65]);
        *(u32x4*)(d + g * 8) = o;
    }
}
DEVI void ph_wprep_dense(const P& p, float* sm) {
    char* ws = ows(p);
    constexpr int TI = (D / 128) * (INW / 64), TO = (D / 128) * (D / 64);
    for (int q = obid(); q < 2 * (TI + TO); q += gridDim.x) {
        int r = q; const int l = r / (TI + TO); r -= l * (TI + TO);
        if (r < TI) { const int kb = r / (INW / 64), nb = r % (INW / 64);
            tr_tile(sm, p.in[I_WIN] + (size_t)l * D * INW, INW, kb * 128, nb * 64, (bf16_t*)(ws + WS_WINT) + (size_t)l * INW * D, D, 0); }
        else { r -= TI; const int kb = r / (D / 64), nb = r % (D / 64);
            tr_tile(sm, p.in[I_WOUT] + (size_t)l * D * D, D, kb * 128, nb * 64, (bf16_t*)(ws + WS_WOUTT) + (size_t)l * D * D, D, 0); }
    }
}
DEVI void ph_wprep_moe(const P& p, int l, float* sm, int b0) {
    char* ws = ows(p);
    constexpr int TG = (D / 128) * (DE / 64), TD_ = (DE / 128) * (D / 64);
    const int nbk = gridDim.x - b0;
    if (obid() < b0) return;
    for (int q = obid() - b0; q < NE * (2 * TG + TD_); q += nbk) {
        const int e = q / (2 * TG + TD_); int r = q - e * (2 * TG + TD_);
        if (r < 2 * TG) { const int up = r >= TG; if (up) r -= TG; const int kb = r / (DE / 64), nb = r % (DE / 64);
            tr_tile(sm, p.in[up ? I_MU_ : I_MG] + ((size_t)(l * NE + e)) * D * DE, DE, kb * 128, nb * 64,
                    (bf16_t*)(ws + WS_WGUT) + (size_t)e * 1024 * D, D, up ? 2 : 1); }
        else { r -= 2 * TG; const int kb = r / (D / 64), nb = r % (D / 64);
            tr_tile(sm, p.in[I_MD] + ((size_t)(l * NE + e)) * DE * D, D, kb * 128, nb * 64,
                    (bf16_t*)(ws + WS_WDT) + (size_t)e * D * DE, DE, 0); }
    }
}

DEVI void gemm128_core(LAS char* lds, const bf16_t* A, int lda, const int* rowidx, int mvalid,
                       const bf16_t* Bt, int ldb, int K, f32x4 (&acc)[4][4]) {
    const int tid = otid(), lane = tid & 63, wid = tid >> 6, wr = wid >> 1, wc = wid & 1, fr = lane & 15, fq = lane >> 4;
    const int srow = tid >> 3, sch = tid & 7;
    const bf16_t* ap[4]; const bf16_t* bp[4];
#pragma unroll
    for (int i = 0; i < 4; ++i) {
        const int r = srow + i * 32;
        const int rr = r < mvalid ? r : 0;
        const int ri = rowidx ? rowidx[rr] : rr;
        const int c = sch ^ ((r >> 1) & 7);
        ap[i] = A + (size_t)ri * lda + c * 8;
        bp[i] = Bt + (size_t)r * ldb + c * 8;
    }
#pragma unroll
    for (int m = 0; m < 4; ++m)
#pragma unroll
        for (int n = 0; n < 4; ++n) acc[m][n] = (f32x4){0.f, 0.f, 0.f, 0.f};
    const int nt = K >> 6;
    const int sw = (fr >> 1) & 7;
    const int aoff = (wr * 64 + fr) * 128, boff = 16384 + (wc * 64 + fr) * 128;
#define GSTAGE(kt, buf) do { _Pragma("unroll") for (int _i = 0; _i < 4; ++_i) { \
        __builtin_amdgcn_global_load_lds((const unsigned*)(ap[_i] + (kt) * 64), (LAS unsigned*)(lds + (buf) * 32768 + tid * 16 + _i * 4096), 16, 0, 0); \
        __builtin_amdgcn_global_load_lds((const unsigned*)(bp[_i] + (kt) * 64), (LAS unsigned*)(lds + (buf) * 32768 + 16384 + tid * 16 + _i * 4096), 16, 0, 0); } } while (0)
    GSTAGE(0, 0);
    for (int kt = 0; kt < nt; ++kt) {
        asm volatile("s_waitcnt vmcnt(0)" ::: "memory");
        __syncthreads();
        if (kt + 1 < nt) GSTAGE(kt + 1, (kt + 1) & 1);
        const LAS char* base = lds + (kt & 1) * 32768;
#pragma unroll
        for (int kk = 0; kk < 2; ++kk) {
            bf16x8 af[4], bfr[4];
            const int co = (((kk * 4 + fq) ^ sw) * 16);
#pragma unroll
            for (int m = 0; m < 4; ++m) af[m] = *(const LAS bf16x8*)(base + aoff + m * 2048 + co);
#pragma unroll
            for (int n = 0; n < 4; ++n) bfr[n] = *(const LAS bf16x8*)(base + boff + n * 2048 + co);
            __builtin_amdgcn_s_setprio(1);
#pragma unroll
            for (int m = 0; m < 4; ++m)
#pragma unroll
                for (int n = 0; n < 4; ++n) acc[m][n] = __builtin_amdgcn_mfma_f32_16x16x32_bf16(bfr[n], af[m], acc[m][n], 0, 0, 0);
            __builtin_amdgcn_s_setprio(0);
        }
    }
#undef GSTAGE
}

DEVI int vblock() { const int g = gridDim.x, b = obid(); return (g & 7) == 0 ? (b & 7) * (g >> 3) + (b >> 3) : b; }
DEVI void ph_inproj(const P& p, int l, float* sm) {
    char* ws = ows(p);
    const bf16_t* hb = (const bf16_t*)(ws + WS_HB);
    const bf16_t* wt = (const bf16_t*)(ws + WS_WINT) + (size_t)l * INW * D;
    bf16_t* proj = (bf16_t*)(ws + WS_PROJ);
    const float2* rope = (const float2*)(ws + WS_ROPE);
    const int tid = otid(), lane = tid & 63, wid = tid >> 6, wr = wid >> 1, wc = wid & 1, fr = lane & 15, fq = lane >> 4;
    constexpr int TN = INW / 128;
    for (int q = vblock(); q < (T / 128) * TN; q += gridDim.x) {
        int mi, ni;
        if (q < 3 * 1024) { const int nbk = q >> 10, w = q & 1023, t = w & 63; mi = (w >> 6) * 8 + (t >> 3); ni = nbk * 8 + (t & 7); }
        else { const int q2 = q - 3 * 1024; mi = q2 / 3; ni = 24 + q2 % 3; }
        f32x4 acc[4][4];
        gemm128_core((LAS char*)sm, hb + (size_t)mi * 128 * D, D, nullptr, 128, wt + (size_t)ni * 128 * D, D, D, acc);
        const int colw = ni * 128 + wc * 64;
#pragma unroll
        for (int m = 0; m < 4; ++m) {
            const int row = mi * 128 + wr * 64 + m * 16 + fr;
            if (colw < 768) {
                const float sc = colw >= 384 ? 0.125f : 1.f;
                const float2* rp = rope + (size_t)(row & (S - 1)) * 32 + fq * 4;
#pragma unroll
                for (int n = 0; n < 2; ++n)
#pragma unroll
                    for (int r = 0; r < 4; ++r) {
                        const float2 cs = rp[n * 16 + r];
                        const float x1 = acc[m][n][r], x2 = acc[m][n + 2][r];
                        acc[m][n][r] = (x1 * cs.x - x2 * cs.y) * sc;
                        acc[m][n + 2][r] = (x1 * cs.y + x2 * cs.x) * sc;
                    }
            }
            bf16_t* o = proj + (size_t)row * INW + colw + fq * 4;
#pragma unroll
            for (int n = 0; n < 4; ++n) { u32x2 w; w.x = pk2(acc[m][n][0], acc[m][n][1]); w.y = pk2(acc[m][n][2], acc[m][n][3]); *(u32x2*)(o + n * 16) = w; }
        }
    }
}

DEVI void ph_outproj(const P& p, int l, float* sm) {
    char* ws = ows(p);
    const bf16_t* yc = (const bf16_t*)(ws + WS_YCAT);
    const bf16_t* wt = (const bf16_t*)(ws + WS_WOUTT) + (size_t)l * D * D;
    bf16_t* mix = (bf16_t*)(ws + WS_MIX);
    const int tid = otid(), lane = tid & 63, wid = tid >> 6, wr = wid >> 1, wc = wid & 1, fr = lane & 15, fq = lane >> 4;
    for (int q = vblock(); q < (T / 128) * 8; q += gridDim.x) {
        const int mi = q >> 3, ni = q & 7;
        f32x4 acc[4][4];
        gemm128_core((LAS char*)sm, yc + (size_t)mi * 128 * D, D, nullptr, 128, wt + (size_t)ni * 128 * D, D, D, acc);
#pragma unroll
        for (int m = 0; m < 4; ++m) {
            bf16_t* o = mix + (size_t)(mi * 128 + wr * 64 + m * 16 + fr) * D + ni * 128 + wc * 64 + fq * 4;
#pragma unroll
            for (int n = 0; n < 4; ++n) { u32x2 w; w.x = pk2(acc[m][n][0], acc[m][n][1]); w.y = pk2(acc[m][n][2], acc[m][n][3]); *(u32x2*)(o + n * 16) = w; }
        }
    }
}

DEVI void ld8bf(const bf16_t* src, float* dst) {
    const u32x4 u = *(const u32x4*)src;
    dst[0] = bflo(u.x); dst[1] = bfhi(u.x); dst[2] = bflo(u.y); dst[3] = bfhi(u.y);
    dst[4] = bflo(u.z); dst[5] = bfhi(u.z); dst[6] = bflo(u.w); dst[7] = bfhi(u.w);
}
DEVI bf16x8 pack8(const float* v) {
    u32x4 u; u.x = pk2(v[0], v[1]); u.y = pk2(v[2], v[3]); u.z = pk2(v[4], v[5]); u.w = pk2(v[6], v[7]);
    return __builtin_bit_cast(bf16x8, u);
}
DEVI void ret_stage_rows(LAS char* img, const bf16_t* proj, size_t tok0, int col0, float logg, int mode, int tid) {
#pragma unroll
    for (int i = 0; i < 4; ++i) {
        const int idx = tid + i * 256, row = idx >> 3, ch = idx & 7;
        float v[8];
        ld8bf(proj + (tok0 + row) * INW + col0 + ch * 8, v);
        const float sc = fexp((mode == 0 ? (float)row : -(float)row) * logg);
#pragma unroll
        for (int j = 0; j < 8; ++j) v[j] *= sc;
        *(LAS bf16x8*)(img + row * 128 + ((ch ^ ((row >> 1) & 7)) * 16)) = pack8(v);
    }
}
DEVI void ret_stage_T(LAS char* img, const bf16_t* proj, size_t tok0, int col0, float logg, int mode, int tid) {
#pragma unroll
    for (int i = 0; i < 4; ++i) {
        const int idx = tid + i * 256, tok = idx >> 3, ch = idx & 7;
        float v[8];
        ld8bf(proj + (tok0 + tok) * INW + col0 + ch * 8, v);
        const float sc = mode == 2 ? fexp((float)(127 - tok) * logg) : 1.f;
        const int ck = (tok >> 5) * 4 + ((tok >> 2) & 3), jj = ((tok >> 4) & 1) * 4 + (tok & 3);
#pragma unroll
        for (int j = 0; j < 8; ++j) {
            const int e = ch * 8 + j;
            *(LAS bf16_t*)(img + e * 256 + ((ck ^ (e & 15)) * 16) + jj * 2) = (bf16_t)f2bf(v[j] * sc);
        }
    }
}
DEVI bf16x8 frag_row(const LAS char* img, int row, int kk, int fq) { return *(const LAS bf16x8*)(img + row * 128 + (((kk * 4 + fq) ^ ((row >> 1) & 7)) * 16)); }
DEVI bf16x8 frag_T(const LAS char* img, int e, int kp, int fq) { return *(const LAS bf16x8*)(img + e * 256 + (((kp * 4 + fq) ^ (e & 15)) * 16)); }

DEVI void ph_ret_kv(const P& p, float* sm, int b0) {
    char* ws = ows(p);
    const bf16_t* proj = (const bf16_t*)(ws + WS_PROJ);
    float* kv = (float*)(ws + WS_KV);
    LAS char* lds = (LAS char*)sm;
    const int tid = otid(), lane = tid & 63, wid = tid >> 6, fr = lane & 15, fq = lane >> 4;
    if (obid() < b0) return;
    for (int item = obid() - b0; item < NBATCH * 64 * 6; item += gridDim.x - b0) {
        const int h = item % 6, n = (item / 6) % 64, b = item / 384;
        const float logg = (float)LOGG[h];
        const size_t tok0 = (size_t)b * S + n * 128;
        __syncthreads();
        ret_stage_T(lds, proj, tok0, 768 + h * 64, logg, 0, tid);
        ret_stage_T(lds + 16384, proj, tok0, 384 + h * 64, logg, 2, tid);
        __syncthreads();
        f32x4 acc[4];
#pragma unroll
        for (int dt = 0; dt < 4; ++dt) acc[dt] = (f32x4){0.f, 0.f, 0.f, 0.f};
#pragma unroll
        for (int kk = 0; kk < 4; ++kk) {
            const bf16x8 av = frag_T(lds, wid * 16 + fr, kk, fq);
#pragma unroll
            for (int dt = 0; dt < 4; ++dt) acc[dt] = __builtin_amdgcn_mfma_f32_16x16x32_bf16(av, frag_T(lds + 16384, dt * 16 + fr, kk, fq), acc[dt], 0, 0, 0);
        }
        float* o = kv + (size_t)item * 4096;
#pragma unroll
        for (int dt = 0; dt < 4; ++dt)
#pragma unroll
            for (int r = 0; r < 4; ++r) o[(wid * 16 + fq * 4 + r) * 64 + dt * 16 + fr] = acc[dt][r];
    }
}

DEVI void ph_ret_scan(const P& p) {
    float* kv = (float*)(ows(p) + WS_KV);
    const int total = NBATCH * 6 * 4096;
    for (int idx = obid() * NT + otid(); idx < total; idx += gridDim.x * NT) {
        const int de = idx & 4095, bh = idx >> 12, h = bh % 6, b = bh / 6;
        const float g = expf(128.f * (float)LOGG[h]);
        float st = 0.f;
        float* base = kv + ((size_t)(b * 64) * 6 + h) * 4096 + de;
        for (int n0 = 0; n0 < 64; n0 += 16) {
            float x[16];
#pragma unroll
            for (int j = 0; j < 16; ++j) x[j] = base[(size_t)(n0 + j) * 6 * 4096];
#pragma unroll
            for (int j = 0; j < 16; ++j) { const float xv = x[j]; x[j] = st; st = st * g + xv; }
#pragma unroll
            for (int j = 0; j < 16; ++j) base[(size_t)(n0 + j) * 6 * 4096] = x[j];
        }
    }
}

DEVI void ph_ret_out(const P& p, float* sm, int b0) {
    char* ws = ows(p);
    const bf16_t* proj = (const bf16_t*)(ws + WS_PROJ);
    const float* kv = (const float*)(ws + WS_KV);
    bf16_t* ycat = (bf16_t*)(ws + WS_YCAT);
    LAS char* lds = (LAS char*)sm;
    const LAS char* qs = lds; const LAS char* ks = lds + 16384; const LAS char* vt = lds + 32768;
    const int tid = otid(), lane = tid & 63, wid = tid >> 6, fr = lane & 15, fq = lane >> 4;
    if (obid() < b0) return;
    for (int item = obid() - b0; item < NBATCH * 64 * 6; item += gridDim.x - b0) {
        const int h = item % 6, n = (item / 6) % 64, b = item / 384;
        const float logg = (float)LOGG[h];
        const float gam = expf(logg);
        const size_t tok0 = (size_t)b * S + n * 128;
        __syncthreads();
        ret_stage_rows(lds, proj, tok0, h * 64, logg, 0, tid);
        ret_stage_rows(lds + 16384, proj, tok0, 384 + h * 64, logg, 1, tid);
        ret_stage_T(lds + 32768, proj, tok0, 768 + h * 64, logg, 0, tid);
        __syncthreads();
        const float* prevT = kv + (size_t)item * 4096;
#pragma unroll 1
        for (int qi = 0; qi < 2; ++qi) {
            const int qt = qi == 0 ? wid : 7 - wid;
            bf16x8 bq[2];
            bq[0] = frag_row(qs, qt * 16 + fr, 0, fq); bq[1] = frag_row(qs, qt * 16 + fr, 1, fq);
            f32x4 acc[4];
#pragma unroll
            for (int et = 0; et < 4; ++et) acc[et] = (f32x4){0.f, 0.f, 0.f, 0.f};
#pragma unroll
            for (int et = 0; et < 4; ++et)
#pragma unroll
                for (int kk = 0; kk < 2; ++kk) {
                    const float* src = prevT + (et * 16 + fr) * 64 + kk * 32 + fq * 8;
                    const float4 x0 = *(const float4*)src, x1 = *(const float4*)(src + 4);
                    const float v8[8] = {x0.x, x0.y, x0.z, x0.w, x1.x, x1.y, x1.z, x1.w};
                    acc[et] = __builtin_amdgcn_mfma_f32_16x16x32_bf16(pack8(v8), bq[kk], acc[et], 0, 0, 0);
                }
#pragma unroll
            for (int et = 0; et < 4; ++et) acc[et] = acc[et] * gam;
            for (int kp = 0; kp <= (qt >> 1); ++kp) {
                float pv[8];
#pragma unroll
                for (int a = 0; a < 2; ++a) {
                    const int kt = 2 * kp + a;
                    f32x4 sT = (f32x4){0.f, 0.f, 0.f, 0.f};
                    if (kt <= qt) {
                        sT = __builtin_amdgcn_mfma_f32_16x16x32_bf16(frag_row(ks, kt * 16 + fr, 0, fq), bq[0], sT, 0, 0, 0);
                        sT = __builtin_amdgcn_mfma_f32_16x16x32_bf16(frag_row(ks, kt * 16 + fr, 1, fq), bq[1], sT, 0, 0, 0);
                        if (kt == qt) {
#pragma unroll
                            for (int r = 0; r < 4; ++r) if (fq * 4 + r > fr) sT[r] = 0.f;
                        }
                    }
                    pv[a * 4 + 0] = sT[0]; pv[a * 4 + 1] = sT[1]; pv[a * 4 + 2] = sT[2]; pv[a * 4 + 3] = sT[3];
                }
                const bf16x8 pf = pack8(pv);
#pragma unroll
                for (int et = 0; et < 4; ++et)
                    acc[et] = __builtin_amdgcn_mfma_f32_16x16x32_bf16(frag_T(vt, et * 16 + fr, kp, fq), pf, acc[et], 0, 0, 0);
            }
            float sum = 0.f;
#pragma unroll
            for (int et = 0; et < 4; ++et) sum += (acc[et][0] + acc[et][1]) + (acc[et][2] + acc[et][3]);
            sum += __shfl_xor(sum, 16); sum += __shfl_xor(sum, 32);
            const float mean = sum * (1.f / 64.f);
            float var = 0.f;
#pragma unroll
            for (int et = 0; et < 4; ++et) { acc[et] = acc[et] - mean; var += (acc[et][0] * acc[et][0] + acc[et][1] * acc[et][1]) + (acc[et][2] * acc[et][2] + acc[et][3] * acc[et][3]); }
            var += __shfl_xor(var, 16); var += __shfl_xor(var, 32);
            const float rstd = 1.f / sqrtf(var * (1.f / 64.f) + LN_EPS);
            const size_t tok = tok0 + qt * 16 + fr;
#pragma unroll
            for (int et = 0; et < 4; ++et) {
                const u32x2 gu = *(const u32x2*)(proj + tok * INW + 1152 + h * 64 + et * 16 + fq * 4);
                const float g0 = bflo(gu.x), g1 = bfhi(gu.x), g2 = bflo(gu.y), g3 = bfhi(gu.y);
                u32x2 w;
                w.x = pk2(acc[et][0] * rstd * siluf_(g0), acc[et][1] * rstd * siluf_(g1));
                w.y = pk2(acc[et][2] * rstd * siluf_(g2), acc[et][3] * rstd * siluf_(g3));
                *(u32x2*)(ycat + tok * D + h * 64 + et * 16 + fq * 4) = w;
            }
        }
    }
}

constexpr int RC = 128, NCH = S / RC;

DEVI float zmix(const bf16_t* pc, int s, int col, const float* mu) {
    const float c = bf2f(pc[col]);
    const float pv = s > 0 ? bf2f(pc[col - INW]) : 0.f;
    return c + (pv - c) * mu[col];
}
DEVI void zmix8(const bf16_t* pc, int s, int col, const float* mu, float* z) {
    float c[8], pv[8];
    ld8bf(pc + col, c);
    if (s > 0) ld8bf(pc + col - INW, pv);
    else {
#pragma unroll
        for (int j = 0; j < 8; ++j) pv[j] = 0.f;
    }
    const float4 m0 = *(const float4*)(mu + col), m1 = *(const float4*)(mu + col + 4);
    const float m[8] = {m0.x, m0.y, m0.z, m0.w, m1.x, m1.y, m1.z, m1.w};
#pragma unroll
    for (int j = 0; j < 8; ++j) z[j] = c[j] + (pv[j] - c[j]) * m[j];
}
DEVI float quad_sum(float x) { x += dpp_mov<0xB1>(x); x += dpp_mov<0x4E>(x); return x; }

DEVI void ph_rwkv_prep(const P& p, int l, float* sm) {
    char* ws = ows(p);
    const bf16_t* proj = (const bf16_t*)(ws + WS_PROJ);
    float* rw = (float*)(ws + WS_RW);
    float* rs = (float*)(ws + WS_RS);
    const size_t A1 = (size_t)T * RW;
    const float* mu = p.in[I_MU] + l * RWSLAB;
    const float* w0 = p.in[I_W0] + l * RW; const float* w2 = p.in[I_W2] + (size_t)l * 64 * RW;
    const float* a0 = p.in[I_A0] + l * RW; const float* a2 = p.in[I_A2] + (size_t)l * 64 * RW;
    const float* k_k = p.in[I_KK] + l * RW; const float* k_a = p.in[I_KA] + l * RW; const float* r_k = p.in[I_RK] + l * RW;
    const int tid = otid(), tau = tid >> 2, cq = tid & 3;
    float* zx = sm;
    float* wx = sm + 4160;
    for (int item = obid(); item < (T / 64) * 6; item += gridDim.x) {
        const int h = item % 6, tile = item / 6;
        const int t = tile * 64 + tau, s = t & (S - 1);
        const int hc = h * 64 + cq * 16;
        float u[16], av[16];
#pragma unroll
        for (int pass = 0; pass < 2; ++pass) {
            __syncthreads();
            for (int i = tid; i < 512; i += NT) {
                const int tt = i >> 3, j8 = (i & 7) * 8;
                const int t2 = tile * 64 + tt;
                float z[8];
                zmix8(proj + (size_t)t2 * INW + C_RWKV, t2 & (S - 1), (pass == 0 ? 1152 : 1216) + j8, mu, z);
#pragma unroll
                for (int j = 0; j < 8; ++j) zx[tt * 65 + j8 + j] = pass == 0 ? ftanh(z[j]) : z[j];
            }
            const float* wsrc = pass == 0 ? w2 : a2;
            for (int i = tid; i < 1024; i += NT) {
                const int j = i >> 4, c4 = (i & 15) * 4;
                *(float4*)(wx + j * 64 + c4) = *(const float4*)(wsrc + (size_t)j * RW + h * 64 + c4);
            }
            __syncthreads();
            float acc[16];
#pragma unroll
            for (int cc = 0; cc < 16; ++cc) acc[cc] = 0.f;
#pragma unroll 4
            for (int j = 0; j < 64; ++j) {
                const float zv = zx[tau * 65 + j];
#pragma unroll
                for (int c4 = 0; c4 < 4; ++c4) {
                    const float4 w4 = *(const float4*)(wx + j * 64 + cq * 16 + c4 * 4);
                    acc[c4 * 4] += zv * w4.x; acc[c4 * 4 + 1] += zv * w4.y; acc[c4 * 4 + 2] += zv * w4.z; acc[c4 * 4 + 3] += zv * w4.w;
                }
            }
#pragma unroll
            for (int cc = 0; cc < 16; ++cc) { if (pass == 0) u[cc] = acc[cc]; else av[cc] = acc[cc]; }
        }
        const bf16_t* pc = proj + (size_t)t * INW + C_RWKV;
        float kr[16], rr[16];
        zmix8(pc, s, 384 + hc, mu, kr); zmix8(pc, s, 384 + hc + 8, mu, kr + 8);
        zmix8(pc, s, hc, mu, rr); zmix8(pc, s, hc + 8, mu, rr + 8);
        float kk[16], n2 = 0.f, rsum = 0.f;
        float dec[16], nb[16], km[16];
#pragma unroll
        for (int cc = 0; cc < 16; ++cc) {
            const int c = hc + cc;
            const float wl = -softplusf_(-(u[cc] + w0[c])) - 0.5f;
            dec[cc] = fexp(-fexp(wl));
            const float a = sigmoidf_(av[cc] + a0[c]);
            kk[cc] = kr[cc] * k_k[c];
            n2 += kk[cc] * kk[cc];
            km[cc] = kr[cc] * (1.f + (a - 1.f) * k_a[c]);
            rsum += rr[cc] * km[cc] * r_k[c];
            av[cc] = a;
        }
        n2 = quad_sum(n2); rsum = quad_sum(rsum);
        const float inv = 1.f / fmaxf(sqrtf(n2), 1e-12f);
#pragma unroll
        for (int cc = 0; cc < 16; ++cc) { kk[cc] *= inv; nb[cc] = -kk[cc] * av[cc]; }
        const size_t o = (size_t)t * RW + hc;
        bf16_t* rwb = (bf16_t*)(rw + A1);
#pragma unroll
        for (int c4 = 0; c4 < 4; ++c4)
            *(float4*)(rw + o + c4 * 4) = make_float4(dec[c4 * 4], dec[c4 * 4 + 1], dec[c4 * 4 + 2], dec[c4 * 4 + 3]);
        *(bf16x8*)(rwb + 0 * A1 + o) = pack8(kk); *(bf16x8*)(rwb + 0 * A1 + o + 8) = pack8(kk + 8);
        *(bf16x8*)(rwb + 1 * A1 + o) = pack8(nb); *(bf16x8*)(rwb + 1 * A1 + o + 8) = pack8(nb + 8);
        *(bf16x8*)(rwb + 2 * A1 + o) = pack8(km); *(bf16x8*)(rwb + 2 * A1 + o + 8) = pack8(km + 8);
        if (cq == 0) rs[(size_t)t * 6 + h] = rsum;
    }
}

struct RwOps { float4 kk, w, nb, k, r; float v0, v1, v2, v3; };
DEVI void rw_load(RwOps& o, const float* sm, const float* smV, int tt, int kq, int rl) {
    o.kk = *(const float4*)(sm + 0 * 2048 + tt * 64 + kq * 4);
    o.w = *(const float4*)(sm + 1 * 2048 + tt * 64 + kq * 4);
    o.nb = *(const float4*)(sm + 2 * 2048 + tt * 64 + kq * 4);
    o.k = *(const float4*)(sm + 3 * 2048 + tt * 64 + kq * 4);
    o.r = *(const float4*)(sm + 4 * 2048 + tt * 64 + kq * 4);
    o.v0 = smV[tt * 64 + rl]; o.v1 = smV[tt * 64 + 16 + rl]; o.v2 = smV[tt * 64 + 32 + rl]; o.v3 = smV[tt * 64 + 48 + rl];
}
DEVI float dot4(const float4& a, const float4& b) { return (a.x * b.x + a.y * b.y) + (a.z * b.z + a.w * b.w); }
DEVI void upd4(float4& s, const RwOps& o, float d, float vv) {
    s.x = s.x * o.w.x + d * o.nb.x + vv * o.k.x; s.y = s.y * o.w.y + d * o.nb.y + vv * o.k.y;
    s.z = s.z * o.w.z + d * o.nb.z + vv * o.k.z; s.w = s.w * o.w.w + d * o.nb.w + vv * o.k.w;
}
#define RED16x4(a, b, c, d) do { \
    a += dpp_mov<0xB1>(a); b += dpp_mov<0xB1>(b); c += dpp_mov<0xB1>(c); d += dpp_mov<0xB1>(d); \
    a += dpp_mov<0x4E>(a); b += dpp_mov<0x4E>(b); c += dpp_mov<0x4E>(c); d += dpp_mov<0x4E>(d); \
    a += dpp_mov<0x141>(a); b += dpp_mov<0x141>(b); c += dpp_mov<0x141>(c); d += dpp_mov<0x141>(d); \
    a += dpp_mov<0x140>(a); b += dpp_mov<0x140>(b); c += dpp_mov<0x140>(c); d += dpp_mov<0x140>(d); } while (0)
DEVI void rw_step4(float4 (&st)[4], const RwOps& o, float& y0, float& y1, float& y2, float& y3) {
    float d0 = dot4(st[0], o.kk), d1 = dot4(st[1], o.kk), d2 = dot4(st[2], o.kk), d3 = dot4(st[3], o.kk);
    RED16x4(d0, d1, d2, d3);
    upd4(st[0], o, d0, o.v0); upd4(st[1], o, d1, o.v1); upd4(st[2], o, d2, o.v2); upd4(st[3], o, d3, o.v3);
    y0 = dot4(st[0], o.r); y1 = dot4(st[1], o.r); y2 = dot4(st[2], o.r); y3 = dot4(st[3], o.r);
    RED16x4(y0, y1, y2, y3);
}
DEVI void ph_rwkv_chunk(const P& p, int l, float* sm) {
    char* ws = ows(p);
    const bf16_t* proj = (const bf16_t*)(ws + WS_PROJ);
    const float* rw = (const float*)(ws + WS_RW);
    const size_t A1 = (size_t)T * RW;
    bf16_t* pt = (bf16_t*)(ws + WS_PT);
    bf16_t* yt = (bf16_t*)(ws + WS_RWY);
    float* pq = (float*)(ws + WS_PQ);
    const float* mu = p.in[I_MU] + l * RWSLAB;
    const int tid = otid(), lane = tid & 63, wv = tid >> 6;
    const int rl = wv * 4 + (lane >> 4), kq = lane & 15;
    float* smV = sm + 5 * 2048;
    float* smY = smV + 2048;
    for (int item = obid(); item < 12 * NCH * 2; item += gridDim.x) {
        const int half = item & 1, c = (item >> 1) % NCH, bh = item / (2 * NCH), b = bh / 6, h = bh % 6;
        float4 st[4];
#pragma unroll
        for (int j = 0; j < 4; ++j) {
            const int row = j * 16 + rl;
            st[j].x = (half == 0 && kq * 4 + 0 == row) ? 1.f : 0.f;
            st[j].y = (half == 0 && kq * 4 + 1 == row) ? 1.f : 0.f;
            st[j].z = (half == 0 && kq * 4 + 2 == row) ? 1.f : 0.f;
            st[j].w = (half == 0 && kq * 4 + 3 == row) ? 1.f : 0.f;
        }
        for (int t0 = c * RC; t0 < (c + 1) * RC; t0 += 32) {
            __syncthreads();
            for (int i = tid; i < 512; i += NT) {
                const int tt = i >> 4, k4 = (i & 15) * 4;
                *(float4*)(sm + 1 * 2048 + tt * 64 + k4) = *(const float4*)(rw + ((size_t)b * S + t0 + tt) * RW + h * 64 + k4);
            }
            {
                const int tt = tid >> 3, k8 = (tid & 7) * 8;
                const bf16_t* rwb = (const bf16_t*)(rw + A1) + ((size_t)b * S + t0 + tt) * RW + h * 64 + k8;
                ld8bf(rwb + 0 * A1, sm + 0 * 2048 + tt * 64 + k8);
                ld8bf(rwb + 1 * A1, sm + 2 * 2048 + tt * 64 + k8);
                ld8bf(rwb + 2 * A1, sm + 3 * 2048 + tt * 64 + k8);
            }
            {
                const int tt = tid >> 3, k8 = (tid & 7) * 8;
                const bf16_t* pc = proj + ((size_t)b * S + t0 + tt) * INW + C_RWKV;
                float z[8];
                zmix8(pc, t0 + tt, h * 64 + k8, mu, z);
#pragma unroll
                for (int j = 0; j < 8; ++j) sm[4 * 2048 + tt * 64 + k8 + j] = z[j];
                if (half) zmix8(pc, t0 + tt, 768 + h * 64 + k8, mu, z);
#pragma unroll
                for (int j = 0; j < 8; ++j) smV[tt * 64 + k8 + j] = half ? z[j] : 0.f;
            }
            __syncthreads();
            RwOps cur, nxt;
            rw_load(cur, sm, smV, 0, kq, rl);
#pragma unroll 2
            for (int tt = 0; tt < 32; ++tt) {
                rw_load(nxt, sm, smV, (tt + 1) & 31, kq, rl);
                float y0, y1, y2, y3;
                rw_step4(st, cur, y0, y1, y2, y3);
                if (kq < 4) smY[tt * 64 + kq * 16 + rl] = kq == 0 ? y0 : (kq == 1 ? y1 : (kq == 2 ? y2 : y3));
                cur = nxt;
            }
            __syncthreads();
            {
                bf16_t* dst = half ? yt : pt;
                const int tt = tid >> 3, k8 = (tid & 7) * 8;
                *(bf16x8*)(dst + ((size_t)b * S + t0 + tt) * RW + h * 64 + k8) = pack8(smY + tt * 64 + k8);
            }
        }
#pragma unroll
        for (int j = 0; j < 4; ++j)
            *(float4*)(pq + ((size_t)((bh * NCH + c) * 2 + half)) * 4096 + (j * 16 + rl) * 64 + kq * 4) = st[j];
    }
}

DEVI void ph_rwkv_seq(const P& p, float* sm) {
    char* ws = ows(p);
    const float* pq = (const float*)(ws + WS_PQ);
    float* s0buf = (float*)(ws + WS_S0);
    const int tid = otid(), lane = tid & 63, wid = tid >> 6, lr = lane & 15, lq = lane >> 4;
    float* psm = sm;
    float* ssm = sm + 8192;
    if (obid() >= 48) return;
    const int bh = obid() >> 2, vg = obid() & 3;
    f32x4 st = (f32x4){0.f, 0.f, 0.f, 0.f};
    __syncthreads();
    {
        const float* P0 = pq + ((size_t)(bh * NCH) * 2) * 4096;
#pragma unroll
        for (int i = 0; i < 4; ++i) *(float4*)(psm + (tid + i * 256) * 4) = *(const float4*)(P0 + (tid + i * 256) * 4);
    }
    for (int c = 0; c < NCH; ++c) {
        float* s0t = s0buf + (size_t)(bh * NCH + c) * 4096;
        float* sc = ssm + (c & 1) * 1088;
#pragma unroll
        for (int r = 0; r < 4; ++r) {
            s0t[(16 * wid + lr) * 64 + vg * 16 + 4 * lq + r] = st[r];
            sc[(16 * wid + lr) * 17 + 4 * lq + r] = st[r];
        }
        __syncthreads();
        const int cn = c + 1 < NCH ? c + 1 : c;
        const float* Pn = pq + ((size_t)(bh * NCH + cn) * 2) * 4096;
        const float4 pre0 = *(const float4*)(Pn + (tid + 0 * 256) * 4), pre1 = *(const float4*)(Pn + (tid + 1 * 256) * 4);
        const float4 pre2 = *(const float4*)(Pn + (tid + 2 * 256) * 4), pre3 = *(const float4*)(Pn + (tid + 3 * 256) * 4);
        const float* qsrc = pq + ((size_t)(bh * NCH + c) * 2 + 1) * 4096 + (vg * 16 + 4 * lq) * 64 + 16 * wid + lr;
        const float q0 = qsrc[0], q1 = qsrc[64], q2 = qsrc[128], q3 = qsrc[192];
        const float* pc = psm + (c & 1) * 4096;
        f32x4 acc0 = (f32x4){0.f, 0.f, 0.f, 0.f}, acc1 = (f32x4){0.f, 0.f, 0.f, 0.f};
#pragma unroll
        for (int ks = 0; ks < 16; ks += 2) {
            const float a0 = sc[(4 * ks + lq) * 17 + lr], b0 = pc[(4 * ks + lq) * 64 + 16 * wid + lr];
            const float a1 = sc[(4 * ks + 4 + lq) * 17 + lr], b1 = pc[(4 * ks + 4 + lq) * 64 + 16 * wid + lr];
            acc0 = __builtin_amdgcn_mfma_f32_16x16x4f32(a0, b0, acc0, 0, 0, 0);
            acc1 = __builtin_amdgcn_mfma_f32_16x16x4f32(a1, b1, acc1, 0, 0, 0);
        }
        st[0] = acc0[0] + acc1[0] + q0; st[1] = acc0[1] + acc1[1] + q1; st[2] = acc0[2] + acc1[2] + q2; st[3] = acc0[3] + acc1[3] + q3;
        {
            float* pn = psm + ((c + 1) & 1) * 4096;
            *(float4*)(pn + (tid + 0 * 256) * 4) = pre0; *(float4*)(pn + (tid + 1 * 256) * 4) = pre1;
            *(float4*)(pn + (tid + 2 * 256) * 4) = pre2; *(float4*)(pn + (tid + 3 * 256) * 4) = pre3;
        }
    }
}

DEVI void ph_rwkv_post(const P& p, int l, float* sm) {
    char* ws = ows(p);
    const bf16_t* proj = (const bf16_t*)(ws + WS_PROJ);
    const bf16_t* pt = (const bf16_t*)(ws + WS_PT);
    const bf16_t* yt = (const bf16_t*)(ws + WS_RWY);
    const float* s0buf = (const float*)(ws + WS_S0);
    const float* rs = (const float*)(ws + WS_RS);
    bf16_t* ycat = (bf16_t*)(ws + WS_YCAT);
    const float* mu = p.in[I_MU] + l * RWSLAB;
    const float* g2 = p.in[I_G2] + (size_t)l * 128 * RW;
    const float* gng = p.in[I_GNG] + l * RW; const float* gnb = p.in[I_GNB] + l * RW;
    const int tid = otid(), tau = tid >> 2, vq = tid & 3;
    float* xs = sm;
    float* ms = sm + 4160;
    for (int item = obid(); item < 12 * (S / 64); item += gridDim.x) {
        const int tile = item % (S / 64), bh = item / (S / 64), b = bh / 6, h = bh % 6;
        const int s = tile * 64 + tau;
        const size_t t = (size_t)b * S + s;
        const int c = (tile * 64) / RC;
        const int hv = h * 64 + vq * 16;
        __syncthreads();
        for (int i = tid; i < 1024; i += NT) {
            const int tt = i >> 4, i4 = (i & 15) * 4;
            const float4 x = ld4bf(pt + ((size_t)b * S + tile * 64 + tt) * RW + h * 64 + i4);
            xs[tt * 65 + i4] = x.x; xs[tt * 65 + i4 + 1] = x.y; xs[tt * 65 + i4 + 2] = x.z; xs[tt * 65 + i4 + 3] = x.w;
            *(float4*)(ms + i * 4) = *(const float4*)(s0buf + (size_t)(bh * NCH + c) * 4096 + i * 4);
        }
        __syncthreads();
        float y[16];
#pragma unroll
        for (int c4 = 0; c4 < 4; ++c4) {
            const float4 x = ld4bf(yt + t * RW + hv + c4 * 4);
            y[c4 * 4] = x.x; y[c4 * 4 + 1] = x.y; y[c4 * 4 + 2] = x.z; y[c4 * 4 + 3] = x.w;
        }
#pragma unroll 4
        for (int i = 0; i < 64; ++i) {
            const float pv = xs[tau * 65 + i];
#pragma unroll
            for (int c4 = 0; c4 < 4; ++c4) {
                const float4 m4 = *(const float4*)(ms + i * 64 + vq * 16 + c4 * 4);
                y[c4 * 4] += pv * m4.x; y[c4 * 4 + 1] += pv * m4.y; y[c4 * 4 + 2] += pv * m4.z; y[c4 * 4 + 3] += pv * m4.w;
            }
        }
        float g[16];
#pragma unroll
        for (int cc = 0; cc < 16; ++cc) g[cc] = 0.f;
        for (int jh = 0; jh < 2; ++jh) {
            __syncthreads();
            for (int i = tid; i < 512; i += NT) {
                const int tt = i >> 3, j8 = (i & 7) * 8;
                const int s2 = tile * 64 + tt;
                float z[8];
                zmix8(proj + ((size_t)b * S + s2) * INW + C_RWKV, s2, 1280 + jh * 64 + j8, mu, z);
#pragma unroll
                for (int j = 0; j < 8; ++j) xs[tt * 65 + j8 + j] = sigmoidf_(z[j]);
            }
            for (int i = tid; i < 1024; i += NT) {
                const int j = i >> 4, c4 = (i & 15) * 4;
                *(float4*)(ms + j * 64 + c4) = *(const float4*)(g2 + (size_t)(jh * 64 + j) * RW + h * 64 + c4);
            }
            __syncthreads();
#pragma unroll 4
            for (int j = 0; j < 64; ++j) {
                const float zv = xs[tau * 65 + j];
#pragma unroll
                for (int c4 = 0; c4 < 4; ++c4) {
                    const float4 m4 = *(const float4*)(ms + j * 64 + vq * 16 + c4 * 4);
                    g[c4 * 4] += zv * m4.x; g[c4 * 4 + 1] += zv * m4.y; g[c4 * 4 + 2] += zv * m4.z; g[c4 * 4 + 3] += zv * m4.w;
                }
            }
        }
        float sum = 0.f;
#pragma unroll
        for (int cc = 0; cc < 16; ++cc) sum += y[cc];
        const float mean = quad_sum(sum) * (1.f / 64.f);
        float var = 0.f;
#pragma unroll
        for (int cc = 0; cc < 16; ++cc) { y[cc] -= mean; var += y[cc] * y[cc]; }
        const float rstd = 1.f / sqrtf(quad_sum(var) * (1.f / 64.f) + 64e-5f);
        const float rsv = rs[t * 6 + h];
        float vv[16];
        const bf16_t* pc = proj + t * INW + C_RWKV;
        zmix8(pc, s, 768 + hv, mu, vv); zmix8(pc, s, 768 + hv + 8, mu, vv + 8);
        float o[16];
#pragma unroll
        for (int cc = 0; cc < 16; ++cc) o[cc] = (y[cc] * rstd * gng[hv + cc] + gnb[hv + cc] + rsv * vv[cc]) * g[cc];
        u32x4 w0, w1;
        w0.x = pk2(o[0], o[1]); w0.y = pk2(o[2], o[3]); w0.z = pk2(o[4], o[5]); w0.w = pk2(o[6], o[7]);
        w1.x = pk2(o[8], o[9]); w1.y = pk2(o[10], o[11]); w1.z = pk2(o[12], o[13]); w1.w = pk2(o[14], o[15]);
        bf16_t* op = ycat + t * D + 384 + hv;
        *(u32x4*)op = w0; *(u32x4*)(op + 8) = w1;
    }
}

DEVI void ph_lru_prep(const P& p, int l, float* sm) {
    char* ws = ows(p);
    const bf16_t* proj = (const bf16_t*)(ws + WS_PROJ);
    float* la = (float*)(ws + WS_LA); float* lb = (float*)(ws + WS_LB);
    float* ca = (float*)(ws + WS_LC); float* cb2 = ca + NBATCH * 128 * LW;
    const float* cw = p.in[I_CW] + l * 4 * LW; const float* cb = p.in[I_CB] + l * LW;
    const float* wa = p.in[I_WA] + (size_t)l * 4 * 4096; const float* ba = p.in[I_BA] + l * LW;
    const float* wx = p.in[I_WX] + (size_t)l * 4 * 4096; const float* bx = p.in[I_BX] + l * LW;
    const float* lam = p.in[I_LAM] + l * LW;
    const int tid = otid(), tau = tid >> 2, jq = tid & 3;
    float* xs = sm;
    float* was = sm + 4160;
    float* wxs = sm + 8256;
    for (int item = obid(); item < (T / 64) * 4; item += gridDim.x) {
        const int hb = item & 3, tile = item >> 2;
        const int t = tile * 64 + tau, s = t & (S - 1);
        const int ch0 = hb * 64 + jq * 16;
        __syncthreads();
        float xc[16];
        {
            float raw[4][16];
#pragma unroll
            for (int q = 0; q < 4; ++q) {
                if (s - 3 + q >= 0) {
                    const bf16_t* src = proj + (size_t)(t - 3 + q) * INW + C_LRU + ch0;
                    ld8bf(src, raw[q]); ld8bf(src + 8, raw[q] + 8);
                } else {
#pragma unroll
                    for (int j = 0; j < 16; ++j) raw[q][j] = 0.f;
                }
            }
#pragma unroll
            for (int j = 0; j < 16; ++j) {
                const int ch = ch0 + j;
                xc[j] = cb[ch] + cw[ch] * raw[0][j] + cw[LW + ch] * raw[1][j] + cw[2 * LW + ch] * raw[2][j] + cw[3 * LW + ch] * raw[3][j];
                xs[tau * 65 + jq * 16 + j] = xc[j];
            }
        }
        for (int i = tid; i < 1024; i += NT) {
            *(float4*)(was + i * 4) = *(const float4*)(wa + (size_t)hb * 4096 + i * 4);
            *(float4*)(wxs + i * 4) = *(const float4*)(wx + (size_t)hb * 4096 + i * 4);
        }
        __syncthreads();
        float ra[16], ia[16];
#pragma unroll
        for (int j = 0; j < 16; ++j) { ra[j] = ba[ch0 + j]; ia[j] = bx[ch0 + j]; }
#pragma unroll 2
        for (int i = 0; i < 64; ++i) {
            const float xv = xs[tau * 65 + i];
#pragma unroll
            for (int c4 = 0; c4 < 4; ++c4) {
                const float4 a4 = *(const float4*)(was + i * 64 + jq * 16 + c4 * 4);
                const float4 x4 = *(const float4*)(wxs + i * 64 + jq * 16 + c4 * 4);
                ra[c4 * 4] += xv * a4.x; ra[c4 * 4 + 1] += xv * a4.y; ra[c4 * 4 + 2] += xv * a4.z; ra[c4 * 4 + 3] += xv * a4.w;
                ia[c4 * 4] += xv * x4.x; ia[c4 * 4 + 1] += xv * x4.y; ia[c4 * 4 + 2] += xv * x4.z; ia[c4 * 4 + 3] += xv * x4.w;
            }
        }
        __syncthreads();
#pragma unroll
        for (int j = 0; j < 16; ++j) {
            const float r = sigmoidf_(ra[j]), ig = sigmoidf_(ia[j]);
            const float lga = -8.f * r * softplusf_(-lam[ch0 + j]);
            ra[j] = fexp(lga);
            ia[j] = sqrtf(-expm1f(2.f * lga)) * (ig * xc[j]);
            was[tau * 64 + jq * 16 + j] = ra[j];
            wxs[tau * 64 + jq * 16 + j] = ia[j];
        }
#pragma unroll
        for (int c4 = 0; c4 < 4; ++c4) {
            *(float4*)(la + (size_t)t * LW + ch0 + c4 * 4) = make_float4(ra[c4 * 4], ra[c4 * 4 + 1], ra[c4 * 4 + 2], ra[c4 * 4 + 3]);
            *(float4*)(lb + (size_t)t * LW + ch0 + c4 * 4) = make_float4(ia[c4 * 4], ia[c4 * 4 + 1], ia[c4 * 4 + 2], ia[c4 * 4 + 3]);
        }
        __syncthreads();
        if (tid < 64) {
            float A = 1.f, Bv = 0.f;
            for (int tt = 0; tt < 64; ++tt) { const float a = was[tt * 64 + tid]; A *= a; Bv = a * Bv + wxs[tt * 64 + tid]; }
            ca[(size_t)tile * LW + hb * 64 + tid] = A; cb2[(size_t)tile * LW + hb * 64 + tid] = Bv;
        }
    }
}
DEVI void ph_lru_carry(const P& p) {
    char* ws = ows(p);
    const float* ca = (const float*)(ws + WS_LC); const float* cb = ca + NBATCH * 128 * LW;
    float* hin = (float*)(ws + WS_LC) + 2 * NBATCH * 128 * LW;
    for (int idx = obid() * NT + otid(); idx < NBATCH * LW; idx += gridDim.x * NT) {
        const int c = idx & 255, b = idx >> 8;
        float h = 0.f;
        for (int n0 = 0; n0 < 128; n0 += 16) {
            float a[16], bb[16];
#pragma unroll
            for (int j = 0; j < 16; ++j) { const int o = (b * 128 + n0 + j) * LW + c; a[j] = ca[o]; bb[j] = cb[o]; }
#pragma unroll
            for (int j = 0; j < 16; ++j) { const float hv = h; h = a[j] * h + bb[j]; a[j] = hv; }
#pragma unroll
            for (int j = 0; j < 16; ++j) hin[(b * 128 + n0 + j) * LW + c] = a[j];
        }
    }
}
DEVI void ph_lru_out(const P& p, int b0) {
    char* ws = ows(p);
    const bf16_t* proj = (const bf16_t*)(ws + WS_PROJ);
    const float* la = (const float*)(ws + WS_LA); const float* lb = (const float*)(ws + WS_LB);
    const float* hin = (const float*)(ws + WS_LC) + 2 * NBATCH * 128 * LW;
    bf16_t* ycat = (bf16_t*)(ws + WS_YCAT);
    const int c = otid();
    if (obid() < b0) return;
    for (int tile = obid() - b0; tile < T / 64; tile += gridDim.x - b0) {
        float h = hin[(size_t)tile * LW + c];
#pragma unroll 4
        for (int i = 0; i < 64; ++i) {
            const size_t tok = (size_t)tile * 64 + i;
            h = la[tok * LW + c] * h + lb[tok * LW + c];
            ycat[tok * D + 768 + c] = (bf16_t)f2bf(h * gelu_tanh(bf2f(proj[tok * INW + C_LRU + 256 + c])));
        }
    }
}

DEVI void ph_ln1_router(const P& p, int l, float* sm) {
    char* ws = ows(p);
    const bf16_t* mix = (const bf16_t*)(ws + WS_MIX);
    bf16_t* x1b = (bf16_t*)(ws + WS_X1B);
    int* cnt = (int*)(ws + WS_CNT) + l * NE;
    int* list = (int*)(ws + WS_LIST);
    int* tinfo = (int*)(ws + WS_TINFO);
    float* tw = (float*)(ws + WS_TW);
    const float* wg = p.in[I_MWG] + (size_t)l * D * 4; const float* bg = p.in[I_MBG] + l * 4;
    const float* we = p.in[I_MWE] + (size_t)l * D * NE; const float* be = p.in[I_MBE] + l * NE;
    const int tid = otid(), lane = tid & 63, wid = tid >> 6;
    float* xs = sm;
    float* part = sm + 8192;
    float* lgs = sm + 8192 + 1280;
    for (int rb = obid(); rb < T / 8; rb += gridDim.x) {
        __syncthreads();
#pragma unroll 1
        for (int rr = 0; rr < 2; ++rr) {
            const int r = wid * 2 + rr, row = rb * 8 + r;
            float4 v[4];
            ln_row<true>((const bf16_t*)(ws + WS_HB) + (size_t)row * D, ALPHA, mix + (size_t)row * D, nullptr, 0.f, nullptr, 0.f,
                          p.in[I_LN1G] + l * D, p.in[I_LN1B] + l * D, v, lane);
            store_row_bf(x1b + (size_t)row * D, v, lane);
            store_row(xs + r * 1024, v, lane);
        }
        __syncthreads();
        if (lane < 36) {
            const float* wcol = lane < 4 ? wg + lane : we + (lane - 4);
            const int stride = lane < 4 ? 4 : NE;
            float acc[8];
#pragma unroll
            for (int r = 0; r < 8; ++r) acc[r] = 0.f;
#pragma unroll 2
            for (int e4 = 0; e4 < 64; ++e4) {
                const int e = wid * 256 + e4 * 4;
                const float w0 = wcol[(size_t)(e + 0) * stride], w1 = wcol[(size_t)(e + 1) * stride];
                const float w2 = wcol[(size_t)(e + 2) * stride], w3 = wcol[(size_t)(e + 3) * stride];
#pragma unroll
                for (int r = 0; r < 8; ++r) {
                    const float4 x = *(const float4*)(xs + r * 1024 + e);
                    acc[r] += (x.x * w0 + x.y * w1) + (x.z * w2 + x.w * w3);
                }
            }
#pragma unroll
            for (int r = 0; r < 8; ++r) part[(wid * 8 + r) * 40 + lane] = acc[r];
        }
        __syncthreads();
        for (int i = tid; i < 288; i += NT) {
            const int r = i / 36, o = i % 36;
            const float bias = o < 4 ? bg[o] : be[o - 4];
            lgs[r * 40 + o] = ((part[(0 * 8 + r) * 40 + o] + part[(1 * 8 + r) * 40 + o]) + (part[(2 * 8 + r) * 40 + o] + part[(3 * 8 + r) * 40 + o])) + bias;
        }
        __syncthreads();
        if (tid < 8) {
            const float* L = lgs + tid * 40;
            const int row = rb * 8 + tid;
            int gs = 0; float gm = L[0];
            for (int g = 1; g < 4; ++g) if (L[g] > gm) { gm = L[g]; gs = g; }
            float den = 0.f;
            for (int g = 0; g < 4; ++g) den += expf(L[g] - gm);
            const float ggate = 1.f / den;
            const float* el = L + 4 + gs * 8;
            int i1 = 0; float m1 = el[0];
            for (int j = 1; j < 8; ++j) if (el[j] > m1) { m1 = el[j]; i1 = j; }
            int i2 = -1; float m2 = -3.0e38f;
            for (int j = 0; j < 8; ++j) if (j != i1 && el[j] > m2) { m2 = el[j]; i2 = j; }
            const float p2 = expf(m2 - m1);
            const float wt1 = ggate / (1.f + p2), wt2 = ggate * p2 / (1.f + p2);
            const int e1 = gs * 8 + i1, e2 = gs * 8 + i2;
            const int pos1 = atomicAdd(&cnt[e1], 1);
            const int pos2 = atomicAdd(&cnt[e2], 1);
            list[(size_t)e1 * T + pos1] = row;
            list[(size_t)e2 * T + pos2] = row;
            tinfo[row * 4 + 0] = e1; tinfo[row * 4 + 1] = pos1; tinfo[row * 4 + 2] = e2; tinfo[row * 4 + 3] = pos2;
            tw[row * 2 + 0] = wt1; tw[row * 2 + 1] = wt2;
        }
    }
}

DEVI void ph_moe(const P& p, int l, float* sm, int which) {
    char* ws = ows(p);
    const int* cnt = (const int*)(ws + WS_CNT) + l * NE;
    const int* list = (const int*)(ws + WS_LIST);
    const bf16_t* x1b = (const bf16_t*)(ws + WS_X1B);
    bf16_t* hid = (bf16_t*)(ws + WS_HID);
    bf16_t* out2 = (bf16_t*)(ws + WS_OUT2);
    const bf16_t* wgu = (const bf16_t*)(ws + WS_WGUT);
    const bf16_t* wd = (const bf16_t*)(ws + WS_WDT);
    const int tid = otid(), lane = tid & 63, wid = tid >> 6, wr = wid >> 1, wc = wid & 1, fr = lane & 15, fq = lane >> 4;
    int q = vblock();
    int tbase = 0, off = 0;
    int* cnts = (int*)(sm + 16384 + 32);
    __syncthreads();
    if (tid < NE) cnts[tid] = cnt[tid];
    __syncthreads();
    for (int e = 0; e < NE; ++e) {
        const int ne = cnts[e];
        const int tiles = ((ne + 127) >> 7) * 8;
        while (q < tbase + tiles) {
            const int lt = q - tbase, mi = lt >> 3, ni = lt & 7;
            const int mvalid = min(128, ne - mi * 128);
            f32x4 acc[4][4];
            if (which == 0) {
                gemm128_core((LAS char*)sm, x1b, D, list + (size_t)e * T + mi * 128, mvalid,
                             wgu + ((size_t)e * 1024 + ni * 128) * D, D, D, acc);
#pragma unroll
                for (int m = 0; m < 4; ++m) {
                    const int r = wr * 64 + m * 16 + fr;
                    if (r < mvalid) {
                        bf16_t* o = hid + (size_t)(off + mi * 128 + r) * DE + ni * 64 + wc * 32 + fq * 4;
#pragma unroll
                        for (int n = 0; n < 2; ++n) {
                            u32x2 w;
                            w.x = pk2(siluf_(acc[m][n][0]) * acc[m][n + 2][0], siluf_(acc[m][n][1]) * acc[m][n + 2][1]);
                            w.y = pk2(siluf_(acc[m][n][2]) * acc[m][n + 2][2], siluf_(acc[m][n][3]) * acc[m][n + 2][3]);
                            *(u32x2*)(o + n * 16) = w;
                        }
                    }
                }
            } else {
                gemm128_core((LAS char*)sm, hid + (size_t)(off + mi * 128) * DE, DE, nullptr, mvalid,
                             wd + ((size_t)e * D + ni * 128) * DE, DE, DE, acc);
#pragma unroll
                for (int m = 0; m < 4; ++m) {
                    const int r = wr * 64 + m * 16 + fr;
                    if (r < mvalid) {
                        bf16_t* o = out2 + (size_t)(off + mi * 128 + r) * D + ni * 128 + wc * 64 + fq * 4;
#pragma unroll
                        for (int n = 0; n < 4; ++n) { u32x2 w; w.x = pk2(acc[m][n][0], acc[m][n][1]); w.y = pk2(acc[m][n][2], acc[m][n][3]); *(u32x2*)(o + n * 16) = w; }
                    }
                }
            }
            q += gridDim.x;
        }
        tbase += tiles; off += ne;
    }
}

DEVI void ph_ln2(const P& p, int l, float* sm) {
    char* ws = ows(p);
    const int* cnt = (const int*)(ws + WS_CNT) + l * NE;
    const int* tinfo = (const int*)(ws + WS_TINFO);
    const float* tw = (const float*)(ws + WS_TW);
    const bf16_t* x1 = (const bf16_t*)(ws + WS_X1B);
    const bf16_t* out2 = (const bf16_t*)(ws + WS_OUT2);
    bf16_t* hb = (bf16_t*)(ws + WS_HB);
    int* offs = (int*)sm;
    const int tid = otid(), lane = tid & 63;
    __syncthreads();
    if (tid < NE) offs[64 + tid] = cnt[tid];
    __syncthreads();
    if (tid == 0) { int o = 0; for (int e = 0; e < NE; ++e) { offs[e] = o; o += offs[64 + e]; } }
    __syncthreads();
    const int gw = (obid() * NT + tid) >> 6, nw = gridDim.x * (NT / 64);
    for (int row = gw; row < T; row += nw) {
        const int e1 = tinfo[row * 4], p1 = tinfo[row * 4 + 1], e2 = tinfo[row * 4 + 2], p2 = tinfo[row * 4 + 3];
        const bf16_t* o0 = out2 + (size_t)(offs[e1] + p1) * D;
        const bf16_t* o1 = out2 + (size_t)(offs[e2] + p2) * D;
        float4 v[4];
        ln_row<true>(x1 + (size_t)row * D, ALPHA, nullptr, o0, tw[row * 2], o1, tw[row * 2 + 1],
               p.in[I_LN2G] + l * D, p.in[I_LN2B] + l * D, v, lane);
        if (l == 0) store_row_bf(hb + (size_t)row * D, v, lane);
        else store_row(p.out + (size_t)row * D, v, lane);
    }
}

#define XB_TMO      128
#define XB_XCNT(j)  (256  + 64 * (j))
#define XB_XSUB(j)  (1280 + 64 * (j))
#define XB_XGEN(j)  (2304 + 64 * (j))
#define XB_TOP      3328
#define XB_TOPGEN   3392
#define XCD_BAR_WORDS 3456
#define XB_SPIN_CAP (1u << 18)
DEVI unsigned xb_ld(unsigned* p)              { return __hip_atomic_load(p, __ATOMIC_RELAXED, __HIP_MEMORY_SCOPE_AGENT); }
DEVI unsigned xb_add(unsigned* p, unsigned v) { return __hip_atomic_fetch_add(p, v, __ATOMIC_RELAXED, __HIP_MEMORY_SCOPE_AGENT); }
DEVI unsigned xb_xcc_id() { return (unsigned)__builtin_amdgcn_s_getreg((3 << 11) | 20) & 0xFu; }
#define XB_SPIN(cond, bar) do { unsigned _sp = 0; while (cond) { __builtin_amdgcn_s_sleep(1); \
    if ((++_sp & 255u) == 0u) { if (xb_ld(&(bar)[XB_TMO])) break; if (_sp > XB_SPIN_CAP) { atomicAdd(&(bar)[XB_TMO], 1u); break; } } } } while (0)
struct XcdBarrier { unsigned* bar; unsigned x; volatile LAS unsigned* st; };
DEVI XcdBarrier xcd_barrier_post(unsigned* bar, volatile LAS unsigned* st) {
    XcdBarrier b; b.bar = bar; b.x = xb_xcc_id(); b.st = st;
    if (threadIdx.x == 0) (void)xb_add(&bar[XB_XCNT(b.x)], 1u);
    return b;
}
DEVI void xcd_barrier_complete(unsigned* bar, unsigned x, unsigned& nloc, unsigned& nx) {
    const unsigned G = gridDim.x * gridDim.y * gridDim.z;
    unsigned sum, cnt, mine, sp = 0u;
    for (;;) {
        sum = 0u; cnt = 0u; mine = 0u;
#pragma unroll
        for (unsigned j = 0; j < 16; ++j) { const unsigned c = xb_ld(&bar[XB_XCNT(j)]); sum += c; cnt += (c > 0u) ? 1u : 0u; mine = (j == x) ? c : mine; }
        if (sum == G) break;
        __builtin_amdgcn_s_sleep(1);
        if ((++sp & 255u) == 0u) { if (xb_ld(&bar[XB_TMO])) break; if (sp > XB_SPIN_CAP) { atomicAdd(&bar[XB_TMO], 1u); break; } }
    }
    nloc = mine > 0u ? mine : 1u; nx = cnt > 0u ? cnt : 1u;
}
DEVI void xcd_barrier(const XcdBarrier& b) {
    asm volatile("s_waitcnt vmcnt(0)" ::: "memory");
    __syncthreads();
    if (threadIdx.x == 0) {
        unsigned* bar = b.bar;
        __builtin_amdgcn_s_waitcnt(0);
        unsigned nloc = b.st[0], nx = b.st[1];
        if (nloc == 0u) { xcd_barrier_complete(bar, b.x, nloc, nx); b.st[0] = nloc; b.st[1] = nx; }
        const unsigned old = xb_add(&bar[XB_XSUB(b.x)], 1u);
        const unsigned gen = old / nloc;
        if (old + 1u == (gen + 1u) * nloc) {
            __builtin_amdgcn_fence(__ATOMIC_RELEASE, "agent");
            asm volatile("s_waitcnt vmcnt(0)" ::: "memory");
            const unsigned og = xb_add(&bar[XB_TOP], 1u);
            const unsigned tg = og / nx;
            if (og + 1u == (tg + 1u) * nx) xb_add(&bar[XB_TOPGEN], 1u);
            else XB_SPIN(xb_ld(&bar[XB_TOPGEN]) == tg, bar);
            __builtin_amdgcn_fence(__ATOMIC_ACQUIRE, "agent");
            xb_add(&bar[XB_XGEN(b.x)], 1u);
            asm volatile("s_waitcnt vmcnt(0)" ::: "memory");
        } else {
            XB_SPIN(xb_ld(&bar[XB_XGEN(b.x)]) == gen, bar);
            __builtin_amdgcn_fence(__ATOMIC_ACQUIRE, "agent");
            asm volatile("s_waitcnt vmcnt(0)" ::: "memory");
        }
    }
    __syncthreads();
}

#ifndef PROBE
#define PROBE 0
#endif
constexpr int LDS_BYTES = 65536 + 256;

__global__ void __launch_bounds__(NT, 2) k_mega(P p) {
    extern __shared__ __attribute__((aligned(16))) float sm[];
    volatile LAS unsigned* ctl = (volatile LAS unsigned*)((LAS char*)sm + 65536);
    if (threadIdx.x < 16) ctl[threadIdx.x] = 0u;
    __syncthreads();
    const XcdBarrier bar = xcd_barrier_post((unsigned*)(p.ws + WS_BAR), ctl);
#define GSYNC() xcd_barrier(bar)
    ph_ln_in(p);
    ph_wprep_dense(p, sm);
    GSYNC();
    if (PROBE & 128) { ph_ln_in(p); GSYNC(); }
    if (PROBE & 256) { ph_wprep_dense(p, sm); GSYNC(); }
    for (int l = 0; l < 2; ++l) {
        ph_inproj(p, l, sm); GSYNC();
        if (PROBE & 1) { ph_inproj(p, l, sm); GSYNC(); }
        ph_rwkv_prep(p, l, sm);
        ph_lru_prep(p, l, sm);
        ph_ret_kv(p, sm, 0); GSYNC();
        if (PROBE & 2) { ph_rwkv_prep(p, l, sm); GSYNC(); }
        if (PROBE & 2048) { ph_lru_prep(p, l, sm); GSYNC(); }
        if (PROBE & 4096) { ph_ret_kv(p, sm, 0); GSYNC(); }
        if (PROBE & 4) { ph_rwkv_chunk(p, l, sm); GSYNC(); }
        if (PROBE & 8) { ph_wprep_moe(p, l, sm, 0); GSYNC(); }
        ph_rwkv_chunk(p, l, sm);
        ph_wprep_moe(p, l, sm, 0);
        ph_ret_scan(p);
        ph_lru_carry(p); GSYNC();
        ph_rwkv_seq(p, sm);
        ph_ret_out(p, sm, 48);
        ph_lru_out(p, 48); GSYNC();
        if (PROBE & 16) { ph_rwkv_seq(p, sm); ph_ret_out(p, sm, 48); ph_lru_out(p, 48); GSYNC(); }
        if (PROBE & 8192) { ph_rwkv_seq(p, sm); GSYNC(); }
        if (PROBE & 16384) { ph_ret_out(p, sm, 48); GSYNC(); }
        if (PROBE & 32768) { ph_lru_out(p, 48); GSYNC(); }
        ph_rwkv_post(p, l, sm); GSYNC();
        if (PROBE & 32) { ph_rwkv_post(p, l, sm); GSYNC(); }
        ph_outproj(p, l, sm); GSYNC();
        if (PROBE & 1) { ph_outproj(p, l, sm); GSYNC(); }
        ph_ln1_router(p, l, sm); GSYNC();
        ph_moe(p, l, sm, 0); GSYNC();
        if (PROBE & 1) { ph_moe(p, l, sm, 0); GSYNC(); }
        ph_moe(p, l, sm, 1); GSYNC();
        if (PROBE & 1) { ph_moe(p, l, sm, 1); GSYNC(); }
        ph_ln2(p, l, sm); GSYNC();
        if (PROBE & 64) { ph_ln2(p, l, sm); GSYNC(); }
        if (PROBE & 512) { for (int i = 0; i < 10; ++i) GSYNC(); }
        if (PROBE & 1024) { ph_ret_scan(p); ph_lru_carry(p); GSYNC(); ph_ret_scan(p); ph_lru_carry(p); GSYNC(); }
    }
#undef GSYNC
}

extern "C" void kernel_launch(void* const* d_in, const int* in_sizes, int n_in, void* d_out, int out_size,
                              void* d_ws, size_t ws_size, hipStream_t stream) {
    if (n_in != 34 || ws_size < WS_END) { fprintf(stderr, "kernel_launch: bad args n_in=%d ws=%zu need %zu\n", n_in, ws_size, (size_t)WS_END); return; }
    P p{};
    for (int i = 0; i < 34; ++i) p.in[i] = (const float*)d_in[i];
    p.out = (float*)d_out; p.ws = (char*)d_ws;
    static int grid_blocks = 0;
    if (!grid_blocks) {
        int dev = 0, cus = 0, per_cu = 0;
        (void)hipGetDevice(&dev);
        (void)hipDeviceGetAttribute(&cus, hipDeviceAttributeMultiprocessorCount, dev);
        (void)hipFuncSetAttribute((const void*)k_mega, hipFuncAttributeMaxDynamicSharedMemorySize, LDS_BYTES);
        (void)hipOccupancyMaxActiveBlocksPerMultiprocessor(&per_cu, k_mega, NT, LDS_BYTES);
        if (per_cu < 1) per_cu = 1;
        if (per_cu > 2) per_cu = 2;
        grid_blocks = cus * per_cu;
        fprintf(stderr, "kernel_launch: cus=%d per_cu=%d grid=%d\n", cus, per_cu, grid_blocks);
    }
    (void)hipMemsetAsync((char*)d_ws + WS_CTL, 0, CTL_BYTES, stream);
    void* args[] = {&p};
    hipError_t e = hipLaunchCooperativeKernel((void*)k_mega, dim3(grid_blocks), dim3(NT), args, LDS_BYTES, stream);
    if (e != hipSuccess) fprintf(stderr, "cooperative launch failed: %s (grid %d)\n", hipGetErrorString(e), grid_blocks);
}
```

```cpp
#include <hip/hip_runtime.h>
#include <cstdio>
#include <cstdint>

#define DEVI __device__ __forceinline__

constexpr int D = 1024, NBATCH = 2, S = 8192, T = NBATCH * S;
constexpr int INW = 3456;
constexpr int C_RWKV = 1536, C_LRU = 2944;
constexpr int RW = 384;
constexpr int RWSLAB = 1408;
constexpr int LW = 256;
constexpr int NE = 32, DE = 512;
constexpr int NT = 256;
constexpr float ALPHA = 1.4142135623730951f;
constexpr float LN_EPS = 1e-5f;

constexpr size_t al256(size_t x) { return (x + 255) & ~(size_t)255; }
constexpr size_t WS_WINT = 0;
constexpr size_t WS_WOUTT = al256(WS_WINT + (size_t)2 * INW * D * 2);
constexpr size_t WS_WGUT = al256(WS_WOUTT + (size_t)2 * D * D * 2);
constexpr size_t WS_WDT = al256(WS_WGUT + (size_t)NE * 1024 * D * 2);
constexpr size_t WS_ROPE = al256(WS_WDT + (size_t)NE * D * DE * 2);
constexpr size_t WS_HB = al256(WS_ROPE + (size_t)S * 32 * 8);
constexpr size_t WS_PROJ = al256(WS_HB + (size_t)T * D * 2);
constexpr size_t SZ_PROJ = (size_t)T * INW * 2;
constexpr size_t WS_YCAT = al256(WS_PROJ + SZ_PROJ);
constexpr size_t WS_RW = al256(WS_YCAT + (size_t)T * D * 2);
constexpr size_t SZ_RW1 = (size_t)T * RW * 4;
constexpr size_t WS_RWY = al256(WS_RW + 4 * SZ_RW1);
constexpr size_t WS_LA = al256(WS_RWY + SZ_RW1);
constexpr size_t SZ_L1 = (size_t)T * LW * 4;
constexpr size_t WS_LB = al256(WS_LA + SZ_L1);
constexpr size_t WS_KV = al256(WS_LB + SZ_L1);
constexpr size_t SZ_KV = (size_t)NBATCH * 64 * 6 * 4096 * 4;
constexpr size_t WS_PQ = al256(WS_KV + SZ_KV);
constexpr size_t WS_S0 = al256(WS_PQ + (size_t)12 * 64 * 2 * 4096 * 4);
constexpr size_t WS_RS = al256(WS_S0 + (size_t)12 * 64 * 4096 * 4);
constexpr size_t WS_LC = al256(WS_RS + (size_t)T * 6 * 4);
constexpr size_t SZ_LC1 = (size_t)NBATCH * 128 * LW * 4;
constexpr size_t WS_CTL = al256(WS_LC + 3 * SZ_LC1);
constexpr size_t WS_BAR = WS_CTL;
constexpr size_t WS_CNT = WS_CTL + 16384;
constexpr size_t CTL_BYTES = 16384 + 256;
constexpr size_t WS_LIST = al256(WS_CNT + 256);
constexpr size_t WS_TINFO = al256(WS_LIST + (size_t)NE * T * 4);
constexpr size_t WS_TW = al256(WS_TINFO + (size_t)T * 16);
constexpr size_t WS_END = al256(WS_TW + (size_t)T * 8);
constexpr size_t WS_MIX = WS_RW;
constexpr size_t WS_OUT2 = WS_RW;
constexpr size_t WS_X1 = WS_PROJ;
constexpr size_t WS_X1B = WS_PROJ + (size_t)T * D * 4;
constexpr size_t WS_HID = WS_RW + (size_t)2 * T * D * 2;
static_assert(WS_X1B + (size_t)T * D * 2 <= WS_PROJ + SZ_PROJ, "X1/X1b fit in PROJ");
constexpr size_t WS_PT = WS_RW + 3 * SZ_RW1;
static_assert(WS_OUT2 + (size_t)2 * T * D * 4 <= WS_KV, "OUT2 fits in RW..LB");
static_assert(WS_HID + (size_t)2 * T * DE * 2 <= WS_RW + 4 * SZ_RW1, "HID fits in RW");
static_assert(WS_END <= (size_t)536870912, "workspace budget");

typedef unsigned short bf16_t;
typedef short bf16x8 __attribute__((ext_vector_type(8)));
typedef float f32x4 __attribute__((ext_vector_type(4)));
typedef unsigned u32x2 __attribute__((ext_vector_type(2)));
typedef unsigned u32x4 __attribute__((ext_vector_type(4)));
#define LAS __attribute__((address_space(3)))

struct P {
    const float* in[34];
    float* out;
    char* ws;
};

DEVI char* ows(const P& p) { size_t z = 0; asm volatile("" : "+s"(z)); return p.ws + z; }
enum { I_X = 0, I_LNG, I_LNB, I_WIN, I_WOUT, I_MU, I_W0, I_W2, I_A0, I_A2, I_G2, I_KK, I_KA, I_RK, I_GNG, I_GNB,
       I_CW, I_CB, I_WA, I_BA, I_WX, I_BX, I_LAM, I_LN1G, I_LN1B, I_MWG, I_MBG, I_MWE, I_MBE, I_MG, I_MU_, I_MD, I_LN2G, I_LN2B };

DEVI int otid() { int t = threadIdx.x; asm volatile("" : "+v"(t)); return t; }
DEVI int obid() { int b = blockIdx.x; asm volatile("" : "+s"(b)); return b; }
struct P;
template <int CTRL> DEVI float dpp_mov(float v) { return __builtin_bit_cast(float, __builtin_amdgcn_update_dpp(0, __builtin_bit_cast(int, v), CTRL, 0xF, 0xF, true)); }
DEVI float red16(float x) {
    x += dpp_mov<0xB1>(x);
    x += dpp_mov<0x4E>(x);
    x += dpp_mov<0x141>(x);
    x += dpp_mov<0x140>(x);
    return x;
}
DEVI float wave_sum(float v) {
    v = red16(v);
    const float r0 = __builtin_bit_cast(float, __builtin_amdgcn_readlane(__builtin_bit_cast(int, v), 0));
    const float r1 = __builtin_bit_cast(float, __builtin_amdgcn_readlane(__builtin_bit_cast(int, v), 16));
    const float r2 = __builtin_bit_cast(float, __builtin_amdgcn_readlane(__builtin_bit_cast(int, v), 32));
    const float r3 = __builtin_bit_cast(float, __builtin_amdgcn_readlane(__builtin_bit_cast(int, v), 48));
    return (r0 + r1) + (r2 + r3);
}
DEVI float fexp(float x) { return __builtin_amdgcn_exp2f(x * 1.4426950408889634f); }
DEVI float frcp(float x) { return __builtin_amdgcn_rcpf(x); }
DEVI float sigmoidf_(float x) { return frcp(1.f + fexp(-x)); }
DEVI float siluf_(float x) { return x * frcp(1.f + fexp(-x)); }
DEVI float softplusf_(float x) { return fmaxf(x, 0.f) + __builtin_amdgcn_logf(1.f + fexp(-fabsf(x))) * 0.6931471805599453f; }
DEVI float ftanh(float x) { const float e = fexp(-2.f * fabsf(x)); const float t = (1.f - e) * frcp(1.f + e); return x < 0.f ? -t : t; }
DEVI float gelu_tanh(float x) { return 0.5f * x * (1.f + ftanh(0.7978845608028654f * (x + 0.044715f * x * x * x))); }
typedef __bf16 bf16v2 __attribute__((ext_vector_type(2)));
typedef float f32v2 __attribute__((ext_vector_type(2)));
DEVI unsigned pk2(float lo, float hi) { const f32v2 f = {lo, hi}; return __builtin_bit_cast(unsigned, __builtin_convertvector(f, bf16v2)); }
DEVI unsigned f2bf(float f) { return pk2(f, 0.f) & 0xffffu; }
DEVI float bf2f(bf16_t x) { return __uint_as_float((unsigned)x << 16); }
DEVI float bflo(unsigned u) { return __uint_as_float(u << 16); }
DEVI float bfhi(unsigned u) { return __uint_as_float(u & 0xffff0000u); }
__device__ const double LOGG[6] = {-0.0317486983145803, -0.015748356968139168, -0.007843177461025893,
                                   -0.003913899321136329, -0.0019550348358033506, -0.0009770396478266127};

DEVI void rope_sincos(int s, int i, float& sn, float& cs) {
    double inv = 1.0;
    for (int q = 0; q < i; ++q) inv *= 0.7498942093324559;
    const double ang = (double)s * inv;
    const double n = rint(ang * 0.6366197723675814);
    const double r = fma(-n, 1.5707963267948966, ang);
    const int q = (int)(((long long)n) & 3);
    const double r2 = r * r;
    const double sp = r * (1.0 + r2 * (-1.0 / 6 + r2 * (1.0 / 120 + r2 * (-1.0 / 5040 + r2 * (1.0 / 362880 + r2 * (-1.0 / 39916800))))));
    const double cp = 1.0 + r2 * (-0.5 + r2 * (1.0 / 24 + r2 * (-1.0 / 720 + r2 * (1.0 / 40320 + r2 * (-1.0 / 3628800 + r2 * (1.0 / 479001600))))));
    double s_, c_;
    if (q == 0) { s_ = sp; c_ = cp; } else if (q == 1) { s_ = cp; c_ = -sp; } else if (q == 2) { s_ = -sp; c_ = -cp; } else { s_ = -cp; c_ = sp; }
    sn = (float)s_; cs = (float)c_;
}

DEVI float4 ld4bf(const bf16_t* p) { const u32x2 u = *(const u32x2*)p; return make_float4(bflo(u.x), bfhi(u.x), bflo(u.y), bfhi(u.y)); }
template <bool ABF>
DEVI void ln_row(const void* a, float alpha, const bf16_t* m, const bf16_t* o0, float w0, const bf16_t* o1, float w1,
                 const float* g, const float* bb, float4 (&v)[4], int lane) {
    float s = 0.f;
#pragma unroll
    for (int j = 0; j < 4; ++j) {
        const int e = (j * 64 + lane) * 4;
        float4 x = ABF ? ld4bf((const bf16_t*)a + e) : *(const float4*)((const float*)a + e);
        x.x *= alpha; x.y *= alpha; x.z *= alpha; x.w *= alpha;
        if (m) { const float4 y = ld4bf(m + e); x.x += y.x; x.y += y.y; x.z += y.z; x.w += y.w; }
        if (o0) {
            const float4 y0 = ld4bf(o0 + e); const float4 y1 = ld4bf(o1 + e);
            x.x += w0 * y0.x + w1 * y1.x; x.y += w0 * y0.y + w1 * y1.y; x.z += w0 * y0.z + w1 * y1.z; x.w += w0 * y0.w + w1 * y1.w;
        }
        v[j] = x; s += (x.x + x.y) + (x.z + x.w);
    }
    const float mean = wave_sum(s) * (1.f / D);
    float q = 0.f;
#pragma unroll
    for (int j = 0; j < 4; ++j) {
        v[j].x -= mean; v[j].y -= mean; v[j].z -= mean; v[j].w -= mean;
        q += (v[j].x * v[j].x + v[j].y * v[j].y) + (v[j].z * v[j].z + v[j].w * v[j].w);
    }
    const float rstd = 1.f / sqrtf(wave_sum(q) * (1.f / D) + LN_EPS);
#pragma unroll
    for (int j = 0; j < 4; ++j) {
        const int e = (j * 64 + lane) * 4;
        const float4 gg = *(const float4*)(g + e); const float4 b4 = *(const float4*)(bb + e);
        v[j].x = v[j].x * rstd * gg.x + b4.x; v[j].y = v[j].y * rstd * gg.y + b4.y;
        v[j].z = v[j].z * rstd * gg.z + b4.z; v[j].w = v[j].w * rstd * gg.w + b4.w;
    }
}
DEVI void store_row(float* o, const float4 (&v)[4], int lane) {
#pragma unroll
    for (int j = 0; j < 4; ++j) *(float4*)(o + (j * 64 + lane) * 4) = v[j];
}

DEVI void store_row_bf(bf16_t* o, const float4 (&v)[4], int lane) {
#pragma unroll
    for (int j = 0; j < 4; ++j) { u32x2 w; w.x = pk2(v[j].x, v[j].y); w.y = pk2(v[j].z, v[j].w); *(u32x2*)(o + (j * 64 + lane) * 4) = w; }
}

DEVI void ph_ln_in(const P& p) {
    const int tid = otid(), lane = tid & 63;
    const int gw = (obid() * NT + tid) >> 6, nw = gridDim.x * (NT / 64);
    char* ws = ows(p);
    bf16_t* hb = (bf16_t*)(ws + WS_HB);
    for (int row = gw; row < T; row += nw) {
        float4 v[4];
        ln_row<false>(p.in[I_X] + (size_t)row * D, 1.f, nullptr, nullptr, 0.f, nullptr, 0.f, p.in[I_LNG], p.in[I_LNB], v, lane);
        store_row_bf(hb + (size_t)row * D, v, lane);
    }
    float2* rope = (float2*)(ws + WS_ROPE);
    for (int idx = obid() * NT + tid; idx < S * 32; idx += gridDim.x * NT) {
        float sn, cs; rope_sincos(idx >> 5, idx & 31, sn, cs);
        rope[idx] = make_float2(cs, sn);
    }
}

DEVI void tr_tile(float* sm, const float* W, int N, int k0, int n0, bf16_t* dst, int K, int map) {
    const int tid = otid();
    __syncthreads();
    float4 v[8];
#pragma unroll
    for (int i = 0; i < 8; ++i) {
        const int k = (tid >> 4) + i * 16, n4 = (tid & 15) * 4;
        { const f32x4 t = __builtin_nontemporal_load((const f32x4*)(W + (size_t)(k0 + k) * N + n0 + n4)); v[i] = make_float4(t[0], t[1], t[2], t[3]); }
    }
#pragma unroll
    for (int i = 0; i < 8; ++i) {
        const int k = (tid >> 4) + i * 16, n4 = (tid & 15) * 4;
        sm[k * 65 + n4] = v[i].x; sm[k * 65 + n4 + 1] = v[i].y; sm[k * 65 + n4 + 2] = v[i].z; sm[k * 65 + n4 + 3] = v[i].w;
    }
    __syncthreads();
    const int nl = tid >> 2, kq = (tid & 3) * 32;
    const int n = n0 + nl;
    const int row = map == 0 ? n : (64 * (n >> 5) + (n & 31) + (map == 2 ? 32 : 0));
    const float* c = sm + kq * 65 + nl;
    bf16_t* d = dst + (size_t)row * K + k0 + kq;
#pragma unroll
    for (int g = 0; g < 4; ++g) {
        u32x4 o;
        o.x = pk2(c[(g * 8 + 0) * 65], c[(g * 8 + 1) * 65]); o.y = pk2(c[(g * 8 + 2) * 65], c[(g * 8 + 3) * 65]);
        o.z = pk2(c[(g * 8 + 4) * 65], c[(g * 8 + 5) * 65]); o.w = pk2(c[(g * 8 + 6) * 65], c[(g * 8 + 7) * 65]);
        *(u32x4*)(d + g * 8) = o;
    }
}
DEVI void ph_wprep_dense(const P& p, float* sm) {
    char* ws = ows(p);
    constexpr int TI = (D / 128) * (INW / 64), TO = (D / 128) * (D / 64);
    for (int q = obid(); q < 2 * (TI + TO); q += gridDim.x) {
        int r = q; const int l = r / (TI + TO); r -= l * (TI + TO);
        if (r < TI) { const int kb = r / (INW / 64), nb = r % (INW / 64);
            tr_tile(sm, p.in[I_WIN] + (size_t)l * D * INW, INW, kb * 128, nb * 64, (bf16_t*)(ws + WS_WINT) + (size_t)l * INW * D, D, 0); }
        else { r -= TI; const int kb = r / (D / 64), nb = r % (D / 64);
            tr_tile(sm, p.in[I_WOUT] + (size_t)l * D * D, D, kb * 128, nb * 64, (bf16_t*)(ws + WS_WOUTT) + (size_t)l * D * D, D, 0); }
    }
}
DEVI void ph_wprep_moe(const P& p, int l, float* sm, int b0) {
    char* ws = ows(p);
    constexpr int TG = (D / 128) * (DE / 64), TD_ = (DE / 128) * (D / 64);
    const int nbk = gridDim.x - b0;
    if (obid() < b0) return;
    for (int q = obid() - b0; q < NE * (2 * TG + TD_); q += nbk) {
        const int e = q / (2 * TG + TD_); int r = q - e * (2 * TG + TD_);
        if (r < 2 * TG) { const int up = r >= TG; if (up) r -= TG; const int kb = r / (DE / 64), nb = r % (DE / 64);
            tr_tile(sm, p.in[up ? I_MU_ : I_MG] + ((size_t)(l * NE + e)) * D * DE, DE, kb * 128, nb * 64,
                    (bf16_t*)(ws + WS_WGUT) + (size_t)e * 1024 * D, D, up ? 2 : 1); }
        else { r -= 2 * TG; const int kb = r / (D / 64), nb = r % (D / 64);
            tr_tile(sm, p.in[I_MD] + ((size_t)(l * NE + e)) * DE * D, D, kb * 128, nb * 64,
                    (bf16_t*)(ws + WS_WDT) + (size_t)e * D * DE, DE, 0); }
    }
}

DEVI void gemm128_core(LAS char* lds, const bf16_t* A, int lda, const int* rowidx, int mvalid,
                       const bf16_t* Bt, int ldb, int K, f32x4 (&acc)[4][4]) {
    const int tid = otid(), lane = tid & 63, wid = tid >> 6, wr = wid >> 1, wc = wid & 1, fr = lane & 15, fq = lane >> 4;
    const int srow = tid >> 3, sch = tid & 7;
    const bf16_t* ap[4]; const bf16_t* bp[4];
#pragma unroll
    for (int i = 0; i < 4; ++i) {
        const int r = srow + i * 32;
        const int rr = r < mvalid ? r : 0;
        const int ri = rowidx ? rowidx[rr] : rr;
        const int c = sch ^ ((r >> 1) & 7);
        ap[i] = A + (size_t)ri * lda + c * 8;
        bp[i] = Bt + (size_t)r * ldb + c * 8;
    }
#pragma unroll
    for (int m = 0; m < 4; ++m)
#pragma unroll
        for (int n = 0; n < 4; ++n) acc[m][n] = (f32x4){0.f, 0.f, 0.f, 0.f};
    const int nt = K >> 6;
    const int sw = (fr >> 1) & 7;
    const int aoff = (wr * 64 + fr) * 128, boff = 16384 + (wc * 64 + fr) * 128;
#define GSTAGE(kt, buf) do { _Pragma("unroll") for (int _i = 0; _i < 4; ++_i) { \
        __builtin_amdgcn_global_load_lds((const unsigned*)(ap[_i] + (kt) * 64), (LAS unsigned*)(lds + (buf) * 32768 + tid * 16 + _i * 4096), 16, 0, 0); \
        __builtin_amdgcn_global_load_lds((const unsigned*)(bp[_i] + (kt) * 64), (LAS unsigned*)(lds + (buf) * 32768 + 16384 + tid * 16 + _i * 4096), 16, 0, 0); } } while (0)
    GSTAGE(0, 0);
    for (int kt = 0; kt < nt; ++kt) {
        asm volatile("s_waitcnt vmcnt(0)" ::: "memory");
        __syncthreads();
        if (kt + 1 < nt) GSTAGE(kt + 1, (kt + 1) & 1);
        const LAS char* base = lds + (kt & 1) * 32768;
#pragma unroll
        for (int kk = 0; kk < 2; ++kk) {
            bf16x8 af[4], bfr[4];
            const int co = (((kk * 4 + fq) ^ sw) * 16);
#pragma unroll
            for (int m = 0; m < 4; ++m) af[m] = *(const LAS bf16x8*)(base + aoff + m * 2048 + co);
#pragma unroll
            for (int n = 0; n < 4; ++n) bfr[n] = *(const LAS bf16x8*)(base + boff + n * 2048 + co);
            __builtin_amdgcn_s_setprio(1);
#pragma unroll
            for (int m = 0; m < 4; ++m)
#pragma unroll
                for (int n = 0; n < 4; ++n) acc[m][n] = __builtin_amdgcn_mfma_f32_16x16x32_bf16(bfr[n], af[m], acc[m][n], 0, 0, 0);
            __builtin_amdgcn_s_setprio(0);
        }
    }
#undef GSTAGE
}

DEVI int vblock() { const int g = gridDim.x, b = obid(); return (g & 7) == 0 ? (b & 7) * (g >> 3) + (b >> 3) : b; }
DEVI void ph_inproj(const P& p, int l, float* sm) {
    char* ws = ows(p);
    const bf16_t* hb = (const bf16_t*)(ws + WS_HB);
    const bf16_t* wt = (const bf16_t*)(ws + WS_WINT) + (size_t)l * INW * D;
    bf16_t* proj = (bf16_t*)(ws + WS_PROJ);
    const float2* rope = (const float2*)(ws + WS_ROPE);
    const int tid = otid(), lane = tid & 63, wid = tid >> 6, wr = wid >> 1, wc = wid & 1, fr = lane & 15, fq = lane >> 4;
    constexpr int TN = INW / 128;
    for (int q = vblock(); q < (T / 128) * TN; q += gridDim.x) {
        int mi, ni;
        if (q < 3 * 1024) { const int nbk = q >> 10, w = q & 1023, t = w & 63; mi = (w >> 6) * 8 + (t >> 3); ni = nbk * 8 + (t & 7); }
        else { const int q2 = q - 3 * 1024; mi = q2 / 3; ni = 24 + q2 % 3; }
        f32x4 acc[4][4];
        gemm128_core((LAS char*)sm, hb + (size_t)mi * 128 * D, D, nullptr, 128, wt + (size_t)ni * 128 * D, D, D, acc);
        const int colw = ni * 128 + wc * 64;
#pragma unroll
        for (int m = 0; m < 4; ++m) {
            const int row = mi * 128 + wr * 64 + m * 16 + fr;
            if (colw < 768) {
                const float sc = colw >= 384 ? 0.125f : 1.f;
                const float2* rp = rope + (size_t)(row & (S - 1)) * 32 + fq * 4;
#pragma unroll
                for (int n = 0; n < 2; ++n)
#pragma unroll
                    for (int r = 0; r < 4; ++r) {
                        const float2 cs = rp[n * 16 + r];
                        const float x1 = acc[m][n][r], x2 = acc[m][n + 2][r];
                        acc[m][n][r] = (x1 * cs.x - x2 * cs.y) * sc;
                        acc[m][n + 2][r] = (x1 * cs.y + x2 * cs.x) * sc;
                    }
            }
            bf16_t* o = proj + (size_t)row * INW + colw + fq * 4;
#pragma unroll
            for (int n = 0; n < 4; ++n) { u32x2 w; w.x = pk2(acc[m][n][0], acc[m][n][1]); w.y = pk2(acc[m][n][2], acc[m][n][3]); *(u32x2*)(o + n * 16) = w; }
        }
    }
}

DEVI void ph_outproj(const P& p, int l, float* sm) {
    char* ws = ows(p);
    const bf16_t* yc = (const bf16_t*)(ws + WS_YCAT);
    const bf16_t* wt = (const bf16_t*)(ws + WS_WOUTT) + (size_t)l * D * D;
    bf16_t* mix = (bf16_t*)(ws + WS_MIX);
    const int tid = otid(), lane = tid & 63, wid = tid >> 6, wr = wid >> 1, wc = wid & 1, fr = lane & 15, fq = lane >> 4;
    for (int q = vblock(); q < (T / 128) * 8; q += gridDim.x) {
        const int mi = q >> 3, ni = q & 7;
        f32x4 acc[4][4];
        gemm128_core((LAS char*)sm, yc + (size_t)mi * 128 * D, D, nullptr, 128, wt + (size_t)ni * 128 * D, D, D, acc);
#pragma unroll
        for (int m = 0; m < 4; ++m) {
            bf16_t* o = mix + (size_t)(mi * 128 + wr * 64 + m * 16 + fr) * D + ni * 128 + wc * 64 + fq * 4;
#pragma unroll
            for (int n = 0; n < 4; ++n) { u32x2 w; w.x = pk2(acc[m][n][0], acc[m][n][1]); w.y = pk2(acc[m][n][2], acc[m][n][3]); *(u32x2*)(o + n * 16) = w; }
        }
    }
}

DEVI void ld8bf(const bf16_t* src, float* dst) {
    const u32x4 u = *(const u32x4*)src;
    dst[0] = bflo(u.x); dst[1] = bfhi(u.x); dst[2] = bflo(u.y); dst[3] = bfhi(u.y);
    dst[4] = bflo(u.z); dst[5] = bfhi(u.z); dst[6] = bflo(u.w); dst[7] = bfhi(u.w);
}
DEVI bf16x8 pack8(const float* v) {
    u32x4 u; u.x = pk2(v[0], v[1]); u.y = pk2(v[2], v[3]); u.z = pk2(v[4], v[5]); u.w = pk2(v[6], v[7]);
    return __builtin_bit_cast(bf16x8, u);
}
DEVI void ret_stage_rows(LAS char* img, const bf16_t* proj, size_t tok0, int col0, float logg, int mode, int tid) {
#pragma unroll
    for (int i = 0; i < 4; ++i) {
        const int idx = tid + i * 256, row = idx >> 3, ch = idx & 7;
        float v[8];
        ld8bf(proj + (tok0 + row) * INW + col0 + ch * 8, v);
        const float sc = fexp((mode == 0 ? (float)row : -(float)row) * logg);
#pragma unroll
        for (int j = 0; j < 8; ++j) v[j] *= sc;
        *(LAS bf16x8*)(img + row * 128 + ((ch ^ ((row >> 1) & 7)) * 16)) = pack8(v);
    }
}
DEVI void ret_stage_T(LAS char* img, const bf16_t* proj, size_t tok0, int col0, float logg, int mode, int tid) {
#pragma unroll
    for (int i = 0; i < 4; ++i) {
        const int idx = tid + i * 256, tok = idx >> 3, ch = idx & 7;
        float v[8];
        ld8bf(proj + (tok0 + tok) * INW + col0 + ch * 8, v);
        const float sc = mode == 2 ? fexp((float)(127 - tok) * logg) : 1.f;
        const int ck = (tok >> 5) * 4 + ((tok >> 2) & 3), jj = ((tok >> 4) & 1) * 4 + (tok & 3);
#pragma unroll
        for (int j = 0; j < 8; ++j) {
            const int e = ch * 8 + j;
            *(LAS bf16_t*)(img + e * 256 + ((ck ^ (e & 15)) * 16) + jj * 2) = (bf16_t)f2bf(v[j] * sc);
        }
    }
}
DEVI bf16x8 frag_row(const LAS char* img, int row, int kk, int fq) { return *(const LAS bf16x8*)(img + row * 128 + (((kk * 4 + fq) ^ ((row >> 1) & 7)) * 16)); }
DEVI bf16x8 frag_T(const LAS char* img, int e, int kp, int fq) { return *(const LAS bf16x8*)(img + e * 256 + (((kp * 4 + fq) ^ (e & 15)) * 16)); }

DEVI void ph_ret_kv(const P& p, float* sm, int b0) {
    char* ws = ows(p);
    const bf16_t* proj = (const bf16_t*)(ws + WS_PROJ);
    float* kv = (float*)(ws + WS_KV);
    LAS char* lds = (LAS char*)sm;
    const int tid = otid(), lane = tid & 63, wid = tid >> 6, fr = lane & 15, fq = lane >> 4;
    if (obid() < b0) return;
    for (int item = obid() - b0; item < NBATCH * 64 * 6; item += gridDim.x - b0) {
        const int h = item % 6, n = (item / 6) % 64, b = item / 384;
        const float logg = (float)LOGG[h];
        const size_t tok0 = (size_t)b * S + n * 128;
        __syncthreads();
        ret_stage_T(lds, proj, tok0, 768 + h * 64, logg, 0, tid);
        ret_stage_T(lds + 16384, proj, tok0, 384 + h * 64, logg, 2, tid);
        __syncthreads();
        f32x4 acc[4];
#pragma unroll
        for (int dt = 0; dt < 4; ++dt) acc[dt] = (f32x4){0.f, 0.f, 0.f, 0.f};
#pragma unroll
        for (int kk = 0; kk < 4; ++kk) {
            const bf16x8 av = frag_T(lds, wid * 16 + fr, kk, fq);
#pragma unroll
            for (int dt = 0; dt < 4; ++dt) acc[dt] = __builtin_amdgcn_mfma_f32_16x16x32_bf16(av, frag_T(lds + 16384, dt * 16 + fr, kk, fq), acc[dt], 0, 0, 0);
        }
        float* o = kv + (size_t)item * 4096;
#pragma unroll
        for (int dt = 0; dt < 4; ++dt)
#pragma unroll
            for (int r = 0; r < 4; ++r) o[(wid * 16 + fq * 4 + r) * 64 + dt * 16 + fr] = acc[dt][r];
    }
}

DEVI void ph_ret_scan(const P& p) {
    float* kv = (float*)(ows(p) + WS_KV);
    const int total = NBATCH * 6 * 4096;
    for (int idx = obid() * NT + otid(); idx < total; idx += gridDim.x * NT) {
        const int de = idx & 4095, bh = idx >> 12, h = bh % 6, b = bh / 6;
        const float g = expf(128.f * (float)LOGG[h]);
        float st = 0.f;
        float* base = kv + ((size_t)(b * 64) * 6 + h) * 4096 + de;
        for (int n0 = 0; n0 < 64; n0 += 16) {
            float x[16];
#pragma unroll
            for (int j = 0; j < 16; ++j) x[j] = base[(size_t)(n0 + j) * 6 * 4096];
#pragma unroll
            for (int j = 0; j < 16; ++j) { const float xv = x[j]; x[j] = st; st = st * g + xv; }
#pragma unroll
            for (int j = 0; j < 16; ++j) base[(size_t)(n0 + j) * 6 * 4096] = x[j];
        }
    }
}

DEVI void ph_ret_out(const P& p, float* sm, int b0) {
    char* ws = ows(p);
    const bf16_t* proj = (const bf16_t*)(ws + WS_PROJ);
    const float* kv = (const float*)(ws + WS_KV);
    bf16_t* ycat = (bf16_t*)(ws + WS_YCAT);
    LAS char* lds = (LAS char*)sm;
    const LAS char* qs = lds; const LAS char* ks = lds + 16384; const LAS char* vt = lds + 32768;
    const int tid = otid(), lane = tid & 63, wid = tid >> 6, fr = lane & 15, fq = lane >> 4;
    if (obid() < b0) return;
    for (int item = obid() - b0; item < NBATCH * 64 * 6; item += gridDim.x - b0) {
        const int h = item % 6, n = (item / 6) % 64, b = item / 384;
        const float logg = (float)LOGG[h];
        const float gam = expf(logg);
        const size_t tok0 = (size_t)b * S + n * 128;
        __syncthreads();
        ret_stage_rows(lds, proj, tok0, h * 64, logg, 0, tid);
        ret_stage_rows(lds + 16384, proj, tok0, 384 + h * 64, logg, 1, tid);
        ret_stage_T(lds + 32768, proj, tok0, 768 + h * 64, logg, 0, tid);
        __syncthreads();
        const float* prevT = kv + (size_t)item * 4096;
#pragma unroll 1
        for (int qi = 0; qi < 2; ++qi) {
            const int qt = qi == 0 ? wid : 7 - wid;
            bf16x8 bq[2];
            bq[0] = frag_row(qs, qt * 16 + fr, 0, fq); bq[1] = frag_row(qs, qt * 16 + fr, 1, fq);
            f32x4 acc[4];
#pragma unroll
            for (int et = 0; et < 4; ++et) acc[et] = (f32x4){0.f, 0.f, 0.f, 0.f};
#pragma unroll
            for (int et = 0; et < 4; ++et)
#pragma unroll
                for (int kk = 0; kk < 2; ++kk) {
                    const float* src = prevT + (et * 16 + fr) * 64 + kk * 32 + fq * 8;
                    const float4 x0 = *(const float4*)src, x1 = *(const float4*)(src + 4);
                    const float v8[8] = {x0.x, x0.y, x0.z, x0.w, x1.x, x1.y, x1.z, x1.w};
                    acc[et] = __builtin_amdgcn_mfma_f32_16x16x32_bf16(pack8(v8), bq[kk], acc[et], 0, 0, 0);
                }
#pragma unroll
            for (int et = 0; et < 4; ++et) acc[et] = acc[et] * gam;
            for (int kp = 0; kp <= (qt >> 1); ++kp) {
                float pv[8];
#pragma unroll
                for (int a = 0; a < 2; ++a) {
                    const int kt = 2 * kp + a;
                    f32x4 sT = (f32x4){0.f, 0.f, 0.f, 0.f};
                    if (kt <= qt) {
                        sT = __builtin_amdgcn_mfma_f32_16x16x32_bf16(frag_row(ks, kt * 16 + fr, 0, fq), bq[0], sT, 0, 0, 0);
                        sT = __builtin_amdgcn_mfma_f32_16x16x32_bf16(frag_row(ks, kt * 16 + fr, 1, fq), bq[1], sT, 0, 0, 0);
                        if (kt == qt) {
#pragma unroll
                            for (int r = 0; r < 4; ++r) if (fq * 4 + r > fr) sT[r] = 0.f;
                        }
                    }
                    pv[a * 4 + 0] = sT[0]; pv[a * 4 + 1] = sT[1]; pv[a * 4 + 2] = sT[2]; pv[a * 4 + 3] = sT[3];
                }
                const bf16x8 pf = pack8(pv);
#pragma unroll
                for (int et = 0; et < 4; ++et)
                    acc[et] = __builtin_amdgcn_mfma_f32_16x16x32_bf16(frag_T(vt, et * 16 + fr, kp, fq), pf, acc[et], 0, 0, 0);
            }
            float sum = 0.f;
#pragma unroll
            for (int et = 0; et < 4; ++et) sum += (acc[et][0] + acc[et][1]) + (acc[et][2] + acc[et][3]);
            sum += __shfl_xor(sum, 16); sum += __shfl_xor(sum, 32);
            const float mean = sum * (1.f / 64.f);
            float var = 0.f;
#pragma unroll
            for (int et = 0; et < 4; ++et) { acc[et] = acc[et] - mean; var += (acc[et][0] * acc[et][0] + acc[et][1] * acc[et][1]) + (acc[et][2] * acc[et][2] + acc[et][3] * acc[et][3]); }
            var += __shfl_xor(var, 16); var += __shfl_xor(var, 32);
            const float rstd = 1.f / sqrtf(var * (1.f / 64.f) + LN_EPS);
            const size_t tok = tok0 + qt * 16 + fr;
#pragma unroll
            for (int et = 0; et < 4; ++et) {
                const u32x2 gu = *(const u32x2*)(proj + tok * INW + 1152 + h * 64 + et * 16 + fq * 4);
                const float g0 = bflo(gu.x), g1 = bfhi(gu.x), g2 = bflo(gu.y), g3 = bfhi(gu.y);
                u32x2 w;
                w.x = pk2(acc[et][0] * rstd * siluf_(g0), acc[et][1] * rstd * siluf_(g1));
                w.y = pk2(acc[et][2] * rstd * siluf_(g2), acc[et][3] * rstd * siluf_(g3));
                *(u32x2*)(ycat + tok * D + h * 64 + et * 16 + fq * 4) = w;
            }
        }
    }
}

constexpr int RC = 128, NCH = S / RC;

DEVI float zmix(const bf16_t* pc, int s, int col, const float* mu) {
    const float c = bf2f(pc[col]);
    const float pv = s > 0 ? bf2f(pc[col - INW]) : 0.f;
    return c + (pv - c) * mu[col];
}
DEVI void zmix8(const bf16_t* pc, int s, int col, const float* mu, float* z) {
    float c[8], pv[8];
    ld8bf(pc + col, c);
    if (s > 0) ld8bf(pc + col - INW, pv);
    else {
#pragma unroll
        for (int j = 0; j < 8; ++j) pv[j] = 0.f;
    }
    const float4 m0 = *(const float4*)(mu + col), m1 = *(const float4*)(mu + col + 4);
    const float m[8] = {m0.x, m0.y, m0.z, m0.w, m1.x, m1.y, m1.z, m1.w};
#pragma unroll
    for (int j = 0; j < 8; ++j) z[j] = c[j] + (pv[j] - c[j]) * m[j];
}
DEVI float quad_sum(float x) { x += dpp_mov<0xB1>(x); x += dpp_mov<0x4E>(x); return x; }

DEVI void ph_rwkv_prep(const P& p, int l, float* sm) {
    char* ws = ows(p);
    const bf16_t* proj = (const bf16_t*)(ws + WS_PROJ);
    float* rw = (float*)(ws + WS_RW);
    float* rs = (float*)(ws + WS_RS);
    const size_t A1 = (size_t)T * RW;
    const float* mu = p.in[I_MU] + l * RWSLAB;
    const float* w0 = p.in[I_W0] + l * RW; const float* w2 = p.in[I_W2] + (size_t)l * 64 * RW;
    const float* a0 = p.in[I_A0] + l * RW; const float* a2 = p.in[I_A2] + (size_t)l * 64 * RW;
    const float* k_k = p.in[I_KK] + l * RW; const float* k_a = p.in[I_KA] + l * RW; const float* r_k = p.in[I_RK] + l * RW;
    const int tid = otid(), tau = tid >> 2, cq = tid & 3;
    float* zx = sm;
    float* wx = sm + 4160;
    for (int item = obid(); item < (T / 64) * 6; item += gridDim.x) {
        const int h = item % 6, tile = item / 6;
        const int t = tile * 64 + tau, s = t & (S - 1);
        const int hc = h * 64 + cq * 16;
        float u[16], av[16];
#pragma unroll
        for (int pass = 0; pass < 2; ++pass) {
            __syncthreads();
            for (int i = tid; i < 512; i += NT) {
                const int tt = i >> 3, j8 = (i & 7) * 8;
                const int t2 = tile * 64 + tt;
                float z[8];
                zmix8(proj + (size_t)t2 * INW + C_RWKV, t2 & (S - 1), (pass == 0 ? 1152 : 1216) + j8, mu, z);
#pragma unroll
                for (int j = 0; j < 8; ++j) zx[tt * 65 + j8 + j] = pass == 0 ? ftanh(z[j]) : z[j];
            }
            const float* wsrc = pass == 0 ? w2 : a2;
            for (int i = tid; i < 1024; i += NT) {
                const int j = i >> 4, c4 = (i & 15) * 4;
                *(float4*)(wx + j * 64 + c4) = *(const float4*)(wsrc + (size_t)j * RW + h * 64 + c4);
            }
            __syncthreads();
            float acc[16];
#pragma unroll
            for (int cc = 0; cc < 16; ++cc) acc[cc] = 0.f;
#pragma unroll 4
            for (int j = 0; j < 64; ++j) {
                const float zv = zx[tau * 65 + j];
#pragma unroll
                for (int c4 = 0; c4 < 4; ++c4) {
                    const float4 w4 = *(const float4*)(wx + j * 64 + cq * 16 + c4 * 4);
                    acc[c4 * 4] += zv * w4.x; acc[c4 * 4 + 1] += zv * w4.y; acc[c4 * 4 + 2] += zv * w4.z; acc[c4 * 4 + 3] += zv * w4.w;
                }
            }
#pragma unroll
            for (int cc = 0; cc < 16; ++cc) { if (pass == 0) u[cc] = acc[cc]; else av[cc] = acc[cc]; }
        }
        const bf16_t* pc = proj + (size_t)t * INW + C_RWKV;
        float kr[16], rr[16];
        zmix8(pc, s, 384 + hc, mu, kr); zmix8(pc, s, 384 + hc + 8, mu, kr + 8);
        zmix8(pc, s, hc, mu, rr); zmix8(pc, s, hc + 8, mu, rr + 8);
        float kk[16], n2 = 0.f, rsum = 0.f;
        float dec[16], nb[16], km[16];
#pragma unroll
        for (int cc = 0; cc < 16; ++cc) {
            const int c = hc + cc;
            const float wl = -softplusf_(-(u[cc] + w0[c])) - 0.5f;
            dec[cc] = fexp(-fexp(wl));
            const float a = sigmoidf_(av[cc] + a0[c]);
            kk[cc] = kr[cc] * k_k[c];
            n2 += kk[cc] * kk[cc];
            km[cc] = kr[cc] * (1.f + (a - 1.f) * k_a[c]);
            rsum += rr[cc] * km[cc] * r_k[c];
            av[cc] = a;
        }
        n2 = quad_sum(n2); rsum = quad_sum(rsum);
        const float inv = 1.f / fmaxf(sqrtf(n2), 1e-12f);
#pragma unroll
        for (int cc = 0; cc < 16; ++cc) { kk[cc] *= inv; nb[cc] = -kk[cc] * av[cc]; }
        const size_t o = (size_t)t * RW + hc;
        bf16_t* rwb = (bf16_t*)(rw + A1);
#pragma unroll
        for (int c4 = 0; c4 < 4; ++c4)
            *(float4*)(rw + o + c4 * 4) = make_float4(dec[c4 * 4], dec[c4 * 4 + 1], dec[c4 * 4 + 2], dec[c4 * 4 + 3]);
        *(bf16x8*)(rwb + 0 * A1 + o) = pack8(kk); *(bf16x8*)(rwb + 0 * A1 + o + 8) = pack8(kk + 8);
        *(bf16x8*)(rwb + 1 * A1 + o) = pack8(nb); *(bf16x8*)(rwb + 1 * A1 + o + 8) = pack8(nb + 8);
        *(bf16x8*)(rwb + 2 * A1 + o) = pack8(km); *(bf16x8*)(rwb + 2 * A1 + o + 8) = pack8(km + 8);
        if (cq == 0) rs[(size_t)t * 6 + h] = rsum;
    }
}

struct RwOps { float4 kk, w, nb, k, r; float v0, v1, v2, v3; };
DEVI void rw_load(RwOps& o, const float* sm, const float* smV, int tt, int kq, int rl) {
    o.kk = *(const float4*)(sm + 0 * 2048 + tt * 64 + kq * 4);
    o.w = *(const float4*)(sm + 1 * 2048 + tt * 64 + kq * 4);
    o.nb = *(const float4*)(sm + 2 * 2048 + tt * 64 + kq * 4);
    o.k = *(const float4*)(sm + 3 * 2048 + tt * 64 + kq * 4);
    o.r = *(const float4*)(sm + 4 * 2048 + tt * 64 + kq * 4);
    o.v0 = smV[tt * 64 + rl]; o.v1 = smV[tt * 64 + 16 + rl]; o.v2 = smV[tt * 64 + 32 + rl]; o.v3 = smV[tt * 64 + 48 + rl];
}
DEVI float dot4(const float4& a, const float4& b) { return (a.x * b.x + a.y * b.y) + (a.z * b.z + a.w * b.w); }
DEVI void upd4(float4& s, const RwOps& o, float d, float vv) {
    s.x = s.x * o.w.x + d * o.nb.x + vv * o.k.x; s.y = s.y * o.w.y + d * o.nb.y + vv * o.k.y;
    s.z = s.z * o.w.z + d * o.nb.z + vv * o.k.z; s.w = s.w * o.w.w + d * o.nb.w + vv * o.k.w;
}
#define RED16x4(a, b, c, d) do { \
    a += dpp_mov<0xB1>(a); b += dpp_mov<0xB1>(b); c += dpp_mov<0xB1>(c); d += dpp_mov<0xB1>(d); \
    a += dpp_mov<0x4E>(a); b += dpp_mov<0x4E>(b); c += dpp_mov<0x4E>(c); d += dpp_mov<0x4E>(d); \
    a += dpp_mov<0x141>(a); b += dpp_mov<0x141>(b); c += dpp_mov<0x141>(c); d += dpp_mov<0x141>(d); \
    a += dpp_mov<0x140>(a); b += dpp_mov<0x140>(b); c += dpp_mov<0x140>(c); d += dpp_mov<0x140>(d); } while (0)
DEVI void rw_step4(float4 (&st)[4], const RwOps& o, float& y0, float& y1, float& y2, float& y3) {
    float d0 = dot4(st[0], o.kk), d1 = dot4(st[1], o.kk), d2 = dot4(st[2], o.kk), d3 = dot4(st[3], o.kk);
    RED16x4(d0, d1, d2, d3);
    upd4(st[0], o, d0, o.v0); upd4(st[1], o, d1, o.v1); upd4(st[2], o, d2, o.v2); upd4(st[3], o, d3, o.v3);
    y0 = dot4(st[0], o.r); y1 = dot4(st[1], o.r); y2 = dot4(st[2], o.r); y3 = dot4(st[3], o.r);
    RED16x4(y0, y1, y2, y3);
}
DEVI void ph_rwkv_chunk(const P& p, int l, float* sm) {
    char* ws = ows(p);
    const bf16_t* proj = (const bf16_t*)(ws + WS_PROJ);
    const float* rw = (const float*)(ws + WS_RW);
    const size_t A1 = (size_t)T * RW;
    bf16_t* pt = (bf16_t*)(ws + WS_PT);
    bf16_t* yt = (bf16_t*)(ws + WS_RWY);
    float* pq = (float*)(ws + WS_PQ);
    const float* mu = p.in[I_MU] + l * RWSLAB;
    const int tid = otid(), lane = tid & 63, wv = tid >> 6;
    const int rl = wv * 4 + (lane >> 4), kq = lane & 15;
    float* smV = sm + 5 * 2048;
    float* smY = smV + 2048;
    for (int item = obid(); item < 12 * NCH * 2; item += gridDim.x) {
        const int half = item & 1, c = (item >> 1) % NCH, bh = item / (2 * NCH), b = bh / 6, h = bh % 6;
        float4 st[4];
#pragma unroll
        for (int j = 0; j < 4; ++j) {
            const int row = j * 16 + rl;
            st[j].x = (half == 0 && kq * 4 + 0 == row) ? 1.f : 0.f;
            st[j].y = (half == 0 && kq * 4 + 1 == row) ? 1.f : 0.f;
            st[j].z = (half == 0 && kq * 4 + 2 == row) ? 1.f : 0.f;
            st[j].w = (half == 0 && kq * 4 + 3 == row) ? 1.f : 0.f;
        }
        for (int t0 = c * RC; t0 < (c + 1) * RC; t0 += 32) {
            __syncthreads();
            for (int i = tid; i < 512; i += NT) {
                const int tt = i >> 4, k4 = (i & 15) * 4;
                *(float4*)(sm + 1 * 2048 + tt * 64 + k4) = *(const float4*)(rw + ((size_t)b * S + t0 + tt) * RW + h * 64 + k4);
            }
            {
                const int tt = tid >> 3, k8 = (tid & 7) * 8;
                const bf16_t* rwb = (const bf16_t*)(rw + A1) + ((size_t)b * S + t0 + tt) * RW + h * 64 + k8;
                ld8bf(rwb + 0 * A1, sm + 0 * 2048 + tt * 64 + k8);
                ld8bf(rwb + 1 * A1, sm + 2 * 2048 + tt * 64 + k8);
                ld8bf(rwb + 2 * A1, sm + 3 * 2048 + tt * 64 + k8);
            }
            {
                const int tt = tid >> 3, k8 = (tid & 7) * 8;
                const bf16_t* pc = proj + ((size_t)b * S + t0 + tt) * INW + C_RWKV;
                float z[8];
                zmix8(pc, t0 + tt, h * 64 + k8, mu, z);
#pragma unroll
                for (int j = 0; j < 8; ++j) sm[4 * 2048 + tt * 64 + k8 + j] = z[j];
                if (half) zmix8(pc, t0 + tt, 768 + h * 64 + k8, mu, z);
#pragma unroll
                for (int j = 0; j < 8; ++j) smV[tt * 64 + k8 + j] = half ? z[j] : 0.f;
            }
            __syncthreads();
            RwOps cur, nxt;
            rw_load(cur, sm, smV, 0, kq, rl);
#pragma unroll 2
            for (int tt = 0; tt < 32; ++tt) {
                rw_load(nxt, sm, smV, (tt + 1) & 31, kq, rl);
                float y0, y1, y2, y3;
                rw_step4(st, cur, y0, y1, y2, y3);
                if (kq < 4) smY[tt * 64 + kq * 16 + rl] = kq == 0 ? y0 : (kq == 1 ? y1 : (kq == 2 ? y2 : y3));
                cur = nxt;
            }
            __syncthreads();
            {
                bf16_t* dst = half ? yt : pt;
                const int tt = tid >> 3, k8 = (tid & 7) * 8;
                *(bf16x8*)(dst + ((size_t)b * S + t0 + tt) * RW + h * 64 + k8) = pack8(smY + tt * 64 + k8);
            }
        }
#pragma unroll
        for (int j = 0; j < 4; ++j)
            *(float4*)(pq + ((size_t)((bh * NCH + c) * 2 + half)) * 4096 + (j * 16 + rl) * 64 + kq * 4) = st[j];
    }
}

DEVI void ph_rwkv_seq(const P& p, float* sm) {
    char* ws = ows(p);
    const float* pq = (const float*)(ws + WS_PQ);
    float* s0buf = (float*)(ws + WS_S0);
    const int tid = otid(), lane = tid & 63, wid = tid >> 6, lr = lane & 15, lq = lane >> 4;
    float* psm = sm;
    float* ssm = sm + 8192;
    if (obid() >= 48) return;
    const int bh = obid() >> 2, vg = obid() & 3;
    f32x4 st = (f32x4){0.f, 0.f, 0.f, 0.f};
    __syncthreads();
    {
        const float* P0 = pq + ((size_t)(bh * NCH) * 2) * 4096;
#pragma unroll
        for (int i = 0; i < 4; ++i) *(float4*)(psm + (tid + i * 256) * 4) = *(const float4*)(P0 + (tid + i * 256) * 4);
    }
    for (int c = 0; c < NCH; ++c) {
        float* s0t = s0buf + (size_t)(bh * NCH + c) * 4096;
        float* sc = ssm + (c & 1) * 1088;
#pragma unroll
        for (int r = 0; r < 4; ++r) {
            s0t[(16 * wid + lr) * 64 + vg * 16 + 4 * lq + r] = st[r];
            sc[(16 * wid + lr) * 17 + 4 * lq + r] = st[r];
        }
        __syncthreads();
        const int cn = c + 1 < NCH ? c + 1 : c;
        const float* Pn = pq + ((size_t)(bh * NCH + cn) * 2) * 4096;
        const float4 pre0 = *(const float4*)(Pn + (tid + 0 * 256) * 4), pre1 = *(const float4*)(Pn + (tid + 1 * 256) * 4);
        const float4 pre2 = *(const float4*)(Pn + (tid + 2 * 256) * 4), pre3 = *(const float4*)(Pn + (tid + 3 * 256) * 4);
        const float* qsrc = pq + ((size_t)(bh * NCH + c) * 2 + 1) * 4096 + (vg * 16 + 4 * lq) * 64 + 16 * wid + lr;
        const float q0 = qsrc[0], q1 = qsrc[64], q2 = qsrc[128], q3 = qsrc[192];
        const float* pc = psm + (c & 1) * 4096;
        f32x4 acc0 = (f32x4){0.f, 0.f, 0.f, 0.f}, acc1 = (f32x4){0.f, 0.f, 0.f, 0.f};
#pragma unroll
        for (int ks = 0; ks < 16; ks += 2) {
            const float a0 = sc[(4 * ks + lq) * 17 + lr], b0 = pc[(4 * ks + lq) * 64 + 16 * wid + lr];
            const float a1 = sc[(4 * ks + 4 + lq) * 17 + lr], b1 = pc[(4 * ks + 4 + lq) * 64 + 16 * wid + lr];
            acc0 = __builtin_amdgcn_mfma_f32_16x16x4f32(a0, b0, acc0, 0, 0, 0);
            acc1 = __builtin_amdgcn_mfma_f32_16x16x4f32(a1, b1, acc1, 0, 0, 0);
        }
        st[0] = acc0[0] + acc1[0] + q0; st[1] = acc0[1] + acc1[1] + q1; st[2] = acc0[2] + acc1[2] + q2; st[3] = acc0[3] + acc1[3] + q3;
        {
            float* pn = psm + ((c + 1) & 1) * 4096;
            *(float4*)(pn + (tid + 0 * 256) * 4) = pre0; *(float4*)(pn + (tid + 1 * 256) * 4) = pre1;
            *(float4*)(pn + (tid + 2 * 256) * 4) = pre2; *(float4*)(pn + (tid + 3 * 256) * 4) = pre3;
        }
    }
}

DEVI void ph_rwkv_post(const P& p, int l, float* sm) {
    char* ws = ows(p);
    const bf16_t* proj = (const bf16_t*)(ws + WS_PROJ);
    const bf16_t* pt = (const bf16_t*)(ws + WS_PT);
    const bf16_t* yt = (const bf16_t*)(ws + WS_RWY);
    const float* s0buf = (const float*)(ws + WS_S0);
    const float* rs = (const float*)(ws + WS_RS);
    bf16_t* ycat = (bf16_t*)(ws + WS_YCAT);
    const float* mu = p.in[I_MU] + l * RWSLAB;
    const float* g2 = p.in[I_G2] + (size_t)l * 128 * RW;
    const float* gng = p.in[I_GNG] + l * RW; const float* gnb = p.in[I_GNB] + l * RW;
    const int tid = otid(), tau = tid >> 2, vq = tid & 3;
    float* xs = sm;
    float* ms = sm + 4160;
    for (int item = obid(); item < 12 * (S / 64); item += gridDim.x) {
        const int tile = item % (S / 64), bh = item / (S / 64), b = bh / 6, h = bh % 6;
        const int s = tile * 64 + tau;
        const size_t t = (size_t)b * S + s;
        const int c = (tile * 64) / RC;
        const int hv = h * 64 + vq * 16;
        __syncthreads();
        for (int i = tid; i < 1024; i += NT) {
            const int tt = i >> 4, i4 = (i & 15) * 4;
            const float4 x = ld4bf(pt + ((size_t)b * S + tile * 64 + tt) * RW + h * 64 + i4);
            xs[tt * 65 + i4] = x.x; xs[tt * 65 + i4 + 1] = x.y; xs[tt * 65 + i4 + 2] = x.z; xs[tt * 65 + i4 + 3] = x.w;
            *(float4*)(ms + i * 4) = *(const float4*)(s0buf + (size_t)(bh * NCH + c) * 4096 + i * 4);
        }
        __syncthreads();
        float y[16];
#pragma unroll
        for (int c4 = 0; c4 < 4; ++c4) {
            const float4 x = ld4bf(yt + t * RW + hv + c4 * 4);
            y[c4 * 4] = x.x; y[c4 * 4 + 1] = x.y; y[c4 * 4 + 2] = x.z; y[c4 * 4 + 3] = x.w;
        }
#pragma unroll 4
        for (int i = 0; i < 64; ++i) {
            const float pv = xs[tau * 65 + i];
#pragma unroll
            for (int c4 = 0; c4 < 4; ++c4) {
                const float4 m4 = *(const float4*)(ms + i * 64 + vq * 16 + c4 * 4);
                y[c4 * 4] += pv * m4.x; y[c4 * 4 + 1] += pv * m4.y; y[c4 * 4 + 2] += pv * m4.z; y[c4 * 4 + 3] += pv * m4.w;
            }
        }
        float g[16];
#pragma unroll
        for (int cc = 0; cc < 16; ++cc) g[cc] = 0.f;
        for (int jh = 0; jh < 2; ++jh) {
            __syncthreads();
            for (int i = tid; i < 512; i += NT) {
                const int tt = i >> 3, j8 = (i & 7) * 8;
                const int s2 = tile * 64 + tt;
                float z[8];
                zmix8(proj + ((size_t)b * S + s2) * INW + C_RWKV, s2, 1280 + jh * 64 + j8, mu, z);
#pragma unroll
                for (int j = 0; j < 8; ++j) xs[tt * 65 + j8 + j] = sigmoidf_(z[j]);
            }
            for (int i = tid; i < 1024; i += NT) {
                const int j = i >> 4, c4 = (i & 15) * 4;
                *(float4*)(ms + j * 64 + c4) = *(const float4*)(g2 + (size_t)(jh * 64 + j) * RW + h * 64 + c4);
            }
            __syncthreads();
#pragma unroll 4
            for (int j = 0; j < 64; ++j) {
                const float zv = xs[tau * 65 + j];
#pragma unroll
                for (int c4 = 0; c4 < 4; ++c4) {
                    const float4 m4 = *(const float4*)(ms + j * 64 + vq * 16 + c4 * 4);
                    g[c4 * 4] += zv * m4.x; g[c4 * 4 + 1] += zv * m4.y; g[c4 * 4 + 2] += zv * m4.z; g[c4 * 4 + 3] += zv * m4.w;
                }
            }
        }
        float sum = 0.f;
#pragma unroll
        for (int cc = 0; cc < 16; ++cc) sum += y[cc];
        const float mean = quad_sum(sum) * (1.f / 64.f);
        float var = 0.f;
#pragma unroll
        for (int cc = 0; cc < 16; ++cc) { y[cc] -= mean; var += y[cc] * y[cc]; }
        const float rstd = 1.f / sqrtf(quad_sum(var) * (1.f / 64.f) + 64e-5f);
        const float rsv = rs[t * 6 + h];
        float vv[16];
        const bf16_t* pc = proj + t * INW + C_RWKV;
        zmix8(pc, s, 768 + hv, mu, vv); zmix8(pc, s, 768 + hv + 8, mu, vv + 8);
        float o[16];
#pragma unroll
        for (int cc = 0; cc < 16; ++cc) o[cc] = (y[cc] * rstd * gng[hv + cc] + gnb[hv + cc] + rsv * vv[cc]) * g[cc];
        u32x4 w0, w1;
        w0.x = pk2(o[0], o[1]); w0.y = pk2(o[2], o[3]); w0.z = pk2(o[4], o[5]); w0.w = pk2(o[6], o[7]);
        w1.x = pk2(o[8], o[9]); w1.y = pk2(o[10], o[11]); w1.z = pk2(o[12], o[13]); w1.w = pk2(o[14], o[15]);
        bf16_t* op = ycat + t * D + 384 + hv;
        *(u32x4*)op = w0; *(u32x4*)(op + 8) = w1;
    }
}

DEVI void ph_lru_prep(const P& p, int l, float* sm) {
    char* ws = ows(p);
    const bf16_t* proj = (const bf16_t*)(ws + WS_PROJ);
    float* la = (float*)(ws + WS_LA); float* lb = (float*)(ws + WS_LB);
    float* ca = (float*)(ws + WS_LC); float* cb2 = ca + NBATCH * 128 * LW;
    const float* cw = p.in[I_CW] + l * 4 * LW; const float* cb = p.in[I_CB] + l * LW;
    const float* wa = p.in[I_WA] + (size_t)l * 4 * 4096; const float* ba = p.in[I_BA] + l * LW;
    const float* wx = p.in[I_WX] + (size_t)l * 4 * 4096; const float* bx = p.in[I_BX] + l * LW;
    const float* lam = p.in[I_LAM] + l * LW;
    const int tid = otid(), tau = tid >> 2, jq = tid & 3;
    float* xs = sm;
    float* was = sm + 4160;
    float* wxs = sm + 8256;
    for (int item = obid(); item < (T / 64) * 4; item += gridDim.x) {
        const int hb = item & 3, tile = item >> 2;
        const int t = tile * 64 + tau, s = t & (S - 1);
        const int ch0 = hb * 64 + jq * 16;
        __syncthreads();
        float xc[16];
        {
            float raw[4][16];
#pragma unroll
            for (int q = 0; q < 4; ++q) {
                if (s - 3 + q >= 0) {
                    const bf16_t* src = proj + (size_t)(t - 3 + q) * INW + C_LRU + ch0;
                    ld8bf(src, raw[q]); ld8bf(src + 8, raw[q] + 8);
                } else {
#pragma unroll
                    for (int j = 0; j < 16; ++j) raw[q][j] = 0.f;
                }
            }
#pragma unroll
            for (int j = 0; j < 16; ++j) {
                const int ch = ch0 + j;
                xc[j] = cb[ch] + cw[ch] * raw[0][j] + cw[LW + ch] * raw[1][j] + cw[2 * LW + ch] * raw[2][j] + cw[3 * LW + ch] * raw[3][j];
                xs[tau * 65 + jq * 16 + j] = xc[j];
            }
        }
        for (int i = tid; i < 1024; i += NT) {
            *(float4*)(was + i * 4) = *(const float4*)(wa + (size_t)hb * 4096 + i * 4);
            *(float4*)(wxs + i * 4) = *(const float4*)(wx + (size_t)hb * 4096 + i * 4);
        }
        __syncthreads();
        float ra[16], ia[16];
#pragma unroll
        for (int j = 0; j < 16; ++j) { ra[j] = ba[ch0 + j]; ia[j] = bx[ch0 + j]; }
#pragma unroll 2
        for (int i = 0; i < 64; ++i) {
            const float xv = xs[tau * 65 + i];
#pragma unroll
            for (int c4 = 0; c4 < 4; ++c4) {
                const float4 a4 = *(const float4*)(was + i * 64 + jq * 16 + c4 * 4);
                const float4 x4 = *(const float4*)(wxs + i * 64 + jq * 16 + c4 * 4);
                ra[c4 * 4] += xv * a4.x; ra[c4 * 4 + 1] += xv * a4.y; ra[c4 * 4 + 2] += xv * a4.z; ra[c4 * 4 + 3] += xv * a4.w;
                ia[c4 * 4] += xv * x4.x; ia[c4 * 4 + 1] += xv * x4.y; ia[c4 * 4 + 2] += xv * x4.z; ia[c4 * 4 + 3] += xv * x4.w;
            }
        }
        __syncthreads();
#pragma unroll
        for (int j = 0; j < 16; ++j) {
            const float r = sigmoidf_(ra[j]), ig = sigmoidf_(ia[j]);
            const float lga = -8.f * r * softplusf_(-lam[ch0 + j]);
            ra[j] = fexp(lga);
            ia[j] = sqrtf(-expm1f(2.f * lga)) * (ig * xc[j]);
            was[tau * 64 + jq * 16 + j] = ra[j];
            wxs[tau * 64 + jq * 16 + j] = ia[j];
        }
#pragma unroll
        for (int c4 = 0; c4 < 4; ++c4) {
            *(float4*)(la + (size_t)t * LW + ch0 + c4 * 4) = make_float4(ra[c4 * 4], ra[c4 * 4 + 1], ra[c4 * 4 + 2], ra[c4 * 4 + 3]);
            *(float4*)(lb + (size_t)t * LW + ch0 + c4 * 4) = make_float4(ia[c4 * 4], ia[c4 * 4 + 1], ia[c4 * 4 + 2], ia[c4 * 4 + 3]);
        }
        __syncthreads();
        if (tid < 64) {
            float A = 1.f, Bv = 0.f;
            for (int tt = 0; tt < 64; ++tt) { const float a = was[tt * 64 + tid]; A *= a; Bv = a * Bv + wxs[tt * 64 + tid]; }
            ca[(size_t)tile * LW + hb * 64 + tid] = A; cb2[(size_t)tile * LW + hb * 64 + tid] = Bv;
        }
    }
}
DEVI void ph_lru_carry(const P& p) {
    char* ws = ows(p);
    const float* ca = (const float*)(ws + WS_LC); const float* cb = ca + NBATCH * 128 * LW;
    float* hin = (float*)(ws + WS_LC) + 2 * NBATCH * 128 * LW;
    for (int idx = obid() * NT + otid(); idx < NBATCH * LW; idx += gridDim.x * NT) {
        const int c = idx & 255, b = idx >> 8;
        float h = 0.f;
        for (int n0 = 0; n0 < 128; n0 += 16) {
            float a[16], bb[16];
#pragma unroll
            for (int j = 0; j < 16; ++j) { const int o = (b * 128 + n0 + j) * LW + c; a[j] = ca[o]; bb[j] = cb[o]; }
#pragma unroll
            for (int j = 0; j < 16; ++j) { const float hv = h; h = a[j] * h + bb[j]; a[j] = hv; }
#pragma unroll
            for (int j = 0; j < 16; ++j) hin[(b * 128 + n0 + j) * LW + c] = a[j];
        }
    }
}
DEVI void ph_lru_out(const P& p, int b0) {
    char* ws = ows(p);
    const bf16_t* proj = (const bf16_t*)(ws + WS_PROJ);
    const float* la = (const float*)(ws + WS_LA); const float* lb = (const float*)(ws + WS_LB);
    const float* hin = (const float*)(ws + WS_LC) + 2 * NBATCH * 128 * LW;
    bf16_t* ycat = (bf16_t*)(ws + WS_YCAT);
    const int c = otid();
    if (obid() < b0) return;
    for (int tile = obid() - b0; tile < T / 64; tile += gridDim.x - b0) {
        float h = hin[(size_t)tile * LW + c];
#pragma unroll 4
        for (int i = 0; i < 64; ++i) {
            const size_t tok = (size_t)tile * 64 + i;
            h = la[tok * LW + c] * h + lb[tok * LW + c];
            ycat[tok * D + 768 + c] = (bf16_t)f2bf(h * gelu_tanh(bf2f(proj[tok * INW + C_LRU + 256 + c])));
        }
    }
}

DEVI void ph_ln1_router(const P& p, int l, float* sm) {
    char* ws = ows(p);
    const bf16_t* mix = (const bf16_t*)(ws + WS_MIX);
    bf16_t* x1b = (bf16_t*)(ws + WS_X1B);
    int* cnt = (int*)(ws + WS_CNT) + l * NE;
    int* list = (int*)(ws + WS_LIST);
    int* tinfo = (int*)(ws + WS_TINFO);
    float* tw = (float*)(ws + WS_TW);
    const float* wg = p.in[I_MWG] + (size_t)l * D * 4; const float* bg = p.in[I_MBG] + l * 4;
    const float* we = p.in[I_MWE] + (size_t)l * D * NE; const float* be = p.in[I_MBE] + l * NE;
    const int tid = otid(), lane = tid & 63, wid = tid >> 6;
    float* xs = sm;
    float* part = sm + 8192;
    float* lgs = sm + 8192 + 1280;
    for (int rb = obid(); rb < T / 8; rb += gridDim.x) {
        __syncthreads();
#pragma unroll 1
        for (int rr = 0; rr < 2; ++rr) {
            const int r = wid * 2 + rr, row = rb * 8 + r;
            float4 v[4];
            ln_row<true>((const bf16_t*)(ws + WS_HB) + (size_t)row * D, ALPHA, mix + (size_t)row * D, nullptr, 0.f, nullptr, 0.f,
                          p.in[I_LN1G] + l * D, p.in[I_LN1B] + l * D, v, lane);
            store_row_bf(x1b + (size_t)row * D, v, lane);
            store_row(xs + r * 1024, v, lane);
        }
        __syncthreads();
        if (lane < 36) {
            const float* wcol = lane < 4 ? wg + lane : we + (lane - 4);
            const int stride = lane < 4 ? 4 : NE;
            float acc[8];
#pragma unroll
            for (int r = 0; r < 8; ++r) acc[r] = 0.f;
#pragma unroll 2
            for (int e4 = 0; e4 < 64; ++e4) {
                const int e = wid * 256 + e4 * 4;
                const float w0 = wcol[(size_t)(e + 0) * stride], w1 = wcol[(size_t)(e + 1) * stride];
                const float w2 = wcol[(size_t)(e + 2) * stride], w3 = wcol[(size_t)(e + 3) * stride];
#pragma unroll
                for (int r = 0; r < 8; ++r) {
                    const float4 x = *(const float4*)(xs + r * 1024 + e);
                    acc[r] += (x.x * w0 + x.y * w1) + (x.z * w2 + x.w * w3);
                }
            }
#pragma unroll
            for (int r = 0; r < 8; ++r) part[(wid * 8 + r) * 40 + lane] = acc[r];
        }
        __syncthreads();
        for (int i = tid; i < 288; i += NT) {
            const int r = i / 36, o = i % 36;
            const float bias = o < 4 ? bg[o] : be[o - 4];
            lgs[r * 40 + o] = ((part[(0 * 8 + r) * 40 + o] + part[(1 * 8 + r) * 40 + o]) + (part[(2 * 8 + r) * 40 + o] + part[(3 * 8 + r) * 40 + o])) + bias;
        }
        __syncthreads();
        if (tid < 8) {
            const float* L = lgs + tid * 40;
            const int row = rb * 8 + tid;
            int gs = 0; float gm = L[0];
            for (int g = 1; g < 4; ++g) if (L[g] > gm) { gm = L[g]; gs = g; }
            float den = 0.f;
            for (int g = 0; g < 4; ++g) den += expf(L[g] - gm);
            const float ggate = 1.f / den;
            const float* el = L + 4 + gs * 8;
            int i1 = 0; float m1 = el[0];
            for (int j = 1; j < 8; ++j) if (el[j] > m1) { m1 = el[j]; i1 = j; }
            int i2 = -1; float m2 = -3.0e38f;
            for (int j = 0; j < 8; ++j) if (j != i1 && el[j] > m2) { m2 = el[j]; i2 = j; }
            const float p2 = expf(m2 - m1);
            const float wt1 = ggate / (1.f + p2), wt2 = ggate * p2 / (1.f + p2);
            const int e1 = gs * 8 + i1, e2 = gs * 8 + i2;
            const int pos1 = atomicAdd(&cnt[e1], 1);
            const int pos2 = atomicAdd(&cnt[e2], 1);
            list[(size_t)e1 * T + pos1] = row;
            list[(size_t)e2 * T + pos2] = row;
            tinfo[row * 4 + 0] = e1; tinfo[row * 4 + 1] = pos1; tinfo[row * 4 + 2] = e2; tinfo[row * 4 + 3] = pos2;
            tw[row * 2 + 0] = wt1; tw[row * 2 + 1] = wt2;
        }
    }
}

DEVI void ph_moe(const P& p, int l, float* sm, int which) {
    char* ws = ows(p);
    const int* cnt = (const int*)(ws + WS_CNT) + l * NE;
    const int* list = (const int*)(ws + WS_LIST);
    const bf16_t* x1b = (const bf16_t*)(ws + WS_X1B);
    bf16_t* hid = (bf16_t*)(ws + WS_HID);
    bf16_t* out2 = (bf16_t*)(ws + WS_OUT2);
    const bf16_t* wgu = (const bf16_t*)(ws + WS_WGUT);
    const bf16_t* wd = (const bf16_t*)(ws + WS_WDT);
    const int tid = otid(), lane = tid & 63, wid = tid >> 6, wr = wid >> 1, wc = wid & 1, fr = lane & 15, fq = lane >> 4;
    int q = vblock();
    int tbase = 0, off = 0;
    int* cnts = (int*)(sm + 16384 + 32);
    __syncthreads();
    if (tid < NE) cnts[tid] = cnt[tid];
    __syncthreads();
    for (int e = 0; e < NE; ++e) {
        const int ne = cnts[e];
        const int tiles = ((ne + 127) >> 7) * 8;
        while (q < tbase + tiles) {
            const int lt = q - tbase, mi = lt >> 3, ni = lt & 7;
            const int mvalid = min(128, ne - mi * 128);
            f32x4 acc[4][4];
            if (which == 0) {
                gemm128_core((LAS char*)sm, x1b, D, list + (size_t)e * T + mi * 128, mvalid,
                             wgu + ((size_t)e * 1024 + ni * 128) * D, D, D, acc);
#pragma unroll
                for (int m = 0; m < 4; ++m) {
                    const int r = wr * 64 + m * 16 + fr;
                    if (r < mvalid) {
                        bf16_t* o = hid + (size_t)(off + mi * 128 + r) * DE + ni * 64 + wc * 32 + fq * 4;
#pragma unroll
                        for (int n = 0; n < 2; ++n) {
                            u32x2 w;
                            w.x = pk2(siluf_(acc[m][n][0]) * acc[m][n + 2][0], siluf_(acc[m][n][1]) * acc[m][n + 2][1]);
                            w.y = pk2(siluf_(acc[m][n][2]) * acc[m][n + 2][2], siluf_(acc[m][n][3]) * acc[m][n + 2][3]);
                            *(u32x2*)(o + n * 16) = w;
                        }
                    }
                }
            } else {
                gemm128_core((LAS char*)sm, hid + (size_t)(off + mi * 128) * DE, DE, nullptr, mvalid,
                             wd + ((size_t)e * D + ni * 128) * DE, DE, DE, acc);
#pragma unroll
                for (int m = 0; m < 4; ++m) {
                    const int r = wr * 64 + m * 16 + fr;
                    if (r < mvalid) {
                        bf16_t* o = out2 + (size_t)(off + mi * 128 + r) * D + ni * 128 + wc * 64 + fq * 4;
#pragma unroll
                        for (int n = 0; n < 4; ++n) { u32x2 w; w.x = pk2(acc[m][n][0], acc[m][n][1]); w.y = pk2(acc[m][n][2], acc[m][n][3]); *(u32x2*)(o + n * 16) = w; }
                    }
                }
            }
            q += gridDim.x;
        }
        tbase += tiles; off += ne;
    }
}

DEVI void ph_ln2(const P& p, int l, float* sm) {
    char* ws = ows(p);
    const int* cnt = (const int*)(ws + WS_CNT) + l * NE;
    const int* tinfo = (const int*)(ws + WS_TINFO);
    const float* tw = (const float*)(ws + WS_TW);
    const bf16_t* x1 = (const bf16_t*)(ws + WS_X1B);
    const bf16_t* out2 = (const bf16_t*)(ws + WS_OUT2);
    bf16_t* hb = (bf16_t*)(ws + WS_HB);
    int* offs = (int*)sm;
    const int tid = otid(), lane = tid & 63;
    __syncthreads();
    if (tid < NE) offs[64 + tid] = cnt[tid];
    __syncthreads();
    if (tid == 0) { int o = 0; for (int e = 0; e < NE; ++e) { offs[e] = o; o += offs[64 + e]; } }
    __syncthreads();
    const int gw = (obid() * NT + tid) >> 6, nw = gridDim.x * (NT / 64);
    for (int row = gw; row < T; row += nw) {
        const int e1 = tinfo[row * 4], p1 = tinfo[row * 4 + 1], e2 = tinfo[row * 4 + 2], p2 = tinfo[row * 4 + 3];
        const bf16_t* o0 = out2 + (size_t)(offs[e1] + p1) * D;
        const bf16_t* o1 = out2 + (size_t)(offs[e2] + p2) * D;
        float4 v[4];
        ln_row<true>(x1 + (size_t)row * D, ALPHA, nullptr, o0, tw[row * 2], o1, tw[row * 2 + 1],
               p.in[I_LN2G] + l * D, p.in[I_LN2B] + l * D, v, lane);
        if (l == 0) store_row_bf(hb + (size_t)row * D, v, lane);
        else store_row(p.out + (size_t)row * D, v, lane);
    }
}

#define XB_TMO      128
#define XB_XCNT(j)  (256  + 64 * (j))
#define XB_XSUB(j)  (1280 + 64 * (j))
#define XB_XGEN(j)  (2304 + 64 * (j))
#define XB_TOP      3328
#define XB_TOPGEN   3392
#define XCD_BAR_WORDS 3456
#define XB_SPIN_CAP (1u << 18)
DEVI unsigned xb_ld(unsigned* p)              { return __hip_atomic_load(p, __ATOMIC_RELAXED, __HIP_MEMORY_SCOPE_AGENT); }
DEVI unsigned xb_add(unsigned* p, unsigned v) { return __hip_atomic_fetch_add(p, v, __ATOMIC_RELAXED, __HIP_MEMORY_SCOPE_AGENT); }
DEVI unsigned xb_xcc_id() { return (unsigned)__builtin_amdgcn_s_getreg((3 << 11) | 20) & 0xFu; }
#define XB_SPIN(cond, bar) do { unsigned _sp = 0; while (cond) { __builtin_amdgcn_s_sleep(1); \
    if ((++_sp & 255u) == 0u) { if (xb_ld(&(bar)[XB_TMO])) break; if (_sp > XB_SPIN_CAP) { atomicAdd(&(bar)[XB_TMO], 1u); break; } } } } while (0)
struct XcdBarrier { unsigned* bar; unsigned x; volatile LAS unsigned* st; };
DEVI XcdBarrier xcd_barrier_post(unsigned* bar, volatile LAS unsigned* st) {
    XcdBarrier b; b.bar = bar; b.x = xb_xcc_id(); b.st = st;
    if (threadIdx.x == 0) (void)xb_add(&bar[XB_XCNT(b.x)], 1u);
    return b;
}
DEVI void xcd_barrier_complete(unsigned* bar, unsigned x, unsigned& nloc, unsigned& nx) {
    const unsigned G = gridDim.x * gridDim.y * gridDim.z;
    unsigned sum, cnt, mine, sp = 0u;
    for (;;) {
        sum = 0u; cnt = 0u; mine = 0u;
#pragma unroll
        for (unsigned j = 0; j < 16; ++j) { const unsigned c = xb_ld(&bar[XB_XCNT(j)]); sum += c; cnt += (c > 0u) ? 1u : 0u; mine = (j == x) ? c : mine; }
        if (sum == G) break;
        __builtin_amdgcn_s_sleep(1);
        if ((++sp & 255u) == 0u) { if (xb_ld(&bar[XB_TMO])) break; if (sp > XB_SPIN_CAP) { atomicAdd(&bar[XB_TMO], 1u); break; } }
    }
    nloc = mine > 0u ? mine : 1u; nx = cnt > 0u ? cnt : 1u;
}
DEVI void xcd_barrier(const XcdBarrier& b) {
    asm volatile("s_waitcnt vmcnt(0)" ::: "memory");
    __syncthreads();
    if (threadIdx.x == 0) {
        unsigned* bar = b.bar;
        __builtin_amdgcn_s_waitcnt(0);
        unsigned nloc = b.st[0], nx = b.st[1];
        if (nloc == 0u) { xcd_barrier_complete(bar, b.x, nloc, nx); b.st[0] = nloc; b.st[1] = nx; }
        const unsigned old = xb_add(&bar[XB_XSUB(b.x)], 1u);
        const unsigned gen = old / nloc;
        if (old + 1u == (gen + 1u) * nloc) {
            __builtin_amdgcn_fence(__ATOMIC_RELEASE, "agent");
            asm volatile("s_waitcnt vmcnt(0)" ::: "memory");
            const unsigned og = xb_add(&bar[XB_TOP], 1u);
            const unsigned tg = og / nx;
            if (og + 1u == (tg + 1u) * nx) xb_add(&bar[XB_TOPGEN], 1u);
            else XB_SPIN(xb_ld(&bar[XB_TOPGEN]) == tg, bar);
            __builtin_amdgcn_fence(__ATOMIC_ACQUIRE, "agent");
            xb_add(&bar[XB_XGEN(b.x)], 1u);
            asm volatile("s_waitcnt vmcnt(0)" ::: "memory");
        } else {
            XB_SPIN(xb_ld(&bar[XB_XGEN(b.x)]) == gen, bar);
            __builtin_amdgcn_fence(__ATOMIC_ACQUIRE, "agent");
            asm volatile("s_waitcnt vmcnt(0)" ::: "memory");
        }
    }
    __syncthreads();
}

#ifndef PROBE
#define PROBE 0
#endif
constexpr int LDS_BYTES = 65536 + 256;

__global__ void __launch_bounds__(NT, 2) k_mega(P p) {
    extern __shared__ __attribute__((aligned(16))) float sm[];
    volatile LAS unsigned* ctl = (volatile LAS unsigned*)((LAS char*)sm + 65536);
    if (threadIdx.x < 16) ctl[threadIdx.x] = 0u;
    __syncthreads();
    const XcdBarrier bar = xcd_barrier_post((unsigned*)(p.ws + WS_BAR), ctl);
#define GSYNC() xcd_barrier(bar)
    ph_ln_in(p);
    ph_wprep_dense(p, sm);
    GSYNC();
    if (PROBE & 128) { ph_ln_in(p); GSYNC(); }
    if (PROBE & 256) { ph_wprep_dense(p, sm); GSYNC(); }
    for (int l = 0; l < 2; ++l) {
        ph_inproj(p, l, sm); GSYNC();
        if (PROBE & 1) { ph_inproj(p, l, sm); GSYNC(); }
        ph_rwkv_prep(p, l, sm);
        ph_lru_prep(p, l, sm);
        ph_ret_kv(p, sm, 0); GSYNC();
        if (PROBE & 2) { ph_rwkv_prep(p, l, sm); GSYNC(); }
        if (PROBE & 2048) { ph_lru_prep(p, l, sm); GSYNC(); }
        if (PROBE & 4096) { ph_ret_kv(p, sm, 0); GSYNC(); }
        if (PROBE & 4) { ph_rwkv_chunk(p, l, sm); GSYNC(); }
        if (PROBE & 8) { ph_wprep_moe(p, l, sm, 0); GSYNC(); }
        ph_rwkv_chunk(p, l, sm);
        ph_wprep_moe(p, l, sm, 0);
        ph_ret_scan(p);
        ph_lru_carry(p); GSYNC();
        ph_rwkv_seq(p, sm);
        ph_ret_out(p, sm, 48);
        ph_lru_out(p, 48); GSYNC();
        if (PROBE & 16) { ph_rwkv_seq(p, sm); ph_ret_out(p, sm, 48); ph_lru_out(p, 48); GSYNC(); }
        if (PROBE & 8192) { ph_rwkv_seq(p, sm); GSYNC(); }
        if (PROBE & 16384) { ph_ret_out(p, sm, 48); GSYNC(); }
        if (PROBE & 32768) { ph_lru_out(p, 48); GSYNC(); }
        ph_rwkv_post(p, l, sm); GSYNC();
        if (PROBE & 32) { ph_rwkv_post(p, l, sm); GSYNC(); }
        ph_outproj(p, l, sm); GSYNC();
        if (PROBE & 1) { ph_outproj(p, l, sm); GSYNC(); }
        ph_ln1_router(p, l, sm); GSYNC();
        ph_moe(p, l, sm, 0); GSYNC();
        if (PROBE & 1) { ph_moe(p, l, sm, 0); GSYNC(); }
        ph_moe(p, l, sm, 1); GSYNC();
        if (PROBE & 1) { ph_moe(p, l, sm, 1); GSYNC(); }
        ph_ln2(p, l, sm); GSYNC();
        if (PROBE & 64) { ph_ln2(p, l, sm); GSYNC(); }
        if (PROBE & 512) { for (int i = 0; i < 10; ++i) GSYNC(); }
        if (PROBE & 1024) { ph_ret_scan(p); ph_lru_carry(p); GSYNC(); ph_ret_scan(p); ph_lru_carry(p); GSYNC(); }
    }
#undef GSYNC
}

extern "C" void kernel_launch(void* const* d_in, const int* in_sizes, int n_in, void* d_out, int out_size,
                              void* d_ws, size_t ws_size, hipStream_t stream) {
    if (n_in != 34 || ws_size < WS_END) { fprintf(stderr, "kernel_launch: bad args n_in=%d ws=%zu need %zu\n", n_in, ws_size, (size_t)WS_END); return; }
    P p{};
    for (int i = 0; i < 34; ++i) p.in[i] = (const float*)d_in[i];
    p.out = (float*)d_out; p.ws = (char*)d_ws;
    static int grid_blocks = 0;
    if (!grid_blocks) {
        int dev = 0, cus = 0, per_cu = 0;
        (void)hipGetDevice(&dev);
        (void)hipDeviceGetAttribute(&cus, hipDeviceAttributeMultiprocessorCount, dev);
        (void)hipFuncSetAttribute((const void*)k_mega, hipFuncAttributeMaxDynamicSharedMemorySize, LDS_BYTES);
        (void)hipOccupancyMaxActiveBlocksPerMultiprocessor(&per_cu, k_mega, NT, LDS_BYTES);
        if (per_cu < 1) per_cu = 1;
        if (per_cu > 2) per_cu = 2;
        grid_blocks = cus * per_cu;
        fprintf(stderr, "kernel_launch: cus=%d per_cu=%d grid=%d\n", cus, per_cu, grid_blocks);
    }
    (void)hipMemsetAsync((char*)d_ws + WS_CTL, 0, CTL_BYTES, stream);
    void* args[] = {&p};
    hipError_t e = hipLaunchCooperativeKernel((void*)k_mega, dim3(grid_blocks), dim3(NT), args, LDS_BYTES, stream);
    if (e != hipSuccess) fprintf(stderr, "cooperative launch failed: %s (grid %d)\n", hipGetErrorString(e), grid_blocks);
}
```

```cpp
#include <hip/hip_runtime.h>
#include <cstdio>
#include <cstdint>

#define DEVI __device__ __forceinline__

constexpr int D = 1024, NBATCH = 2, S = 8192, T = NBATCH * S;
constexpr int INW = 3456;
constexpr int C_RWKV = 1536, C_LRU = 2944;
constexpr int RW = 384;
constexpr int RWSLAB = 1408;
constexpr int LW = 256;
constexpr int NE = 32, DE = 512;
constexpr int NT = 256;
constexpr float ALPHA = 1.4142135623730951f;
constexpr float LN_EPS = 1e-5f;

constexpr size_t al256(size_t x) { return (x + 255) & ~(size_t)255; }
constexpr size_t WS_WINT = 0;
constexpr size_t WS_WOUTT = al256(WS_WINT + (size_t)2 * INW * D * 2);
constexpr size_t WS_WGUT = al256(WS_WOUTT + (size_t)2 * D * D * 2);
constexpr size_t WS_WDT = al256(WS_WGUT + (size_t)NE * 1024 * D * 2);
constexpr size_t WS_ROPE = al256(WS_WDT + (size_t)NE * D * DE * 2);
constexpr size_t WS_HB = al256(WS_ROPE + (size_t)S * 32 * 8);
constexpr size_t WS_PROJ = al256(WS_HB + (size_t)T * D * 2);
constexpr size_t SZ_PROJ = (size_t)T * INW * 2;
constexpr size_t WS_YCAT = al256(WS_PROJ + SZ_PROJ);
constexpr size_t WS_RW = al256(WS_YCAT + (size_t)T * D * 2);
constexpr size_t SZ_RW1 = (size_t)T * RW * 4;
constexpr size_t WS_RWY = al256(WS_RW + 4 * SZ_RW1);
constexpr size_t WS_LA = al256(WS_RWY + SZ_RW1);
constexpr size_t SZ_L1 = (size_t)T * LW * 4;
constexpr size_t WS_LB = al256(WS_LA + SZ_L1);
constexpr size_t WS_KV = al256(WS_LB + SZ_L1);
constexpr size_t SZ_KV = (size_t)NBATCH * 64 * 6 * 4096 * 4;
constexpr size_t WS_PQ = al256(WS_KV + SZ_KV);
constexpr size_t WS_S0 = al256(WS_PQ + (size_t)12 * 64 * 2 * 4096 * 4);
constexpr size_t WS_RS = al256(WS_S0 + (size_t)12 * 64 * 4096 * 4);
constexpr size_t WS_LC = al256(WS_RS + (size_t)T * 6 * 4);
constexpr size_t SZ_LC1 = (size_t)NBATCH * 128 * LW * 4;
constexpr size_t WS_CTL = al256(WS_LC + 3 * SZ_LC1);
constexpr size_t WS_BAR = WS_CTL;
constexpr size_t WS_CNT = WS_CTL + 16384;
constexpr size_t CTL_BYTES = 16384 + 256;
constexpr size_t WS_LIST = al256(WS_CNT + 256);
constexpr size_t WS_TINFO = al256(WS_LIST + (size_t)NE * T * 4);
constexpr size_t WS_TW = al256(WS_TINFO + (size_t)T * 16);
constexpr size_t WS_END = al256(WS_TW + (size_t)T * 8);
constexpr size_t WS_MIX = WS_RW;
constexpr size_t WS_OUT2 = WS_RW;
constexpr size_t WS_X1 = WS_PROJ;
constexpr size_t WS_X1B = WS_PROJ + (size_t)T * D * 4;
constexpr size_t WS_HID = WS_RW + (size_t)2 * T * D * 2;
static_assert(WS_X1B + (size_t)T * D * 2 <= WS_PROJ + SZ_PROJ, "X1/X1b fit in PROJ");
constexpr size_t WS_PT = WS_RW + 3 * SZ_RW1;
static_assert(WS_OUT2 + (size_t)2 * T * D * 4 <= WS_KV, "OUT2 fits in RW..LB");
static_assert(WS_HID + (size_t)2 * T * DE * 2 <= WS_RW + 4 * SZ_RW1, "HID fits in RW");
static_assert(WS_END <= (size_t)536870912, "workspace budget");

typedef unsigned short bf16_t;
typedef short bf16x8 __attribute__((ext_vector_type(8)));
typedef float f32x4 __attribute__((ext_vector_type(4)));
typedef unsigned u32x2 __attribute__((ext_vector_type(2)));
typedef unsigned u32x4 __attribute__((ext_vector_type(4)));
#define LAS __attribute__((address_space(3)))

struct P {
    const float* in[34];
    float* out;
    char* ws;
};

DEVI char* ows(const P& p) { size_t z = 0; asm volatile("" : "+s"(z)); return p.ws + z; }
enum { I_X = 0, I_LNG, I_LNB, I_WIN, I_WOUT, I_MU, I_W0, I_W2, I_A0, I_A2, I_G2, I_KK, I_KA, I_RK, I_GNG, I_GNB,
       I_CW, I_CB, I_WA, I_BA, I_WX, I_BX, I_LAM, I_LN1G, I_LN1B, I_MWG, I_MBG, I_MWE, I_MBE, I_MG, I_MU_, I_MD, I_LN2G, I_LN2B };

DEVI int otid() { int t = threadIdx.x; asm volatile("" : "+v"(t)); return t; }
DEVI int obid() { int b = blockIdx.x; asm volatile("" : "+s"(b)); return b; }
struct P;
template <int CTRL> DEVI float dpp_mov(float v) { return __builtin_bit_cast(float, __builtin_amdgcn_update_dpp(0, __builtin_bit_cast(int, v), CTRL, 0xF, 0xF, true)); }
DEVI float red16(float x) {
    x += dpp_mov<0xB1>(x);
    x += dpp_mov<0x4E>(x);
    x += dpp_mov<0x141>(x);
    x += dpp_mov<0x140>(x);
    return x;
}
DEVI float wave_sum(float v) {
    v = red16(v);
    const float r0 = __builtin_bit_cast(float, __builtin_amdgcn_readlane(__builtin_bit_cast(int, v), 0));
    const float r1 = __builtin_bit_cast(float, __builtin_amdgcn_readlane(__builtin_bit_cast(int, v), 16));
    const float r2 = __builtin_bit_cast(float, __builtin_amdgcn_readlane(__builtin_bit_cast(int, v), 32));
    const float r3 = __builtin_bit_cast(float, __builtin_amdgcn_readlane(__builtin_bit_cast(int, v), 48));
    return (r0 + r1) + (r2 + r3);
}
DEVI float fexp(float x) { return __builtin_amdgcn_exp2f(x * 1.4426950408889634f); }
DEVI float frcp(float x) { return __builtin_amdgcn_rcpf(x); }
DEVI float sigmoidf_(float x) { return frcp(1.f + fexp(-x)); }
DEVI float siluf_(float x) { return x * frcp(1.f + fexp(-x)); }
DEVI float softplusf_(float x) { return fmaxf(x, 0.f) + __builtin_amdgcn_logf(1.f + fexp(-fabsf(x))) * 0.6931471805599453f; }
DEVI float ftanh(float x) { const float e = fexp(-2.f * fabsf(x)); const float t = (1.f - e) * frcp(1.f + e); return x < 0.f ? -t : t; }
DEVI float gelu_tanh(float x) { return 0.5f * x * (1.f + ftanh(0.7978845608028654f * (x + 0.044715f * x * x * x))); }
typedef __bf16 bf16v2 __attribute__((ext_vector_type(2)));
typedef float f32v2 __attribute__((ext_vector_type(2)));
DEVI unsigned pk2(float lo, float hi) { const f32v2 f = {lo, hi}; return __builtin_bit_cast(unsigned, __builtin_convertvector(f, bf16v2)); }
DEVI unsigned f2bf(float f) { return pk2(f, 0.f) & 0xffffu; }
DEVI float bf2f(bf16_t x) { return __uint_as_float((unsigned)x << 16); }
DEVI float bflo(unsigned u) { return __uint_as_float(u << 16); }
DEVI float bfhi(unsigned u) { return __uint_as_float(u & 0xffff0000u); }
__device__ const double LOGG[6] = {-0.0317486983145803, -0.015748356968139168, -0.007843177461025893,
                                   -0.003913899321136329, -0.0019550348358033506, -0.0009770396478266127};

DEVI void rope_sincos(int s, int i, float& sn, float& cs) {
    double inv = 1.0;
    for (int q = 0; q < i; ++q) inv *= 0.7498942093324559;
    const double ang = (double)s * inv;
    const double n = rint(ang * 0.6366197723675814);
    const double r = fma(-n, 1.5707963267948966, ang);
    const int q = (int)(((long long)n) & 3);
    const double r2 = r * r;
    const double sp = r * (1.0 + r2 * (-1.0 / 6 + r2 * (1.0 / 120 + r2 * (-1.0 / 5040 + r2 * (1.0 / 362880 + r2 * (-1.0 / 39916800))))));
    const double cp = 1.0 + r2 * (-0.5 + r2 * (1.0 / 24 + r2 * (-1.0 / 720 + r2 * (1.0 / 40320 + r2 * (-1.0 / 3628800 + r2 * (1.0 / 479001600))))));
    double s_, c_;
    if (q == 0) { s_ = sp; c_ = cp; } else if (q == 1) { s_ = cp; c_ = -sp; } else if (q == 2) { s_ = -sp; c_ = -cp; } else { s_ = -cp; c_ = sp; }
    sn = (float)s_; cs = (float)c_;
}

DEVI float4 ld4bf(const bf16_t* p) { const u32x2 u = *(const u32x2*)p; return make_float4(bflo(u.x), bfhi(u.x), bflo(u.y), bfhi(u.y)); }
template <bool ABF>
DEVI void ln_row(const void* a, float alpha, const bf16_t* m, const bf16_t* o0, float w0, const bf16_t* o1, float w1,
                 const float* g, const float* bb, float4 (&v)[4], int lane) {
    float s = 0.f;
#pragma unroll
    for (int j = 0; j < 4; ++j) {
        const int e = (j * 64 + lane) * 4;
        float4 x = ABF ? ld4bf((const bf16_t*)a + e) : *(const float4*)((const float*)a + e);
        x.x *= alpha; x.y *= alpha; x.z *= alpha; x.w *= alpha;
        if (m) { const float4 y = ld4bf(m + e); x.x += y.x; x.y += y.y; x.z += y.z; x.w += y.w; }
        if (o0) {
            const float4 y0 = ld4bf(o0 + e); const float4 y1 = ld4bf(o1 + e);
            x.x += w0 * y0.x + w1 * y1.x; x.y += w0 * y0.y + w1 * y1.y; x.z += w0 * y0.z + w1 * y1.z; x.w += w0 * y0.w + w1 * y1.w;
        }
        v[j] = x; s += (x.x + x.y) + (x.z + x.w);
    }
    const float mean = wave_sum(s) * (1.f / D);
    float q = 0.f;
#pragma unroll
    for (int j = 0; j < 4; ++j) {
        v[j].x -= mean; v[j].y -= mean; v[j].z -= mean; v[j].w -= mean;
        q += (v[j].x * v[j].x + v[j].y * v[j].y) + (v[j].z * v[j].z + v[j].w * v[j].w);
    }
    const float rstd = 1.f / sqrtf(wave_sum(q) * (1.f / D) + LN_EPS);
#pragma unroll
    for (int j = 0; j < 4; ++j) {
        const int e = (j * 64 + lane) * 4;
        const float4 gg = *(const float4*)(g + e); const float4 b4 = *(const float4*)(bb + e);
        v[j].x = v[j].x * rstd * gg.x + b4.x; v[j].y = v[j].y * rstd * gg.y + b4.y;
        v[j].z = v[j].z * rstd * gg.z + b4.z; v[j].w = v[j].w * rstd * gg.w + b4.w;
    }
}
DEVI void store_row(float* o, const float4 (&v)[4], int lane) {
#pragma unroll
    for (int j = 0; j < 4; ++j) *(float4*)(o + (j * 64 + lane) * 4) = v[j];
}

DEVI void store_row_bf(bf16_t* o, const float4 (&v)[4], int lane) {
#pragma unroll
    for (int j = 0; j < 4; ++j) { u32x2 w; w.x = pk2(v[j].x, v[j].y); w.y = pk2(v[j].z, v[j].w); *(u32x2*)(o + (j * 64 + lane) * 4) = w; }
}

DEVI void ph_ln_in(const P& p) {
    const int tid = otid(), lane = tid & 63;
    const int gw = (obid() * NT + tid) >> 6, nw = gridDim.x * (NT / 64);
    char* ws = ows(p);
    bf16_t* hb = (bf16_t*)(ws + WS_HB);
    for (int row = gw; row < T; row += nw) {
        float4 v[4];
        ln_row<false>(p.in[I_X] + (size_t)row * D, 1.f, nullptr, nullptr, 0.f, nullptr, 0.f, p.in[I_LNG], p.in[I_LNB], v, lane);
        store_row_bf(hb + (size_t)row * D, v, lane);
    }
    float2* rope = (float2*)(ws + WS_ROPE);
    for (int idx = obid() * NT + tid; idx < S * 32; idx += gridDim.x * NT) {
        float sn, cs; rope_sincos(idx >> 5, idx & 31, sn, cs);
        rope[idx] = make_float2(cs, sn);
    }
}

DEVI void tr_tile(float* sm, const float* W, int N, int k0, int n0, bf16_t* dst, int K, int map) {
    const int tid = otid();
    __syncthreads();
    float4 v[8];
#pragma unroll
    for (int i = 0; i < 8; ++i) {
        const int k = (tid >> 4) + i * 16, n4 = (tid & 15) * 4;
        { const f32x4 t = __builtin_nontemporal_load((const f32x4*)(W + (size_t)(k0 + k) * N + n0 + n4)); v[i] = make_float4(t[0], t[1], t[2], t[3]); }
    }
#pragma unroll
    for (int i = 0; i < 8; ++i) {
        const int k = (tid >> 4) + i * 16, n4 = (tid & 15) * 4;
        sm[k * 65 + n4] = v[i].x; sm[k * 65 + n4 + 1] = v[i].y; sm[k * 65 + n4 + 2] = v[i].z; sm[k * 65 + n4 + 3] = v[i].w;
    }
    __syncthreads();
    const int nl = tid >> 2, kq = (tid & 3) * 32;
    const int n = n0 + nl;
    const int row = map == 0 ? n : (64 * (n >> 5) + (n & 31) + (map == 2 ? 32 : 0));
    const float* c = sm + kq * 65 + nl;
    bf16_t* d = dst + (size_t)row * K + k0 + kq;
#pragma unroll
    for (int g = 0; g < 4; ++g) {
        u32x4 o;
        o.x = pk2(c[(g * 8 + 0) * 65], c[(g * 8 + 1) * 65]); o.y = pk2(c[(g * 8 + 2) * 65], c[(g * 8 + 3) * 65]);
        o.z = pk2(c[(g * 8 + 4) * 65], c[(g * 8 + 5) * 65]); o.w = pk2(c[(g * 8 + 6) * 65], c[(g * 8 + 7) * 65]);
        *(u32x4*)(d + g * 8) = o;
    }
}
DEVI void ph_wprep_dense(const P& p, float* sm) {
    char* ws = ows(p);
    constexpr int TI = (D / 128) * (INW / 64), TO = (D / 128) * (D / 64);
    for (int q = obid(); q < 2 * (TI + TO); q += gridDim.x) {
        int r = q; const int l = r / (TI + TO); r -= l * (TI + TO);
        if (r < TI) { const int kb = r / (INW / 64), nb = r % (INW / 64);
            tr_tile(sm, p.in[I_WIN] + (size_t)l * D * INW, INW, kb * 128, nb * 64, (bf16_t*)(ws + WS_WINT) + (size_t)l * INW * D, D, 0); }
        else { r -= TI; const int kb = r / (D / 64), nb = r % (D / 64);
            tr_tile(sm, p.in[I_WOUT] + (size_t)l * D * D, D, kb * 128, nb * 64, (bf16_t*)(ws + WS_WOUTT) + (size_t)l * D * D, D, 0); }
    }
}
DEVI void ph_wprep_moe(const P& p, int l, float* sm, int b0) {
    char* ws = ows(p);
    constexpr int TG = (D / 128) * (DE / 64), TD_ = (DE / 128) * (D / 64);
    const int nbk = gridDim.x - b0;
    if (obid() < b0) return;
    for (int q = obid() - b0; q < NE * (2 * TG + TD_); q += nbk) {
        const int e = q / (2 * TG + TD_); int r = q - e * (2 * TG + TD_);
        if (r < 2 * TG) { const int up = r >= TG; if (up) r -= TG; const int kb = r / (DE / 64), nb = r % (DE / 64);
            tr_tile(sm, p.in[up ? I_MU_ : I_MG] + ((size_t)(l * NE + e)) * D * DE, DE, kb * 128, nb * 64,
                    (bf16_t*)(ws + WS_WGUT) + (size_t)e * 1024 * D, D, up ? 2 : 1); }
        else { r -= 2 * TG; const int kb = r / (D / 64), nb = r % (D / 64);
            tr_tile(sm, p.in[I_MD] + ((size_t)(l * NE + e)) * DE * D, D, kb * 128, nb * 64,
                    (bf16_t*)(ws + WS_WDT) + (size_t)e * D * DE, DE, 0); }
    }
}

DEVI void gemm128_core(LAS char* lds, const bf16_t* A, int lda, const int* rowidx, int mvalid,
                       const bf16_t* Bt, int ldb, int K, f32x4 (&acc)[4][4]) {
    const int tid = otid(), lane = tid & 63, wid = tid >> 6, wr = wid >> 1, wc = wid & 1, fr = lane & 15, fq = lane >> 4;
    const int srow = tid >> 3, sch = tid & 7;
    const bf16_t* ap[4]; const bf16_t* bp[4];
#pragma unroll
    for (int i = 0; i < 4; ++i) {
        const int r = srow + i * 32;
        const int rr = r < mvalid ? r : 0;
        const int ri = rowidx ? rowidx[rr] : rr;
        const int c = sch ^ ((r >> 1) & 7);
        ap[i] = A + (size_t)ri * lda + c * 8;
        bp[i] = Bt + (size_t)r * ldb + c * 8;
    }
#pragma unroll
    for (int m = 0; m < 4; ++m)
#pragma unroll
        for (int n = 0; n < 4; ++n) acc[m][n] = (f32x4){0.f, 0.f, 0.f, 0.f};
    const int nt = K >> 6;
    const int sw = (fr >> 1) & 7;
    const int aoff = (wr * 64 + fr) * 128, boff = 16384 + (wc * 64 + fr) * 128;
#define GSTAGE(kt, buf) do { _Pragma("unroll") for (int _i = 0; _i < 4; ++_i) { \
        __builtin_amdgcn_global_load_lds((const unsigned*)(ap[_i] + (kt) * 64), (LAS unsigned*)(lds + (buf) * 32768 + tid * 16 + _i * 4096), 16, 0, 0); \
        __builtin_amdgcn_global_load_lds((const unsigned*)(bp[_i] + (kt) * 64), (LAS unsigned*)(lds + (buf) * 32768 + 16384 + tid * 16 + _i * 4096), 16, 0, 0); } } while (0)
    GSTAGE(0, 0);
    for (int kt = 0; kt < nt; ++kt) {
        asm volatile("s_waitcnt vmcnt(0)" ::: "memory");
        __syncthreads();
        if (kt + 1 < nt) GSTAGE(kt + 1, (kt + 1) & 1);
        const LAS char* base = lds + (kt & 1) * 32768;
#pragma unroll
        for (int kk = 0; kk < 2; ++kk) {
            bf16x8 af[4], bfr[4];
            const int co = (((kk * 4 + fq) ^ sw) * 16);
#pragma unroll
            for (int m = 0; m < 4; ++m) af[m] = *(const LAS bf16x8*)(base + aoff + m * 2048 + co);
#pragma unroll
            for (int n = 0; n < 4; ++n) bfr[n] = *(const LAS bf16x8*)(base + boff + n * 2048 + co);
            __builtin_amdgcn_s_setprio(1);
#pragma unroll
            for (int m = 0; m < 4; ++m)
#pragma unroll
                for (int n = 0; n < 4; ++n) acc[m][n] = __builtin_amdgcn_mfma_f32_16x16x32_bf16(bfr[n], af[m], acc[m][n], 0, 0, 0);
            __builtin_amdgcn_s_setprio(0);
        }
    }
#undef GSTAGE
}

DEVI int vblock() { const int g = gridDim.x, b = obid(); return (g & 7) == 0 ? (b & 7) * (g >> 3) + (b >> 3) : b; }
DEVI void ph_inproj(const P& p, int l, float* sm) {
    char* ws = ows(p);
    const bf16_t* hb = (const bf16_t*)(ws + WS_HB);
    const bf16_t* wt = (const bf16_t*)(ws + WS_WINT) + (size_t)l * INW * D;
    bf16_t* proj = (bf16_t*)(ws + WS_PROJ);
    const float2* rope = (const float2*)(ws + WS_ROPE);
    const int tid = otid(), lane = tid & 63, wid = tid >> 6, wr = wid >> 1, wc = wid & 1, fr = lane & 15, fq = lane >> 4;
    constexpr int TN = INW / 128;
    for (int q = vblock(); q < (T / 128) * TN; q += gridDim.x) {
        int mi, ni;
        if (q < 3 * 1024) { const int nbk = q >> 10, w = q & 1023, t = w & 63; mi = (w >> 6) * 8 + (t >> 3); ni = nbk * 8 + (t & 7); }
        else { const int q2 = q - 3 * 1024; mi = q2 / 3; ni = 24 + q2 % 3; }
        f32x4 acc[4][4];
        gemm128_core((LAS char*)sm, hb + (size_t)mi * 128 * D, D, nullptr, 128, wt + (size_t)ni * 128 * D, D, D, acc);
        const int colw = ni * 128 + wc * 64;
#pragma unroll
        for (int m = 0; m < 4; ++m) {
            const int row = mi * 128 + wr * 64 + m * 16 + fr;
            if (colw < 768) {
                const float sc = colw >= 384 ? 0.125f : 1.f;
                const float2* rp = rope + (size_t)(row & (S - 1)) * 32 + fq * 4;
#pragma unroll
                for (int n = 0; n < 2; ++n)
#pragma unroll
                    for (int r = 0; r < 4; ++r) {
                        const float2 cs = rp[n * 16 + r];
                        const float x1 = acc[m][n][r], x2 = acc[m][n + 2][r];
                        acc[m][n][r] = (x1 * cs.x - x2 * cs.y) * sc;
                        acc[m][n + 2][r] = (x1 * cs.y + x2 * cs.x) * sc;
                    }
            }
            bf16_t* o = proj + (size_t)row * INW + colw + fq * 4;
#pragma unroll
            for (int n = 0; n < 4; ++n) { u32x2 w; w.x = pk2(acc[m][n][0], acc[m][n][1]); w.y = pk2(acc[m][n][2], acc[m][n][3]); *(u32x2*)(o + n * 16) = w; }
        }
    }
}

DEVI void ph_outproj(const P& p, int l, float* sm) {
    char* ws = ows(p);
    const bf16_t* yc = (const bf16_t*)(ws + WS_YCAT);
    const bf16_t* wt = (const bf16_t*)(ws + WS_WOUTT) + (size_t)l * D * D;
    bf16_t* mix = (bf16_t*)(ws + WS_MIX);
    const int tid = otid(), lane = tid & 63, wid = tid >> 6, wr = wid >> 1, wc = wid & 1, fr = lane & 15, fq = lane >> 4;
    for (int q = vblock(); q < (T / 128) * 8; q += gridDim.x) {
        const int mi = q >> 3, ni = q & 7;
        f32x4 acc[4][4];
        gemm128_core((LAS char*)sm, yc + (size_t)mi * 128 * D, D, nullptr, 128, wt + (size_t)ni * 128 * D, D, D, acc);
#pragma unroll
        for (int m = 0; m < 4; ++m) {
            bf16_t* o = mix + (size_t)(mi * 128 + wr * 64 + m * 16 + fr) * D + ni * 128 + wc * 64 + fq * 4;
#pragma unroll
            for (int n = 0; n < 4; ++n) { u32x2 w; w.x = pk2(acc[m][n][0], acc[m][n][1]); w.y = pk2(acc[m][n][2], acc[m][n][3]); *(u32x2*)(o + n * 16) = w; }
        }
    }
}

DEVI void ld8bf(const bf16_t* src, float* dst) {
    const u32x4 u = *(const u32x4*)src;
    dst[0] = bflo(u.x); dst[1] = bfhi(u.x); dst[2] = bflo(u.y); dst[3] = bfhi(u.y);
    dst[4] = bflo(u.z); dst[5] = bfhi(u.z); dst[6] = bflo(u.w); dst[7] = bfhi(u.w);
}
DEVI bf16x8 pack8(const float* v) {
    u32x4 u; u.x = pk2(v[0], v[1]); u.y = pk2(v[2], v[3]); u.z = pk2(v[4], v[5]); u.w = pk2(v[6], v[7]);
    return __builtin_bit_cast(bf16x8, u);
}
DEVI void ret_stage_rows(LAS char* img, const bf16_t* proj, size_t tok0, int col0, float logg, int mode, int tid) {
#pragma unroll
    for (int i = 0; i < 4; ++i) {
        const int idx = tid + i * 256, row = idx >> 3, ch = idx & 7;
        float v[8];
        ld8bf(proj + (tok0 + row) * INW + col0 + ch * 8, v);
        const float sc = fexp((mode == 0 ? (float)row : -(float)row) * logg);
#pragma unroll
        for (int j = 0; j < 8; ++j) v[j] *= sc;
        *(LAS bf16x8*)(img + row * 128 + ((ch ^ ((row >> 1) & 7)) * 16)) = pack8(v);
    }
}
DEVI void ret_stage_T(LAS char* img, const bf16_t* proj, size_t tok0, int col0, float logg, int mode, int tid) {
#pragma unroll
    for (int i = 0; i < 4; ++i) {
        const int idx = tid + i * 256, tok = idx >> 3, ch = idx & 7;
        float v[8];
        ld8bf(proj + (tok0 + tok) * INW + col0 + ch * 8, v);
        const float sc = mode == 2 ? fexp((float)(127 - tok) * logg) : 1.f;
        const int ck = (tok >> 5) * 4 + ((tok >> 2) & 3), jj = ((tok >> 4) & 1) * 4 + (tok & 3);
#pragma unroll
        for (int j = 0; j < 8; ++j) {
            const int e = ch * 8 + j;
            *(LAS bf16_t*)(img + e * 256 + ((ck ^ (e & 15)) * 16) + jj * 2) = (bf16_t)f2bf(v[j] * sc);
        }
    }
}
DEVI bf16x8 frag_row(const LAS char* img, int row, int kk, int fq) { return *(const LAS bf16x8*)(img + row * 128 + (((kk * 4 + fq) ^ ((row >> 1) & 7)) * 16)); }
DEVI bf16x8 frag_T(const LAS char* img, int e, int kp, int fq) { return *(const LAS bf16x8*)(img + e * 256 + (((kp * 4 + fq) ^ (e & 15)) * 16)); }

DEVI void ph_ret_kv(const P& p, float* sm, int b0) {
    char* ws = ows(p);
    const bf16_t* proj = (const bf16_t*)(ws + WS_PROJ);
    float* kv = (float*)(ws + WS_KV);
    LAS char* lds = (LAS char*)sm;
    const int tid = otid(), lane = tid & 63, wid = tid >> 6, fr = lane & 15, fq = lane >> 4;
    if (obid() < b0) return;
    for (int item = obid() - b0; item < NBATCH * 64 * 6; item += gridDim.x - b0) {
        const int h = item % 6, n = (item / 6) % 64, b = item / 384;
        const float logg = (float)LOGG[h];
        const size_t tok0 = (size_t)b * S + n * 128;
        __syncthreads();
        ret_stage_T(lds, proj, tok0, 768 + h * 64, logg, 0, tid);
        ret_stage_T(lds + 16384, proj, tok0, 384 + h * 64, logg, 2, tid);
        __syncthreads();
        f32x4 acc[4];
#pragma unroll
        for (int dt = 0; dt < 4; ++dt) acc[dt] = (f32x4){0.f, 0.f, 0.f, 0.f};
#pragma unroll
        for (int kk = 0; kk < 4; ++kk) {
            const bf16x8 av = frag_T(lds, wid * 16 + fr, kk, fq);
#pragma unroll
            for (int dt = 0; dt < 4; ++dt) acc[dt] = __builtin_amdgcn_mfma_f32_16x16x32_bf16(av, frag_T(lds + 16384, dt * 16 + fr, kk, fq), acc[dt], 0, 0, 0);
        }
        float* o = kv + (size_t)item * 4096;
#pragma unroll
        for (int dt = 0; dt < 4; ++dt)
#pragma unroll
            for (int r = 0; r < 4; ++r) o[(wid * 16 + fq * 4 + r) * 64 + dt * 16 + fr] = acc[dt][r];
    }
}

DEVI void ph_ret_scan(const P& p) {
    float* kv = (float*)(ows(p) + WS_KV);
    const int total = NBATCH * 6 * 4096;
    for (int idx = obid() * NT + otid(); idx < total; idx += gridDim.x * NT) {
        const int de = idx & 4095, bh = idx >> 12, h = bh % 6, b = bh / 6;
        const float g = expf(128.f * (float)LOGG[h]);
        float st = 0.f;
        float* base = kv + ((size_t)(b * 64) * 6 + h) * 4096 + de;
        for (int n0 = 0; n0 < 64; n0 += 16) {
            float x[16];
#pragma unroll
            for (int j = 0; j < 16; ++j) x[j] = base[(size_t)(n0 + j) * 6 * 4096];
#pragma unroll
            for (int j = 0; j < 16; ++j) { const float xv = x[j]; x[j] = st; st = st * g + xv; }
#pragma unroll
            for (int j = 0; j < 16; ++j) base[(size_t)(n0 + j) * 6 * 4096] = x[j];
        }
    }
}

DEVI void ph_ret_out(const P& p, float* sm, int b0) {
    char* ws = ows(p);
    const bf16_t* proj = (const bf16_t*)(ws + WS_PROJ);
    const float* kv = (const float*)(ws + WS_KV);
    bf16_t* ycat = (bf16_t*)(ws + WS_YCAT);
    LAS char* lds = (LAS char*)sm;
    const LAS char* qs = lds; const LAS char* ks = lds + 16384; const LAS char* vt = lds + 32768;
    const int tid = otid(), lane = tid & 63, wid = tid >> 6, fr = lane & 15, fq = lane >> 4;
    if (obid() < b0) return;
    for (int item = obid() - b0; item < NBATCH * 64 * 6; item += gridDim.x - b0) {
        const int h = item % 6, n = (item / 6) % 64, b = item / 384;
        const float logg = (float)LOGG[h];
        const float gam = expf(logg);
        const size_t tok0 = (size_t)b * S + n * 128;
        __syncthreads();
        ret_stage_rows(lds, proj, tok0, h * 64, logg, 0, tid);
        ret_stage_rows(lds + 16384, proj, tok0, 384 + h * 64, logg, 1, tid);
        ret_stage_T(lds + 32768, proj, tok0, 768 + h * 64, logg, 0, tid);
        __syncthreads();
        const float* prevT = kv + (size_t)item * 4096;
#pragma unroll 1
        for (int qi = 0; qi < 2; ++qi) {
            const int qt = qi == 0 ? wid : 7 - wid;
            bf16x8 bq[2];
            bq[0] = frag_row(qs, qt * 16 + fr, 0, fq); bq[1] = frag_row(qs, qt * 16 + fr, 1, fq);
            f32x4 acc[4];
#pragma unroll
            for (int et = 0; et < 4; ++et) acc[et] = (f32x4){0.f, 0.f, 0.f, 0.f};
#pragma unroll
            for (int et = 0; et < 4; ++et)
#pragma unroll
                for (int kk = 0; kk < 2; ++kk) {
                    const float* src = prevT + (et * 16 + fr) * 64 + kk * 32 + fq * 8;
                    const float4 x0 = *(const float4*)src, x1 = *(const float4*)(src + 4);
                    const float v8[8] = {x0.x, x0.y, x0.z, x0.w, x1.x, x1.y, x1.z, x1.w};
                    acc[et] = __builtin_amdgcn_mfma_f32_16x16x32_bf16(pack8(v8), bq[kk], acc[et], 0, 0, 0);
                }
#pragma unroll
            for (int et = 0; et < 4; ++et) acc[et] = acc[et] * gam;
            for (int kp = 0; kp <= (qt >> 1); ++kp) {
                float pv[8];
#pragma unroll
                for (int a = 0; a < 2; ++a) {
                    const int kt = 2 * kp + a;
                    f32x4 sT = (f32x4){0.f, 0.f, 0.f, 0.f};
                    if (kt <= qt) {
                        sT = __builtin_amdgcn_mfma_f32_16x16x32_bf16(frag_row(ks, kt * 16 + fr, 0, fq), bq[0], sT, 0, 0, 0);
                        sT = __builtin_amdgcn_mfma_f32_16x16x32_bf16(frag_row(ks, kt * 16 + fr, 1, fq), bq[1], sT, 0, 0, 0);
                        if (kt == qt) {
#pragma unroll
                            for (int r = 0; r < 4; ++r) if (fq * 4 + r > fr) sT[r] = 0.f;
                        }
                    }
                    pv[a * 4 + 0] = sT[0]; pv[a * 4 + 1] = sT[1]; pv[a * 4 + 2] = sT[2]; pv[a * 4 + 3] = sT[3];
                }
                const bf16x8 pf = pack8(pv);
#pragma unroll
                for (int et = 0; et < 4; ++et)
                    acc[et] = __builtin_amdgcn_mfma_f32_16x16x32_bf16(frag_T(vt, et * 16 + fr, kp, fq), pf, acc[et], 0, 0, 0);
            }
            float sum = 0.f;
#pragma unroll
            for (int et = 0; et < 4; ++et) sum += (acc[et][0] + acc[et][1]) + (acc[et][2] + acc[et][3]);
            sum += __shfl_xor(sum, 16); sum += __shfl_xor(sum, 32);
            const float mean = sum * (1.f / 64.f);
            float var = 0.f;
#pragma unroll
            for (int et = 0; et < 4; ++et) { acc[et] = acc[et] - mean; var += (acc[et][0] * acc[et][0] + acc[et][1] * acc[et][1]) + (acc[et][2] * acc[et][2] + acc[et][3] * acc[et][3]); }
            var += __shfl_xor(var, 16); var += __shfl_xor(var, 32);
            const float rstd = 1.f / sqrtf(var * (1.f / 64.f) + LN_EPS);
            const size_t tok = tok0 + qt * 16 + fr;
#pragma unroll
            for (int et = 0; et < 4; ++et) {
                const u32x2 gu = *(const u32x2*)(proj + tok * INW + 1152 + h * 64 + et * 16 + fq * 4);
                const float g0 = bflo(gu.x), g1 = bfhi(gu.x), g2 = bflo(gu.y), g3 = bfhi(gu.y);
                u32x2 w;
                w.x = pk2(acc[et][0] * rstd * siluf_(g0), acc[et][1] * rstd * siluf_(g1));
                w.y = pk2(acc[et][2] * rstd * siluf_(g2), acc[et][3] * rstd * siluf_(g3));
                *(u32x2*)(ycat + tok * D + h * 64 + et * 16 + fq * 4) = w;
            }
        }
    }
}

constexpr int RC = 128, NCH = S / RC;

DEVI float zmix(const bf16_t* pc, int s, int col, const float* mu) {
    const float c = bf2f(pc[col]);
    const float pv = s > 0 ? bf2f(pc[col - INW]) : 0.f;
    return c + (pv - c) * mu[col];
}
DEVI void zmix8(const bf16_t* pc, int s, int col, const float* mu, float* z) {
    float c[8], pv[8];
    ld8bf(pc + col, c);
    if (s > 0) ld8bf(pc + col - INW, pv);
    else {
#pragma unroll
        for (int j = 0; j < 8; ++j) pv[j] = 0.f;
    }
    const float4 m0 = *(const float4*)(mu + col), m1 = *(const float4*)(mu + col + 4);
    const float m[8] = {m0.x, m0.y, m0.z, m0.w, m1.x, m1.y, m1.z, m1.w};
#pragma unroll
    for (int j = 0; j < 8; ++j) z[j] = c[j] + (pv[j] - c[j]) * m[j];
}
DEVI float quad_sum(float x) { x += dpp_mov<0xB1>(x); x += dpp_mov<0x4E>(x); return x; }

DEVI void ph_rwkv_prep(const P& p, int l, float* sm) {
    char* ws = ows(p);
    const bf16_t* proj = (const bf16_t*)(ws + WS_PROJ);
    float* rw = (float*)(ws + WS_RW);
    float* rs = (float*)(ws + WS_RS);
    const size_t A1 = (size_t)T * RW;
    const float* mu = p.in[I_MU] + l * RWSLAB;
    const float* w0 = p.in[I_W0] + l * RW; const float* w2 = p.in[I_W2] + (size_t)l * 64 * RW;
    const float* a0 = p.in[I_A0] + l * RW; const float* a2 = p.in[I_A2] + (size_t)l * 64 * RW;
    const float* k_k = p.in[I_KK] + l * RW; const float* k_a = p.in[I_KA] + l * RW; const float* r_k = p.in[I_RK] + l * RW;
    const int tid = otid(), tau = tid >> 2, cq = tid & 3;
    float* zx = sm;
    float* wx = sm + 4160;
    for (int item = obid(); item < (T / 64) * 6; item += gridDim.x) {
        const int h = item % 6, tile = item / 6;
        const int t = tile * 64 + tau, s = t & (S - 1);
        const int hc = h * 64 + cq * 16;
        float u[16], av[16];
#pragma unroll
        for (int pass = 0; pass < 2; ++pass) {
            __syncthreads();
            for (int i = tid; i < 512; i += NT) {
                const int tt = i >> 3, j8 = (i & 7) * 8;
                const int t2 = tile * 64 + tt;
                float z[8];
                zmix8(proj + (size_t)t2 * INW + C_RWKV, t2 & (S - 1), (pass == 0 ? 1152 : 1216) + j8, mu, z);
#pragma unroll
                for (int j = 0; j < 8; ++j) zx[tt * 65 + j8 + j] = pass == 0 ? ftanh(z[j]) : z[j];
            }
            const float* wsrc = pass == 0 ? w2 : a2;
            for (int i = tid; i < 1024; i += NT) {
                const int j = i >> 4, c4 = (i & 15) * 4;
                *(float4*)(wx + j * 64 + c4) = *(const float4*)(wsrc + (size_t)j * RW + h * 64 + c4);
            }
            __syncthreads();
            float acc[16];
#pragma unroll
            for (int cc = 0; cc < 16; ++cc) acc[cc] = 0.f;
#pragma unroll 4
            for (int j = 0; j < 64; ++j) {
                const float zv = zx[tau * 65 + j];
#pragma unroll
                for (int c4 = 0; c4 < 4; ++c4) {
                    const float4 w4 = *(const float4*)(wx + j * 64 + cq * 16 + c4 * 4);
                    acc[c4 * 4] += zv * w4.x; acc[c4 * 4 + 1] += zv * w4.y; acc[c4 * 4 + 2] += zv * w4.z; acc[c4 * 4 + 3] += zv * w4.w;
                }
            }
#pragma unroll
            for (int cc = 0; cc < 16; ++cc) { if (pass == 0) u[cc] = acc[cc]; else av[cc] = acc[cc]; }
        }
        const bf16_t* pc = proj + (size_t)t * INW + C_RWKV;
        float kr[16], rr[16];
        zmix8(pc, s, 384 + hc, mu, kr); zmix8(pc, s, 384 + hc + 8, mu, kr + 8);
        zmix8(pc, s, hc, mu, rr); zmix8(pc, s, hc + 8, mu, rr + 8);
        float kk[16], n2 = 0.f, rsum = 0.f;
        float dec[16], nb[16], km[16];
#pragma unroll
        for (int cc = 0; cc < 16; ++cc) {
            const int c = hc + cc;
            const float wl = -softplusf_(-(u[cc] + w0[c])) - 0.5f;
            dec[cc] = fexp(-fexp(wl));
            const float a = sigmoidf_(av[cc] + a0[c]);
            kk[cc] = kr[cc] * k_k[c];
            n2 += kk[cc] * kk[cc];
            km[cc] = kr[cc] * (1.f + (a - 1.f) * k_a[c]);
            rsum += rr[cc] * km[cc] * r_k[c];
            av[cc] = a;
        }
        n2 = quad_sum(n2); rsum = quad_sum(rsum);
        const float inv = 1.f / fmaxf(sqrtf(n2), 1e-12f);
#pragma unroll
        for (int cc = 0; cc < 16; ++cc) { kk[cc] *= inv; nb[cc] = -kk[cc] * av[cc]; }
        const size_t o = (size_t)t * RW + hc;
        bf16_t* rwb = (bf16_t*)(rw + A1);
#pragma unroll
        for (int c4 = 0; c4 < 4; ++c4)
            *(float4*)(rw + o + c4 * 4) = make_float4(dec[c4 * 4], dec[c4 * 4 + 1], dec[c4 * 4 + 2], dec[c4 * 4 + 3]);
        *(bf16x8*)(rwb + 0 * A1 + o) = pack8(kk); *(bf16x8*)(rwb + 0 * A1 + o + 8) = pack8(kk + 8);
        *(bf16x8*)(rwb + 1 * A1 + o) = pack8(nb); *(bf16x8*)(rwb + 1 * A1 + o + 8) = pack8(nb + 8);
        *(bf16x8*)(rwb + 2 * A1 + o) = pack8(km); *(bf16x8*)(rwb + 2 * A1 + o + 8) = pack8(km + 8);
        if (cq == 0) rs[(size_t)t * 6 + h] = rsum;
    }
}

struct RwOps { float4 kk, w, nb, k, r; float v0, v1, v2, v3; };
DEVI void rw_load(RwOps& o, const float* sm, const float* smV, int tt, int kq, int rl) {
    o.kk = *(const float4*)(sm + 0 * 2048 + tt * 64 + kq * 4);
    o.w = *(const float4*)(sm + 1 * 2048 + tt * 64 + kq * 4);
    o.nb = *(const float4*)(sm + 2 * 2048 + tt * 64 + kq * 4);
    o.k = *(const float4*)(sm + 3 * 2048 + tt * 64 + kq * 4);
    o.r = *(const float4*)(sm + 4 * 2048 + tt * 64 + kq * 4);
    o.v0 = smV[tt * 64 + rl]; o.v1 = smV[tt * 64 + 16 + rl]; o.v2 = smV[tt * 64 + 32 + rl]; o.v3 = smV[tt * 64 + 48 + rl];
}
DEVI float dot4(const float4& a, const float4& b) { return (a.x * b.x + a.y * b.y) + (a.z * b.z + a.w * b.w); }
DEVI void upd4(float4& s, const RwOps& o, float d, float vv) {
    s.x = s.x * o.w.x + d * o.nb.x + vv * o.k.x; s.y = s.y * o.w.y + d * o.nb.y + vv * o.k.y;
    s.z = s.z * o.w.z + d * o.nb.z + vv * o.k.z; s.w = s.w * o.w.w + d * o.nb.w + vv * o.k.w;
}
#define RED16x4(a, b, c, d) do { \
    a += dpp_mov<0xB1>(a); b += dpp_mov<0xB1>(b); c += dpp_mov<0xB1>(c); d += dpp_mov<0xB1>(d); \
    a += dpp_mov<0x4E>(a); b += dpp_mov<0x4E>(b); c += dpp_mov<0x4E>(c); d += dpp_mov<0x4E>(d); \
    a += dpp_mov<0x141>(a); b += dpp_mov<0x141>(b); c += dpp_mov<0x141>(c); d += dpp_mov<0x141>(d); \
    a += dpp_mov<0x140>(a); b += dpp_mov<0x140>(b); c += dpp_mov<0x140>(c); d += dpp_mov<0x140>(d); } while (0)
DEVI void rw_step4(float4 (&st)[4], const RwOps& o, float& y0, float& y1, float& y2, float& y3) {
    float d0 = dot4(st[0], o.kk), d1 = dot4(st[1], o.kk), d2 = dot4(st[2], o.kk), d3 = dot4(st[3], o.kk);
    RED16x4(d0, d1, d2, d3);
    upd4(st[0], o, d0, o.v0); upd4(st[1], o, d1, o.v1); upd4(st[2], o, d2, o.v2); upd4(st[3], o, d3, o.v3);
    y0 = dot4(st[0], o.r); y1 = dot4(st[1], o.r); y2 = dot4(st[2], o.r); y3 = dot4(st[3], o.r);
    RED16x4(y0, y1, y2, y3);
}
DEVI void ph_rwkv_chunk(const P& p, int l, float* sm) {
    char* ws = ows(p);
    const bf16_t* proj = (const bf16_t*)(ws + WS_PROJ);
    const float* rw = (const float*)(ws + WS_RW);
    const size_t A1 = (size_t)T * RW;
    bf16_t* pt = (bf16_t*)(ws + WS_PT);
    bf16_t* yt = (bf16_t*)(ws + WS_RWY);
    float* pq = (float*)(ws + WS_PQ);
    const float* mu = p.in[I_MU] + l * RWSLAB;
    const int tid = otid(), lane = tid & 63, wv = tid >> 6;
    const int rl = wv * 4 + (lane >> 4), kq = lane & 15;
    float* smV = sm + 5 * 2048;
    float* smY = smV + 2048;
    for (int item = obid(); item < 12 * NCH * 2; item += gridDim.x) {
        const int half = item & 1, c = (item >> 1) % NCH, bh = item / (2 * NCH), b = bh / 6, h = bh % 6;
        float4 st[4];
#pragma unroll
        for (int j = 0; j < 4; ++j) {
            const int row = j * 16 + rl;
            st[j].x = (half == 0 && kq * 4 + 0 == row) ? 1.f : 0.f;
            st[j].y = (half == 0 && kq * 4 + 1 == row) ? 1.f : 0.f;
            st[j].z = (half == 0 && kq * 4 + 2 == row) ? 1.f : 0.f;
            st[j].w = (half == 0 && kq * 4 + 3 == row) ? 1.f : 0.f;
        }
        for (int t0 = c * RC; t0 < (c + 1) * RC; t0 += 32) {
            __syncthreads();
            for (int i = tid; i < 512; i += NT) {
                const int tt = i >> 4, k4 = (i & 15) * 4;
                *(float4*)(sm + 1 * 2048 + tt * 64 + k4) = *(const float4*)(rw + ((size_t)b * S + t0 + tt) * RW + h * 64 + k4);
            }
            {
                const int tt = tid >> 3, k8 = (tid & 7) * 8;
                const bf16_t* rwb = (const bf16_t*)(rw + A1) + ((size_t)b * S + t0 + tt) * RW + h * 64 + k8;
                ld8bf(rwb + 0 * A1, sm + 0 * 2048 + tt * 64 + k8);
                ld8bf(rwb + 1 * A1, sm + 2 * 2048 + tt * 64 + k8);
                ld8bf(rwb + 2 * A1, sm + 3 * 2048 + tt * 64 + k8);
            }
            {
                const int tt = tid >> 3, k8 = (tid & 7) * 8;
                const bf16_t* pc = proj + ((size_t)b * S + t0 + tt) * INW + C_RWKV;
                float z[8];
                zmix8(pc, t0 + tt, h * 64 + k8, mu, z);
#pragma unroll
                for (int j = 0; j < 8; ++j) sm[4 * 2048 + tt * 64 + k8 + j] = z[j];
                if (half) zmix8(pc, t0 + tt, 768 + h * 64 + k8, mu, z);
#pragma unroll
                for (int j = 0; j < 8; ++j) smV[tt * 64 + k8 + j] = half ? z[j] : 0.f;
            }
            __syncthreads();
            RwOps cur, nxt;
            rw_load(cur, sm, smV, 0, kq, rl);
#pragma unroll 2
            for (int tt = 0; tt < 32; ++tt) {
                rw_load(nxt, sm, smV, (tt + 1) & 31, kq, rl);
                float y0, y1, y2, y3;
                rw_step4(st, cur, y0, y1, y2, y3);
                if (kq < 4) smY[tt * 64 + kq * 16 + rl] = kq == 0 ? y0 : (kq == 1 ? y1 : (kq == 2 ? y2 : y3));
                cur = nxt;
            }
            __syncthreads();
            {
                bf16_t* dst = half ? yt : pt;
                const int tt = tid >> 3, k8 = (tid & 7) * 8;
                *(bf16x8*)(dst + ((size_t)b * S + t0 + tt) * RW + h * 64 + k8) = pack8(smY + tt * 64 + k8);
            }
        }
#pragma unroll
        for (int j = 0; j < 4; ++j)
            *(float4*)(pq + ((size_t)((bh * NCH + c) * 2 + half)) * 4096 + (j * 16 + rl) * 64 + kq * 4) = st[j];
    }
}

DEVI f32x4 mma_tile(f32x4 acc, const float* A, int a_rs, int a_cs, const float* B, int b_rs, int b_cs, int K, int lr, int lq) {
#pragma unroll 4
    for (int ks = 0; ks < K; ks += 4) {
        const float a = A[lr * a_rs + (ks + lq) * a_cs];
        const float b = B[(ks + lq) * b_rs + lr * b_cs];
        acc = __builtin_amdgcn_mfma_f32_16x16x4f32(a, b, acc, 0, 0, 0);
    }
    return acc;
}
constexpr int WB = 16;
DEVI void ph_rwkv_chunk_wy(const P& p, int l, float* sm) {
    char* ws = ows(p);
    const bf16_t* proj = (const bf16_t*)(ws + WS_PROJ);
    const float* rw = (const float*)(ws + WS_RW);
    const size_t A1 = (size_t)T * RW;
    bf16_t* pt = (bf16_t*)(ws + WS_PT);
    bf16_t* yt = (bf16_t*)(ws + WS_RWY);
    float* pq = (float*)(ws + WS_PQ);
    const float* mu = p.in[I_MU] + l * RWSLAB;
    const int tid = otid(), lane = tid & 63, wid = tid >> 6, lr = lane & 15, lq = lane >> 4;
    float* rKK = sm;
    float* rW = sm + 1024; float* rNB = sm + 2048; float* rK = sm + 3072; float* rR = sm + 4096;
    float* xt = sm + 5120;
    float* At = sm + 6144;
    float* Bt = At + 1040; float* Kt = At + 2080; float* Rt = At + 3120;
    float* Sm = sm + 10304;
    float* WL = sm + 14464;
    float* Eb = sm;
    float* Lab = sm + 1040; float* Lak = Lab + 272; float* Lrb = Lak + 272; float* Lrk = Lrb + 272;
    float* Tm = Lrk + 272;
    for (int item = obid(); item < 12 * NCH * 2; item += gridDim.x) {
        const int half = item & 1, c = (item >> 1) % NCH, bh = item / (2 * NCH), b = bh / 6, h = bh % 6;
        __syncthreads();
        for (int i = tid; i < 64 * 64; i += NT) { const int r = i >> 6, k = i & 63; Sm[r * 65 + k] = (half == 0 && r == k) ? 1.f : 0.f; }
        for (int t0 = c * RC; t0 < (c + 1) * RC; t0 += WB) {
            __syncthreads();
            {
                const int tt = tid >> 4, k4 = (tid & 15) * 4;
                *(float4*)(rW + tt * 64 + k4) = *(const float4*)(rw + ((size_t)b * S + t0 + tt) * RW + h * 64 + k4);
            }
            if (tid < WB * 8) {
                const int tt = tid >> 3, k8 = (tid & 7) * 8;
                const bf16_t* rwb = (const bf16_t*)(rw + A1) + ((size_t)b * S + t0 + tt) * RW + h * 64 + k8;
                ld8bf(rwb + 0 * A1, rKK + tt * 64 + k8);
                ld8bf(rwb + 1 * A1, rNB + tt * 64 + k8);
                ld8bf(rwb + 2 * A1, rK + tt * 64 + k8);
                const bf16_t* pc = proj + ((size_t)b * S + t0 + tt) * INW + C_RWKV;
                float z[8];
                zmix8(pc, t0 + tt, h * 64 + k8, mu, z);
#pragma unroll
                for (int j = 0; j < 8; ++j) rR[tt * 64 + k8 + j] = z[j];
                if (half) zmix8(pc, t0 + tt, 768 + h * 64 + k8, mu, z);
#pragma unroll
                for (int j = 0; j < 8; ++j) xt[tt * 64 + k8 + j] = half ? z[j] : 0.f;
            }
            __syncthreads();
            {
                const int k = tid & 63, q = tid >> 6;
                float Wp = 1.f;
                for (int t = 0; t < 4 * q; ++t) Wp *= rW[t * 64 + k];
#pragma unroll
                for (int j = 0; j < 4; ++j) {
                    const int t = 4 * q + j;
                    const float wv = rW[t * 64 + k];
                    const float Wt = Wp * wv, inv = 1.f / Wt;
                    At[t * 65 + k] = Wp * rKK[t * 64 + k];
                    Bt[t * 65 + k] = rNB[t * 64 + k] * inv;
                    Kt[t * 65 + k] = rK[t * 64 + k] * inv;
                    Rt[t * 65 + k] = Wt * rR[t * 64 + k];
                    Wp = Wt;
                }
                if (q == 3) WL[k] = Wp;
            }
            __syncthreads();
            f32x4 e = (f32x4){0.f, 0.f, 0.f, 0.f}, y = e;
            {
                const float* ga = (wid < 2) ? At : Rt;
                const float* gb = (wid & 1) ? Kt : Bt;
                f32x4 g = mma_tile((f32x4){0.f, 0.f, 0.f, 0.f}, ga, 65, 1, gb, 1, 65, 64, lr, lq);
                float* gd = wid == 0 ? Lab : (wid == 1 ? Lak : (wid == 2 ? Lrb : Lrk));
#pragma unroll
                for (int r = 0; r < 4; ++r) {
                    const int t = 4 * lq + r;
                    const bool keep = wid < 2 ? (lr < t) : (lr <= t);
                    gd[t * 17 + lr] = keep ? g[r] : 0.f;
                }
                e = mma_tile(e, At, 65, 1, Sm + 16 * wid * 65, 1, 65, 64, lr, lq);
                y = mma_tile(y, Rt, 65, 1, Sm + 16 * wid * 65, 1, 65, 64, lr, lq);
            }
            __syncthreads();
            if (half) {
                e = mma_tile(e, Lak, 17, 1, xt + 16 * wid, 64, 1, 16, lr, lq);
                y = mma_tile(y, Lrk, 17, 1, xt + 16 * wid, 64, 1, 16, lr, lq);
            }
#pragma unroll
            for (int r = 0; r < 4; ++r) Eb[(4 * lq + r) * 65 + 16 * wid + lr] = e[r];
            if (tid < 16) {
                float tc[16];
#pragma unroll
                for (int t = 0; t < 16; ++t) tc[t] = (t == tid) ? 1.f : 0.f;
#pragma unroll
                for (int j = 0; j < 15; ++j) {
                    const float tj = tc[j];
#pragma unroll
                    for (int t = j + 1; t < 16; ++t) tc[t] += Lab[t * 17 + j] * tj;
                }
#pragma unroll
                for (int t = 0; t < 16; ++t) Tm[t * 17 + tid] = tc[t];
            }
            __syncthreads();
            {
                f32x4 d = mma_tile((f32x4){0.f, 0.f, 0.f, 0.f}, Tm, 17, 1, Eb + 16 * wid, 65, 1, 16, lr, lq);
#pragma unroll
                for (int r = 0; r < 4; ++r) Eb[(4 * lq + r) * 65 + 16 * wid + lr] = d[r];
                y = mma_tile(y, Lrb, 17, 1, Eb + 16 * wid, 65, 1, 16, lr, lq);
                bf16_t* dst = (half ? yt : pt) + ((size_t)b * S + t0) * RW + h * 64 + 16 * wid + lr;
#pragma unroll
                for (int r = 0; r < 4; ++r) dst[(size_t)(4 * lq + r) * RW] = (bf16_t)f2bf(y[r]);
            }
            __syncthreads();
#pragma unroll
            for (int n = 0; n < 4; ++n) {
                f32x4 sa;
#pragma unroll
                for (int r = 0; r < 4; ++r) sa[r] = Sm[(16 * wid + 4 * lq + r) * 65 + 16 * n + lr];
                sa = mma_tile(sa, Eb + 16 * wid, 1, 65, Bt + 16 * n, 65, 1, 16, lr, lq);
                if (half) sa = mma_tile(sa, xt + 16 * wid, 1, 64, Kt + 16 * n, 65, 1, 16, lr, lq);
                const float wl = WL[16 * n + lr];
#pragma unroll
                for (int r = 0; r < 4; ++r) Sm[(16 * wid + 4 * lq + r) * 65 + 16 * n + lr] = sa[r] * wl;
            }
        }
        __syncthreads();
        float* o = pq + ((size_t)((bh * NCH + c) * 2 + half)) * 4096;
        for (int i = tid; i < 64 * 64; i += NT) o[i] = Sm[(i >> 6) * 65 + (i & 63)];
    }
}

DEVI void ph_rwkv_seq(const P& p, float* sm) {
    char* ws = ows(p);
    const float* pq = (const float*)(ws + WS_PQ);
    float* s0buf = (float*)(ws + WS_S0);
    const int tid = otid(), lane = tid & 63, wid = tid >> 6, lr = lane & 15, lq = lane >> 4;
    float* psm = sm;
    float* ssm = sm + 8192;
    if (obid() >= 48) return;
    const int bh = obid() >> 2, vg = obid() & 3;
    f32x4 st = (f32x4){0.f, 0.f, 0.f, 0.f};
    __syncthreads();
    {
        const float* P0 = pq + ((size_t)(bh * NCH) * 2) * 4096;
#pragma unroll
        for (int i = 0; i < 4; ++i) *(float4*)(psm + (tid + i * 256) * 4) = *(const float4*)(P0 + (tid + i * 256) * 4);
    }
    for (int c = 0; c < NCH; ++c) {
        float* s0t = s0buf + (size_t)(bh * NCH + c) * 4096;
        float* sc = ssm + (c & 1) * 1088;
#pragma unroll
        for (int r = 0; r < 4; ++r) {
            s0t[(16 * wid + lr) * 64 + vg * 16 + 4 * lq + r] = st[r];
            sc[(16 * wid + lr) * 17 + 4 * lq + r] = st[r];
        }
        __syncthreads();
        const int cn = c + 1 < NCH ? c + 1 : c;
        const float* Pn = pq + ((size_t)(bh * NCH + cn) * 2) * 4096;
        const float4 pre0 = *(const float4*)(Pn + (tid + 0 * 256) * 4), pre1 = *(const float4*)(Pn + (tid + 1 * 256) * 4);
        const float4 pre2 = *(const float4*)(Pn + (tid + 2 * 256) * 4), pre3 = *(const float4*)(Pn + (tid + 3 * 256) * 4);
        const float* qsrc = pq + ((size_t)(bh * NCH + c) * 2 + 1) * 4096 + (vg * 16 + 4 * lq) * 64 + 16 * wid + lr;
        const float q0 = qsrc[0], q1 = qsrc[64], q2 = qsrc[128], q3 = qsrc[192];
        const float* pc = psm + (c & 1) * 4096;
        f32x4 acc0 = (f32x4){0.f, 0.f, 0.f, 0.f}, acc1 = (f32x4){0.f, 0.f, 0.f, 0.f};
#pragma unroll
        for (int ks = 0; ks < 16; ks += 2) {
            const float a0 = sc[(4 * ks + lq) * 17 + lr], b0 = pc[(4 * ks + lq) * 64 + 16 * wid + lr];
            const float a1 = sc[(4 * ks + 4 + lq) * 17 + lr], b1 = pc[(4 * ks + 4 + lq) * 64 + 16 * wid + lr];
            acc0 = __builtin_amdgcn_mfma_f32_16x16x4f32(a0, b0, acc0, 0, 0, 0);
            acc1 = __builtin_amdgcn_mfma_f32_16x16x4f32(a1, b1, acc1, 0, 0, 0);
        }
        st[0] = acc0[0] + acc1[0] + q0; st[1] = acc0[1] + acc1[1] + q1; st[2] = acc0[2] + acc1[2] + q2; st[3] = acc0[3] + acc1[3] + q3;
        {
            float* pn = psm + ((c + 1) & 1) * 4096;
            *(float4*)(pn + (tid + 0 * 256) * 4) = pre0; *(float4*)(pn + (tid + 1 * 256) * 4) = pre1;
            *(float4*)(pn + (tid + 2 * 256) * 4) = pre2; *(float4*)(pn + (tid + 3 * 256) * 4) = pre3;
        }
    }
}

DEVI void ph_rwkv_post(const P& p, int l, float* sm) {
    char* ws = ows(p);
    const bf16_t* proj = (const bf16_t*)(ws + WS_PROJ);
    const bf16_t* pt = (const bf16_t*)(ws + WS_PT);
    const bf16_t* yt = (const bf16_t*)(ws + WS_RWY);
    const float* s0buf = (const float*)(ws + WS_S0);
    const float* rs = (const float*)(ws + WS_RS);
    bf16_t* ycat = (bf16_t*)(ws + WS_YCAT);
    const float* mu = p.in[I_MU] + l * RWSLAB;
    const float* g2 = p.in[I_G2] + (size_t)l * 128 * RW;
    const float* gng = p.in[I_GNG] + l * RW; const float* gnb = p.in[I_GNB] + l * RW;
    const int tid = otid(), tau = tid >> 2, vq = tid & 3;
    float* xs = sm;
    float* ms = sm + 4160;
    for (int item = obid(); item < 12 * (S / 64); item += gridDim.x) {
        const int tile = item % (S / 64), bh = item / (S / 64), b = bh / 6, h = bh % 6;
        const int s = tile * 64 + tau;
        const size_t t = (size_t)b * S + s;
        const int c = (tile * 64) / RC;
        const int hv = h * 64 + vq * 16;
        __syncthreads();
        for (int i = tid; i < 1024; i += NT) {
            const int tt = i >> 4, i4 = (i & 15) * 4;
            const float4 x = ld4bf(pt + ((size_t)b * S + tile * 64 + tt) * RW + h * 64 + i4);
            xs[tt * 65 + i4] = x.x; xs[tt * 65 + i4 + 1] = x.y; xs[tt * 65 + i4 + 2] = x.z; xs[tt * 65 + i4 + 3] = x.w;
            *(float4*)(ms + i * 4) = *(const float4*)(s0buf + (size_t)(bh * NCH + c) * 4096 + i * 4);
        }
        __syncthreads();
        float y[16];
#pragma unroll
        for (int c4 = 0; c4 < 4; ++c4) {
            const float4 x = ld4bf(yt + t * RW + hv + c4 * 4);
            y[c4 * 4] = x.x; y[c4 * 4 + 1] = x.y; y[c4 * 4 + 2] = x.z; y[c4 * 4 + 3] = x.w;
        }
#pragma unroll 4
        for (int i = 0; i < 64; ++i) {
            const float pv = xs[tau * 65 + i];
#pragma unroll
            for (int c4 = 0; c4 < 4; ++c4) {
                const float4 m4 = *(const float4*)(ms + i * 64 + vq * 16 + c4 * 4);
                y[c4 * 4] += pv * m4.x; y[c4 * 4 + 1] += pv * m4.y; y[c4 * 4 + 2] += pv * m4.z; y[c4 * 4 + 3] += pv * m4.w;
            }
        }
        float g[16];
#pragma unroll
        for (int cc = 0; cc < 16; ++cc) g[cc] = 0.f;
        for (int jh = 0; jh < 2; ++jh) {
            __syncthreads();
            for (int i = tid; i < 512; i += NT) {
                const int tt = i >> 3, j8 = (i & 7) * 8;
                const int s2 = tile * 64 + tt;
                float z[8];
                zmix8(proj + ((size_t)b * S + s2) * INW + C_RWKV, s2, 1280 + jh * 64 + j8, mu, z);
#pragma unroll
                for (int j = 0; j < 8; ++j) xs[tt * 65 + j8 + j] = sigmoidf_(z[j]);
            }
            for (int i = tid; i < 1024; i += NT) {
                const int j = i >> 4, c4 = (i & 15) * 4;
                *(float4*)(ms + j * 64 + c4) = *(const float4*)(g2 + (size_t)(jh * 64 + j) * RW + h * 64 + c4);
            }
            __syncthreads();
#pragma unroll 4
            for (int j = 0; j < 64; ++j) {
                const float zv = xs[tau * 65 + j];
#pragma unroll
                for (int c4 = 0; c4 < 4; ++c4) {
                    const float4 m4 = *(const float4*)(ms + j * 64 + vq * 16 + c4 * 4);
                    g[c4 * 4] += zv * m4.x; g[c4 * 4 + 1] += zv * m4.y; g[c4 * 4 + 2] += zv * m4.z; g[c4 * 4 + 3] += zv * m4.w;
                }
            }
        }
        float sum = 0.f;
#pragma unroll
        for (int cc = 0; cc < 16; ++cc) sum += y[cc];
        const float mean = quad_sum(sum) * (1.f / 64.f);
        float var = 0.f;
#pragma unroll
        for (int cc = 0; cc < 16; ++cc) { y[cc] -= mean; var += y[cc] * y[cc]; }
        const float rstd = 1.f / sqrtf(quad_sum(var) * (1.f / 64.f) + 64e-5f);
        const float rsv = rs[t * 6 + h];
        float vv[16];
        const bf16_t* pc = proj + t * INW + C_RWKV;
        zmix8(pc, s, 768 + hv, mu, vv); zmix8(pc, s, 768 + hv + 8, mu, vv + 8);
        float o[16];
#pragma unroll
        for (int cc = 0; cc < 16; ++cc) o[cc] = (y[cc] * rstd * gng[hv + cc] + gnb[hv + cc] + rsv * vv[cc]) * g[cc];
        u32x4 w0, w1;
        w0.x = pk2(o[0], o[1]); w0.y = pk2(o[2], o[3]); w0.z = pk2(o[4], o[5]); w0.w = pk2(o[6], o[7]);
        w1.x = pk2(o[8], o[9]); w1.y = pk2(o[10], o[11]); w1.z = pk2(o[12], o[13]); w1.w = pk2(o[14], o[15]);
        bf16_t* op = ycat + t * D + 384 + hv;
        *(u32x4*)op = w0; *(u32x4*)(op + 8) = w1;
    }
}

DEVI void ph_lru_prep(const P& p, int l, float* sm) {
    char* ws = ows(p);
    const bf16_t* proj = (const bf16_t*)(ws + WS_PROJ);
    float* la = (float*)(ws + WS_LA); float* lb = (float*)(ws + WS_LB);
    float* ca = (float*)(ws + WS_LC); float* cb2 = ca + NBATCH * 128 * LW;
    const float* cw = p.in[I_CW] + l * 4 * LW; const float* cb = p.in[I_CB] + l * LW;
    const float* wa = p.in[I_WA] + (size_t)l * 4 * 4096; const float* ba = p.in[I_BA] + l * LW;
    const float* wx = p.in[I_WX] + (size_t)l * 4 * 4096; const float* bx = p.in[I_BX] + l * LW;
    const float* lam = p.in[I_LAM] + l * LW;
    const int tid = otid(), tau = tid >> 2, jq = tid & 3;
    float* xs = sm;
    float* was = sm + 4160;
    float* wxs = sm + 8256;
    for (int item = obid(); item < (T / 64) * 4; item += gridDim.x) {
        const int hb = item & 3, tile = item >> 2;
        const int t = tile * 64 + tau, s = t & (S - 1);
        const int ch0 = hb * 64 + jq * 16;
        __syncthreads();
        float xc[16];
        {
            float raw[4][16];
#pragma unroll
            for (int q = 0; q < 4; ++q) {
                if (s - 3 + q >= 0) {
                    const bf16_t* src = proj + (size_t)(t - 3 + q) * INW + C_LRU + ch0;
                    ld8bf(src, raw[q]); ld8bf(src + 8, raw[q] + 8);
                } else {
#pragma unroll
                    for (int j = 0; j < 16; ++j) raw[q][j] = 0.f;
                }
            }
#pragma unroll
            for (int j = 0; j < 16; ++j) {
                const int ch = ch0 + j;
                xc[j] = cb[ch] + cw[ch] * raw[0][j] + cw[LW + ch] * raw[1][j] + cw[2 * LW + ch] * raw[2][j] + cw[3 * LW + ch] * raw[3][j];
                xs[tau * 65 + jq * 16 + j] = xc[j];
            }
        }
        for (int i = tid; i < 1024; i += NT) {
            *(float4*)(was + i * 4) = *(const float4*)(wa + (size_t)hb * 4096 + i * 4);
            *(float4*)(wxs + i * 4) = *(const float4*)(wx + (size_t)hb * 4096 + i * 4);
        }
        __syncthreads();
        float ra[16], ia[16];
#pragma unroll
        for (int j = 0; j < 16; ++j) { ra[j] = ba[ch0 + j]; ia[j] = bx[ch0 + j]; }
#pragma unroll 2
        for (int i = 0; i < 64; ++i) {
            const float xv = xs[tau * 65 + i];
#pragma unroll
            for (int c4 = 0; c4 < 4; ++c4) {
                const float4 a4 = *(const float4*)(was + i * 64 + jq * 16 + c4 * 4);
                const float4 x4 = *(const float4*)(wxs + i * 64 + jq * 16 + c4 * 4);
                ra[c4 * 4] += xv * a4.x; ra[c4 * 4 + 1] += xv * a4.y; ra[c4 * 4 + 2] += xv * a4.z; ra[c4 * 4 + 3] += xv * a4.w;
                ia[c4 * 4] += xv * x4.x; ia[c4 * 4 + 1] += xv * x4.y; ia[c4 * 4 + 2] += xv * x4.z; ia[c4 * 4 + 3] += xv * x4.w;
            }
        }
        __syncthreads();
#pragma unroll
        for (int j = 0; j < 16; ++j) {
            const float r = sigmoidf_(ra[j]), ig = sigmoidf_(ia[j]);
            const float lga = -8.f * r * softplusf_(-lam[ch0 + j]);
            ra[j] = fexp(lga);
            ia[j] = sqrtf(-expm1f(2.f * lga)) * (ig * xc[j]);
            was[tau * 64 + jq * 16 + j] = ra[j];
            wxs[tau * 64 + jq * 16 + j] = ia[j];
        }
#pragma unroll
        for (int c4 = 0; c4 < 4; ++c4) {
            *(float4*)(la + (size_t)t * LW + ch0 + c4 * 4) = make_float4(ra[c4 * 4], ra[c4 * 4 + 1], ra[c4 * 4 + 2], ra[c4 * 4 + 3]);
            *(float4*)(lb + (size_t)t * LW + ch0 + c4 * 4) = make_float4(ia[c4 * 4], ia[c4 * 4 + 1], ia[c4 * 4 + 2], ia[c4 * 4 + 3]);
        }
        __syncthreads();
        if (tid < 64) {
            float A = 1.f, Bv = 0.f;
            for (int tt = 0; tt < 64; ++tt) { const float a = was[tt * 64 + tid]; A *= a; Bv = a * Bv + wxs[tt * 64 + tid]; }
            ca[(size_t)tile * LW + hb * 64 + tid] = A; cb2[(size_t)tile * LW + hb * 64 + tid] = Bv;
        }
    }
}
DEVI void ph_lru_carry(const P& p) {
    char* ws = ows(p);
    const float* ca = (const float*)(ws + WS_LC); const float* cb = ca + NBATCH * 128 * LW;
    float* hin = (float*)(ws + WS_LC) + 2 * NBATCH * 128 * LW;
    for (int idx = obid() * NT + otid(); idx < NBATCH * LW; idx += gridDim.x * NT) {
        const int c = idx & 255, b = idx >> 8;
        float h = 0.f;
        for (int n0 = 0; n0 < 128; n0 += 16) {
            float a[16], bb[16];
#pragma unroll
            for (int j = 0; j < 16; ++j) { const int o = (b * 128 + n0 + j) * LW + c; a[j] = ca[o]; bb[j] = cb[o]; }
#pragma unroll
            for (int j = 0; j < 16; ++j) { const float hv = h; h = a[j] * h + bb[j]; a[j] = hv; }
#pragma unroll
            for (int j = 0; j < 16; ++j) hin[(b * 128 + n0 + j) * LW + c] = a[j];
        }
    }
}
DEVI void ph_lru_out(const P& p, int b0) {
    char* ws = ows(p);
    const bf16_t* proj = (const bf16_t*)(ws + WS_PROJ);
    const float* la = (const float*)(ws + WS_LA); const float* lb = (const float*)(ws + WS_LB);
    const float* hin = (const float*)(ws + WS_LC) + 2 * NBATCH * 128 * LW;
    bf16_t* ycat = (bf16_t*)(ws + WS_YCAT);
    const int c = otid();
    if (obid() < b0) return;
    for (int tile = obid() - b0; tile < T / 64; tile += gridDim.x - b0) {
        float h = hin[(size_t)tile * LW + c];
#pragma unroll 4
        for (int i = 0; i < 64; ++i) {
            const size_t tok = (size_t)tile * 64 + i;
            h = la[tok * LW + c] * h + lb[tok * LW + c];
            ycat[tok * D + 768 + c] = (bf16_t)f2bf(h * gelu_tanh(bf2f(proj[tok * INW + C_LRU + 256 + c])));
        }
    }
}

DEVI void ph_ln1_router(const P& p, int l, float* sm) {
    char* ws = ows(p);
    const bf16_t* mix = (const bf16_t*)(ws + WS_MIX);
    bf16_t* x1b = (bf16_t*)(ws + WS_X1B);
    int* cnt = (int*)(ws + WS_CNT) + l * NE;
    int* list = (int*)(ws + WS_LIST);
    int* tinfo = (int*)(ws + WS_TINFO);
    float* tw = (float*)(ws + WS_TW);
    const float* wg = p.in[I_MWG] + (size_t)l * D * 4; const float* bg = p.in[I_MBG] + l * 4;
    const float* we = p.in[I_MWE] + (size_t)l * D * NE; const float* be = p.in[I_MBE] + l * NE;
    const int tid = otid(), lane = tid & 63, wid = tid >> 6;
    float* xs = sm;
    float* part = sm + 8192;
    float* lgs = sm + 8192 + 1280;
    for (int rb = obid(); rb < T / 8; rb += gridDim.x) {
        __syncthreads();
#pragma unroll 1
        for (int rr = 0; rr < 2; ++rr) {
            const int r = wid * 2 + rr, row = rb * 8 + r;
            float4 v[4];
            ln_row<true>((const bf16_t*)(ws + WS_HB) + (size_t)row * D, ALPHA, mix + (size_t)row * D, nullptr, 0.f, nullptr, 0.f,
                          p.in[I_LN1G] + l * D, p.in[I_LN1B] + l * D, v, lane);
            store_row_bf(x1b + (size_t)row * D, v, lane);
            store_row(xs + r * 1024, v, lane);
        }
        __syncthreads();
        if (lane < 36) {
            const float* wcol = lane < 4 ? wg + lane : we + (lane - 4);
            const int stride = lane < 4 ? 4 : NE;
            float acc[8];
#pragma unroll
            for (int r = 0; r < 8; ++r) acc[r] = 0.f;
#pragma unroll 2
            for (int e4 = 0; e4 < 64; ++e4) {
                const int e = wid * 256 + e4 * 4;
                const float w0 = wcol[(size_t)(e + 0) * stride], w1 = wcol[(size_t)(e + 1) * stride];
                const float w2 = wcol[(size_t)(e + 2) * stride], w3 = wcol[(size_t)(e + 3) * stride];
#pragma unroll
                for (int r = 0; r < 8; ++r) {
                    const float4 x = *(const float4*)(xs + r * 1024 + e);
                    acc[r] += (x.x * w0 + x.y * w1) + (x.z * w2 + x.w * w3);
                }
            }
#pragma unroll
            for (int r = 0; r < 8; ++r) part[(wid * 8 + r) * 40 + lane] = acc[r];
        }
        __syncthreads();
        for (int i = tid; i < 288; i += NT) {
            const int r = i / 36, o = i % 36;
            const float bias = o < 4 ? bg[o] : be[o - 4];
            lgs[r * 40 + o] = ((part[(0 * 8 + r) * 40 + o] + part[(1 * 8 + r) * 40 + o]) + (part[(2 * 8 + r) * 40 + o] + part[(3 * 8 + r) * 40 + o])) + bias;
        }
        __syncthreads();
        if (tid < 8) {
            const float* L = lgs + tid * 40;
            const int row = rb * 8 + tid;
            int gs = 0; float gm = L[0];
            for (int g = 1; g < 4; ++g) if (L[g] > gm) { gm = L[g]; gs = g; }
            float den = 0.f;
            for (int g = 0; g < 4; ++g) den += expf(L[g] - gm);
            const float ggate = 1.f / den;
            const float* el = L + 4 + gs * 8;
            int i1 = 0; float m1 = el[0];
            for (int j = 1; j < 8; ++j) if (el[j] > m1) { m1 = el[j]; i1 = j; }
            int i2 = -1; float m2 = -3.0e38f;
            for (int j = 0; j < 8; ++j) if (j != i1 && el[j] > m2) { m2 = el[j]; i2 = j; }
            const float p2 = expf(m2 - m1);
            const float wt1 = ggate / (1.f + p2), wt2 = ggate * p2 / (1.f + p2);
            const int e1 = gs * 8 + i1, e2 = gs * 8 + i2;
            const int pos1 = atomicAdd(&cnt[e1], 1);
            const int pos2 = atomicAdd(&cnt[e2], 1);
            list[(size_t)e1 * T + pos1] = row;
            list[(size_t)e2 * T + pos2] = row;
            tinfo[row * 4 + 0] = e1; tinfo[row * 4 + 1] = pos1; tinfo[row * 4 + 2] = e2; tinfo[row * 4 + 3] = pos2;
            tw[row * 2 + 0] = wt1; tw[row * 2 + 1] = wt2;
        }
    }
}

DEVI void ph_moe(const P& p, int l, float* sm, int which) {
    char* ws = ows(p);
    const int* cnt = (const int*)(ws + WS_CNT) + l * NE;
    const int* list = (const int*)(ws + WS_LIST);
    const bf16_t* x1b = (const bf16_t*)(ws + WS_X1B);
    bf16_t* hid = (bf16_t*)(ws + WS_HID);
    bf16_t* out2 = (bf16_t*)(ws + WS_OUT2);
    const bf16_t* wgu = (const bf16_t*)(ws + WS_WGUT);
    const bf16_t* wd = (const bf16_t*)(ws + WS_WDT);
    const int tid = otid(), lane = tid & 63, wid = tid >> 6, wr = wid >> 1, wc = wid & 1, fr = lane & 15, fq = lane >> 4;
    int q = vblock();
    int tbase = 0, off = 0;
    int* cnts = (int*)(sm + 16384 + 32);
    __syncthreads();
    if (tid < NE) cnts[tid] = cnt[tid];
    __syncthreads();
    for (int e = 0; e < NE; ++e) {
        const int ne = cnts[e];
        const int tiles = ((ne + 127) >> 7) * 8;
        while (q < tbase + tiles) {
            const int lt = q - tbase, mi = lt >> 3, ni = lt & 7;
            const int mvalid = min(128, ne - mi * 128);
            f32x4 acc[4][4];
            if (which == 0) {
                gemm128_core((LAS char*)sm, x1b, D, list + (size_t)e * T + mi * 128, mvalid,
                             wgu + ((size_t)e * 1024 + ni * 128) * D, D, D, acc);
#pragma unroll
                for (int m = 0; m < 4; ++m) {
                    const int r = wr * 64 + m * 16 + fr;
                    if (r < mvalid) {
                        bf16_t* o = hid + (size_t)(off + mi * 128 + r) * DE + ni * 64 + wc * 32 + fq * 4;
#pragma unroll
                        for (int n = 0; n < 2; ++n) {
                            u32x2 w;
                            w.x = pk2(siluf_(acc[m][n][0]) * acc[m][n + 2][0], siluf_(acc[m][n][1]) * acc[m][n + 2][1]);
                            w.y = pk2(siluf_(acc[m][n][2]) * acc[m][n + 2][2], siluf_(acc[m][n][3]) * acc[m][n + 2][3]);
                            *(u32x2*)(o + n * 16) = w;
                        }
                    }
                }
            } else {
                gemm128_core((LAS char*)sm, hid + (size_t)(off + mi * 128) * DE, DE, nullptr, mvalid,
                             wd + ((size_t)e * D + ni * 128) * DE, DE, DE, acc);
#pragma unroll
                for (int m = 0; m < 4; ++m) {
                    const int r = wr * 64 + m * 16 + fr;
                    if (r < mvalid) {
                        bf16_t* o = out2 + (size_t)(off + mi * 128 + r) * D + ni * 128 + wc * 64 + fq * 4;
#pragma unroll
                        for (int n = 0; n < 4; ++n) { u32x2 w; w.x = pk2(acc[m][n][0], acc[m][n][1]); w.y = pk2(acc[m][n][2], acc[m][n][3]); *(u32x2*)(o + n * 16) = w; }
                    }
                }
            }
            q += gridDim.x;
        }
        tbase += tiles; off += ne;
    }
}

DEVI void ph_ln2(const P& p, int l, float* sm) {
    char* ws = ows(p);
    const int* cnt = (const int*)(ws + WS_CNT) + l * NE;
    const int* tinfo = (const int*)(ws + WS_TINFO);
    const float* tw = (const float*)(ws + WS_TW);
    const bf16_t* x1 = (const bf16_t*)(ws + WS_X1B);
    const bf16_t* out2 = (const bf16_t*)(ws + WS_OUT2);
    bf16_t* hb = (bf16_t*)(ws + WS_HB);
    int* offs = (int*)sm;
    const int tid = otid(), lane = tid & 63;
    __syncthreads();
    if (tid < NE) offs[64 + tid] = cnt[tid];
    __syncthreads();
    if (tid == 0) { int o = 0; for (int e = 0; e < NE; ++e) { offs[e] = o; o += offs[64 + e]; } }
    __syncthreads();
    const int gw = (obid() * NT + tid) >> 6, nw = gridDim.x * (NT / 64);
    for (int row = gw; row < T; row += nw) {
        const int e1 = tinfo[row * 4], p1 = tinfo[row * 4 + 1], e2 = tinfo[row * 4 + 2], p2 = tinfo[row * 4 + 3];
        const bf16_t* o0 = out2 + (size_t)(offs[e1] + p1) * D;
        const bf16_t* o1 = out2 + (size_t)(offs[e2] + p2) * D;
        float4 v[4];
        ln_row<true>(x1 + (size_t)row * D, ALPHA, nullptr, o0, tw[row * 2], o1, tw[row * 2 + 1],
               p.in[I_LN2G] + l * D, p.in[I_LN2B] + l * D, v, lane);
        if (l == 0) store_row_bf(hb + (size_t)row * D, v, lane);
        else store_row(p.out + (size_t)row * D, v, lane);
    }
}

#define XB_TMO      128
#define XB_XCNT(j)  (256  + 64 * (j))
#define XB_XSUB(j)  (1280 + 64 * (j))
#define XB_XGEN(j)  (2304 + 64 * (j))
#define XB_TOP      3328
#define XB_TOPGEN   3392
#define XCD_BAR_WORDS 3456
#define XB_SPIN_CAP (1u << 18)
DEVI unsigned xb_ld(unsigned* p)              { return __hip_atomic_load(p, __ATOMIC_RELAXED, __HIP_MEMORY_SCOPE_AGENT); }
DEVI unsigned xb_add(unsigned* p, unsigned v) { return __hip_atomic_fetch_add(p, v, __ATOMIC_RELAXED, __HIP_MEMORY_SCOPE_AGENT); }
DEVI unsigned xb_xcc_id() { return (unsigned)__builtin_amdgcn_s_getreg((3 << 11) | 20) & 0xFu; }
#define XB_SPIN(cond, bar) do { unsigned _sp = 0; while (cond) { __builtin_amdgcn_s_sleep(1); \
    if ((++_sp & 255u) == 0u) { if (xb_ld(&(bar)[XB_TMO])) break; if (_sp > XB_SPIN_CAP) { atomicAdd(&(bar)[XB_TMO], 1u); break; } } } } while (0)
struct XcdBarrier { unsigned* bar; unsigned x; volatile LAS unsigned* st; };
DEVI XcdBarrier xcd_barrier_post(unsigned* bar, volatile LAS unsigned* st) {
    XcdBarrier b; b.bar = bar; b.x = xb_xcc_id(); b.st = st;
    if (threadIdx.x == 0) (void)xb_add(&bar[XB_XCNT(b.x)], 1u);
    return b;
}
DEVI void xcd_barrier_complete(unsigned* bar, unsigned x, unsigned& nloc, unsigned& nx) {
    const unsigned G = gridDim.x * gridDim.y * gridDim.z;
    unsigned sum, cnt, mine, sp = 0u;
    for (;;) {
        sum = 0u; cnt = 0u; mine = 0u;
#pragma unroll
        for (unsigned j = 0; j < 16; ++j) { const unsigned c = xb_ld(&bar[XB_XCNT(j)]); sum += c; cnt += (c > 0u) ? 1u : 0u; mine = (j == x) ? c : mine; }
        if (sum == G) break;
        __builtin_amdgcn_s_sleep(1);
        if ((++sp & 255u) == 0u) { if (xb_ld(&bar[XB_TMO])) break; if (sp > XB_SPIN_CAP) { atomicAdd(&bar[XB_TMO], 1u); break; } }
    }
    nloc = mine > 0u ? mine : 1u; nx = cnt > 0u ? cnt : 1u;
}
DEVI void xcd_barrier(const XcdBarrier& b) {
    asm volatile("s_waitcnt vmcnt(0)" ::: "memory");
    __syncthreads();
    if (threadIdx.x == 0) {
        unsigned* bar = b.bar;
        __builtin_amdgcn_s_waitcnt(0);
        unsigned nloc = b.st[0], nx = b.st[1];
        if (nloc == 0u) { xcd_barrier_complete(bar, b.x, nloc, nx); b.st[0] = nloc; b.st[1] = nx; }
        const unsigned old = xb_add(&bar[XB_XSUB(b.x)], 1u);
        const unsigned gen = old / nloc;
        if (old + 1u == (gen + 1u) * nloc) {
            __builtin_amdgcn_fence(__ATOMIC_RELEASE, "agent");
            asm volatile("s_waitcnt vmcnt(0)" ::: "memory");
            const unsigned og = xb_add(&bar[XB_TOP], 1u);
            const unsigned tg = og / nx;
            if (og + 1u == (tg + 1u) * nx) xb_add(&bar[XB_TOPGEN], 1u);
            else XB_SPIN(xb_ld(&bar[XB_TOPGEN]) == tg, bar);
            __builtin_amdgcn_fence(__ATOMIC_ACQUIRE, "agent");
            xb_add(&bar[XB_XGEN(b.x)], 1u);
            asm volatile("s_waitcnt vmcnt(0)" ::: "memory");
        } else {
            XB_SPIN(xb_ld(&bar[XB_XGEN(b.x)]) == gen, bar);
            __builtin_amdgcn_fence(__ATOMIC_ACQUIRE, "agent");
            asm volatile("s_waitcnt vmcnt(0)" ::: "memory");
        }
    }
    __syncthreads();
}

#ifndef PROBE
#define PROBE 0
#endif
constexpr int LDS_BYTES = 65536 + 256;

__global__ void __launch_bounds__(NT, 2) k_mega(P p) {
    extern __shared__ __attribute__((aligned(16))) float sm[];
    volatile LAS unsigned* ctl = (volatile LAS unsigned*)((LAS char*)sm + 65536);
    if (threadIdx.x < 16) ctl[threadIdx.x] = 0u;
    __syncthreads();
    const XcdBarrier bar = xcd_barrier_post((unsigned*)(p.ws + WS_BAR), ctl);
#define GSYNC() xcd_barrier(bar)
    ph_ln_in(p);
    ph_wprep_dense(p, sm);
    GSYNC();
    if (PROBE & 128) { ph_ln_in(p); GSYNC(); }
    if (PROBE & 256) { ph_wprep_dense(p, sm); GSYNC(); }
    for (int l = 0; l < 2; ++l) {
        ph_inproj(p, l, sm); GSYNC();
        if (PROBE & 1) { ph_inproj(p, l, sm); GSYNC(); }
        ph_rwkv_prep(p, l, sm);
        ph_lru_prep(p, l, sm);
        ph_ret_kv(p, sm, 0); GSYNC();
        if (PROBE & 2) { ph_rwkv_prep(p, l, sm); GSYNC(); }
        if (PROBE & 2048) { ph_lru_prep(p, l, sm); GSYNC(); }
        if (PROBE & 4096) { ph_ret_kv(p, sm, 0); GSYNC(); }
        if (PROBE & 4) { ph_rwkv_chunk_wy(p, l, sm); GSYNC(); }
        if (PROBE & 8) { ph_wprep_moe(p, l, sm, 0); GSYNC(); }
        ph_rwkv_chunk_wy(p, l, sm);
        ph_wprep_moe(p, l, sm, 0);
        ph_ret_scan(p);
        ph_lru_carry(p); GSYNC();
        ph_rwkv_seq(p, sm);
        ph_ret_out(p, sm, 48);
        ph_lru_out(p, 48); GSYNC();
        if (PROBE & 16) { ph_rwkv_seq(p, sm); ph_ret_out(p, sm, 48); ph_lru_out(p, 48); GSYNC(); }
        if (PROBE & 8192) { ph_rwkv_seq(p, sm); GSYNC(); }
        if (PROBE & 16384) { ph_ret_out(p, sm, 48); GSYNC(); }
        if (PROBE & 32768) { ph_lru_out(p, 48); GSYNC(); }
        ph_rwkv_post(p, l, sm); GSYNC();
        if (PROBE & 32) { ph_rwkv_post(p, l, sm); GSYNC(); }
        ph_outproj(p, l, sm); GSYNC();
        if (PROBE & 1) { ph_outproj(p, l, sm); GSYNC(); }
        ph_ln1_router(p, l, sm); GSYNC();
        ph_moe(p, l, sm, 0); GSYNC();
        if (PROBE & 1) { ph_moe(p, l, sm, 0); GSYNC(); }
        ph_moe(p, l, sm, 1); GSYNC();
        if (PROBE & 1) { ph_moe(p, l, sm, 1); GSYNC(); }
        ph_ln2(p, l, sm); GSYNC();
        if (PROBE & 64) { ph_ln2(p, l, sm); GSYNC(); }
        if (PROBE & 512) { for (int i = 0; i < 10; ++i) GSYNC(); }
        if (PROBE & 1024) { ph_ret_scan(p); ph_lru_carry(p); GSYNC(); ph_ret_scan(p); ph_lru_carry(p); GSYNC(); }
    }
#undef GSYNC
}

extern "C" void kernel_launch(void* const* d_in, const int* in_sizes, int n_in, void* d_out, int out_size,
                              void* d_ws, size_t ws_size, hipStream_t stream) {
    if (n_in != 34 || ws_size < WS_END) { fprintf(stderr, "kernel_launch: bad args n_in=%d ws=%zu need %zu\n", n_in, ws_size, (size_t)WS_END); return; }
    P p{};
    for (int i = 0; i < 34; ++i) p.in[i] = (const float*)d_in[i];
    p.out = (float*)d_out; p.ws = (char*)d_ws;
    static int grid_blocks = 0;
    if (!grid_blocks) {
        int dev = 0, cus = 0, per_cu = 0;
        (void)hipGetDevice(&dev);
        (void)hipDeviceGetAttribute(&cus, hipDeviceAttributeMultiprocessorCount, dev);
        (void)hipFuncSetAttribute((const void*)k_mega, hipFuncAttributeMaxDynamicSharedMemorySize, LDS_BYTES);
        (void)hipOccupancyMaxActiveBlocksPerMultiprocessor(&per_cu, k_mega, NT, LDS_BYTES);
        if (per_cu < 1) per_cu = 1;
        if (per_cu > 2) per_cu = 2;
        grid_blocks = cus * per_cu;
        fprintf(stderr, "kernel_launch: cus=%d per_cu=%d grid=%d\n", cus, per_cu, grid_blocks);
    }
    (void)hipMemsetAsync((char*)d_ws + WS_CTL, 0, CTL_BYTES, stream);
    void* args[] = {&p};
    hipError_t e = hipLaunchCooperativeKernel((void*)k_mega, dim3(grid_blocks), dim3(NT), args, LDS_BYTES, stream);
    if (e != hipSuccess) fprintf(stderr, "cooperative launch failed: %s (grid %d)\n", hipGetErrorString(e), grid_blocks);
}
```

```cpp
#include <hip/hip_runtime.h>
#include <cstdio>
#include <cstdint>

#define DEVI __device__ __forceinline__

constexpr int D = 1024, NBATCH = 2, S = 8192, T = NBATCH * S;
constexpr int INW = 3456;
constexpr int C_RWKV = 1536, C_LRU = 2944;
constexpr int RW = 384;
constexpr int RWSLAB = 1408;
constexpr int LW = 256;
constexpr int NE = 32, DE = 512;
constexpr int NT = 256;
constexpr float ALPHA = 1.4142135623730951f;
constexpr float LN_EPS = 1e-5f;

constexpr size_t al256(size_t x) { return (x + 255) & ~(size_t)255; }
constexpr size_t WS_WINT = 0;
constexpr size_t WS_WOUTT = al256(WS_WINT + (size_t)2 * INW * D * 2);
constexpr size_t WS_WGUT = al256(WS_WOUTT + (size_t)2 * D * D * 2);
constexpr size_t WS_WDT = al256(WS_WGUT + (size_t)NE * 1024 * D * 2);
constexpr size_t WS_ROPE = al256(WS_WDT + (size_t)NE * D * DE * 2);
constexpr size_t WS_HB = al256(WS_ROPE + (size_t)S * 32 * 8);
constexpr size_t WS_PROJ = al256(WS_HB + (size_t)T * D * 2);
constexpr size_t SZ_PROJ = (size_t)T * INW * 2;
constexpr size_t WS_YCAT = al256(WS_PROJ + SZ_PROJ);
constexpr size_t WS_RW = al256(WS_YCAT + (size_t)T * D * 2);
constexpr size_t SZ_RW1 = (size_t)T * RW * 4;
constexpr size_t WS_RWY = al256(WS_RW + 4 * SZ_RW1);
constexpr size_t WS_LA = al256(WS_RWY + SZ_RW1);
constexpr size_t SZ_L1 = (size_t)T * LW * 4;
constexpr size_t WS_LB = al256(WS_LA + SZ_L1);
constexpr size_t WS_KV = al256(WS_LB + SZ_L1);
constexpr size_t SZ_KV = (size_t)NBATCH * 64 * 6 * 4096 * 4;
constexpr size_t WS_PQ = al256(WS_KV + SZ_KV);
constexpr size_t WS_S0 = al256(WS_PQ + (size_t)12 * 64 * 2 * 4096 * 4);
constexpr size_t WS_RS = al256(WS_S0 + (size_t)12 * 64 * 4096 * 4);
constexpr size_t WS_LC = al256(WS_RS + (size_t)T * 6 * 4);
constexpr size_t SZ_LC1 = (size_t)NBATCH * 128 * LW * 4;
constexpr size_t WS_CTL = al256(WS_LC + 3 * SZ_LC1);
constexpr size_t WS_BAR = WS_CTL;
constexpr size_t WS_CNT = WS_CTL + 16384;
constexpr size_t CTL_BYTES = 16384 + 256;
constexpr size_t WS_LIST = al256(WS_CNT + 256);
constexpr size_t WS_TINFO = al256(WS_LIST + (size_t)NE * T * 4);
constexpr size_t WS_TW = al256(WS_TINFO + (size_t)T * 16);
constexpr size_t WS_END = al256(WS_TW + (size_t)T * 8);
constexpr size_t WS_MIX = WS_RW;
constexpr size_t WS_OUT2 = WS_RW;
constexpr size_t WS_X1 = WS_PROJ;
constexpr size_t WS_X1B = WS_PROJ + (size_t)T * D * 4;
constexpr size_t WS_HID = WS_RW + (size_t)2 * T * D * 2;
static_assert(WS_X1B + (size_t)T * D * 2 <= WS_PROJ + SZ_PROJ, "X1/X1b fit in PROJ");
constexpr size_t WS_PT = WS_RW + 3 * SZ_RW1;
static_assert(WS_OUT2 + (size_t)2 * T * D * 4 <= WS_KV, "OUT2 fits in RW..LB");
static_assert(WS_HID + (size_t)2 * T * DE * 2 <= WS_RW + 4 * SZ_RW1, "HID fits in RW");
static_assert(WS_END <= (size_t)536870912, "workspace budget");

typedef unsigned short bf16_t;
typedef short bf16x8 __attribute__((ext_vector_type(8)));
typedef float f32x4 __attribute__((ext_vector_type(4)));
typedef unsigned u32x2 __attribute__((ext_vector_type(2)));
typedef unsigned u32x4 __attribute__((ext_vector_type(4)));
#define LAS __attribute__((address_space(3)))

struct P {
    const float* in[34];
    float* out;
    char* ws;
};

DEVI char* ows(const P& p) { size_t z = 0; asm volatile("" : "+s"(z)); return p.ws + z; }
enum { I_X = 0, I_LNG, I_LNB, I_WIN, I_WOUT, I_MU, I_W0, I_W2, I_A0, I_A2, I_G2, I_KK, I_KA, I_RK, I_GNG, I_GNB,
       I_CW, I_CB, I_WA, I_BA, I_WX, I_BX, I_LAM, I_LN1G, I_LN1B, I_MWG, I_MBG, I_MWE, I_MBE, I_MG, I_MU_, I_MD, I_LN2G, I_LN2B };

DEVI int otid() { int t = threadIdx.x; asm volatile("" : "+v"(t)); return t; }
DEVI int obid() { int b = blockIdx.x; asm volatile("" : "+s"(b)); return b; }
struct P;
template <int CTRL> DEVI float dpp_mov(float v) { return __builtin_bit_cast(float, __builtin_amdgcn_update_dpp(0, __builtin_bit_cast(int, v), CTRL, 0xF, 0xF, true)); }
DEVI float red16(float x) {
    x += dpp_mov<0xB1>(x);
    x += dpp_mov<0x4E>(x);
    x += dpp_mov<0x141>(x);
    x += dpp_mov<0x140>(x);
    return x;
}
DEVI float wave_sum(float v) {
    v = red16(v);
    const float r0 = __builtin_bit_cast(float, __builtin_amdgcn_readlane(__builtin_bit_cast(int, v), 0));
    const float r1 = __builtin_bit_cast(float, __builtin_amdgcn_readlane(__builtin_bit_cast(int, v), 16));
    const float r2 = __builtin_bit_cast(float, __builtin_amdgcn_readlane(__builtin_bit_cast(int, v), 32));
    const float r3 = __builtin_bit_cast(float, __builtin_amdgcn_readlane(__builtin_bit_cast(int, v), 48));
    return (r0 + r1) + (r2 + r3);
}
DEVI float fexp(float x) { return __builtin_amdgcn_exp2f(x * 1.4426950408889634f); }
DEVI float frcp(float x) { return __builtin_amdgcn_rcpf(x); }
DEVI float sigmoidf_(float x) { return frcp(1.f + fexp(-x)); }
DEVI float siluf_(float x) { return x * frcp(1.f + fexp(-x)); }
DEVI float softplusf_(float x) { return fmaxf(x, 0.f) + __builtin_amdgcn_logf(1.f + fexp(-fabsf(x))) * 0.6931471805599453f; }
DEVI float ftanh(float x) { const float e = fexp(-2.f * fabsf(x)); const float t = (1.f - e) * frcp(1.f + e); return x < 0.f ? -t : t; }
DEVI float gelu_tanh(float x) { return 0.5f * x * (1.f + ftanh(0.7978845608028654f * (x + 0.044715f * x * x * x))); }
typedef __bf16 bf16v2 __attribute__((ext_vector_type(2)));
typedef float f32v2 __attribute__((ext_vector_type(2)));
DEVI unsigned pk2(float lo, float hi) { const f32v2 f = {lo, hi}; return __builtin_bit_cast(unsigned, __builtin_convertvector(f, bf16v2)); }
DEVI unsigned f2bf(float f) { return pk2(f, 0.f) & 0xffffu; }
DEVI float bf2f(bf16_t x) { return __uint_as_float((unsigned)x << 16); }
DEVI float bflo(unsigned u) { return __uint_as_float(u << 16); }
DEVI float bfhi(unsigned u) { return __uint_as_float(u & 0xffff0000u); }
__device__ const double LOGG[6] = {-0.0317486983145803, -0.015748356968139168, -0.007843177461025893,
                                   -0.003913899321136329, -0.0019550348358033506, -0.0009770396478266127};

DEVI void rope_sincos(int s, int i, float& sn, float& cs) {
    double inv = 1.0;
    for (int q = 0; q < i; ++q) inv *= 0.7498942093324559;
    const double ang = (double)s * inv;
    const double n = rint(ang * 0.6366197723675814);
    const double r = fma(-n, 1.5707963267948966, ang);
    const int q = (int)(((long long)n) & 3);
    const double r2 = r * r;
    const double sp = r * (1.0 + r2 * (-1.0 / 6 + r2 * (1.0 / 120 + r2 * (-1.0 / 5040 + r2 * (1.0 / 362880 + r2 * (-1.0 / 39916800))))));
    const double cp = 1.0 + r2 * (-0.5 + r2 * (1.0 / 24 + r2 * (-1.0 / 720 + r2 * (1.0 / 40320 + r2 * (-1.0 / 3628800 + r2 * (1.0 / 479001600))))));
    double s_, c_;
    if (q == 0) { s_ = sp; c_ = cp; } else if (q == 1) { s_ = cp; c_ = -sp; } else if (q == 2) { s_ = -sp; c_ = -cp; } else { s_ = -cp; c_ = sp; }
    sn = (float)s_; cs = (float)c_;
}

DEVI float4 ld4bf(const bf16_t* p) { const u32x2 u = *(const u32x2*)p; return make_float4(bflo(u.x), bfhi(u.x), bflo(u.y), bfhi(u.y)); }
template <bool ABF>
DEVI void ln_row(const void* a, float alpha, const bf16_t* m, const bf16_t* o0, float w0, const bf16_t* o1, float w1,
                 const float* g, const float* bb, float4 (&v)[4], int lane) {
    float s = 0.f;
#pragma unroll
    for (int j = 0; j < 4; ++j) {
        const int e = (j * 64 + lane) * 4;
        float4 x = ABF ? ld4bf((const bf16_t*)a + e) : *(const float4*)((const float*)a + e);
        x.x *= alpha; x.y *= alpha; x.z *= alpha; x.w *= alpha;
        if (m) { const float4 y = ld4bf(m + e); x.x += y.x; x.y += y.y; x.z += y.z; x.w += y.w; }
        if (o0) {
            const float4 y0 = ld4bf(o0 + e); const float4 y1 = ld4bf(o1 + e);
            x.x += w0 * y0.x + w1 * y1.x; x.y += w0 * y0.y + w1 * y1.y; x.z += w0 * y0.z + w1 * y1.z; x.w += w0 * y0.w + w1 * y1.w;
        }
        v[j] = x; s += (x.x + x.y) + (x.z + x.w);
    }
    const float mean = wave_sum(s) * (1.f / D);
    float q = 0.f;
#pragma unroll
    for (int j = 0; j < 4; ++j) {
        v[j].x -= mean; v[j].y -= mean; v[j].z -= mean; v[j].w -= mean;
        q += (v[j].x * v[j].x + v[j].y * v[j].y) + (v[j].z * v[j].z + v[j].w * v[j].w);
    }
    const float rstd = 1.f / sqrtf(wave_sum(q) * (1.f / D) + LN_EPS);
#pragma unroll
    for (int j = 0; j < 4; ++j) {
        const int e = (j * 64 + lane) * 4;
        const float4 gg = *(const float4*)(g + e); const float4 b4 = *(const float4*)(bb + e);
        v[j].x = v[j].x * rstd * gg.x + b4.x; v[j].y = v[j].y * rstd * gg.y + b4.y;
        v[j].z = v[j].z * rstd * gg.z + b4.z; v[j].w = v[j].w * rstd * gg.w + b4.w;
    }
}
DEVI void store_row(float* o, const float4 (&v)[4], int lane) {
#pragma unroll
    for (int j = 0; j < 4; ++j) *(float4*)(o + (j * 64 + lane) * 4) = v[j];
}

DEVI void store_row_bf(bf16_t* o, const float4 (&v)[4], int lane) {
#pragma unroll
    for (int j = 0; j < 4; ++j) { u32x2 w; w.x = pk2(v[j].x, v[j].y); w.y = pk2(v[j].z, v[j].w); *(u32x2*)(o + (j * 64 + lane) * 4) = w; }
}

DEVI void ph_ln_in(const P& p) {
    const int tid = otid(), lane = tid & 63;
    const int gw = (obid() * NT + tid) >> 6, nw = gridDim.x * (NT / 64);
    char* ws = ows(p);
    bf16_t* hb = (bf16_t*)(ws + WS_HB);
    for (int row = gw; row < T; row += nw) {
        float4 v[4];
        ln_row<false>(p.in[I_X] + (size_t)row * D, 1.f, nullptr, nullptr, 0.f, nullptr, 0.f, p.in[I_LNG], p.in[I_LNB], v, lane);
        store_row_bf(hb + (size_t)row * D, v, lane);
    }
    float2* rope = (float2*)(ws + WS_ROPE);
    for (int idx = obid() * NT + tid; idx < S * 32; idx += gridDim.x * NT) {
        float sn, cs; rope_sincos(idx >> 5, idx & 31, sn, cs);
        rope[idx] = make_float2(cs, sn);
    }
}

DEVI void tr_tile(float* sm, const float* W, int N, int k0, int n0, bf16_t* dst, int K, int map) {
    const int tid = otid();
    __syncthreads();
    float4 v[8];
#pragma unroll
    for (int i = 0; i < 8; ++i) {
        const int k = (tid >> 4) + i * 16, n4 = (tid & 15) * 4;
        { const f32x4 t = __builtin_nontemporal_load((const f32x4*)(W + (size_t)(k0 + k) * N + n0 + n4)); v[i] = make_float4(t[0], t[1], t[2], t[3]); }
    }
#pragma unroll
    for (int i = 0; i < 8; ++i) {
        const int k = (tid >> 4) + i * 16, n4 = (tid & 15) * 4;
        sm[k * 65 + n4] = v[i].x; sm[k * 65 + n4 + 1] = v[i].y; sm[k * 65 + n4 + 2] = v[i].z; sm[k * 65 + n4 + 3] = v[i].w;
    }
    __syncthreads();
    const int nl = tid >> 2, kq = (tid & 3) * 32;
    const int n = n0 + nl;
    const int row = map == 0 ? n : (64 * (n >> 5) + (n & 31) + (map == 2 ? 32 : 0));
    const float* c = sm + kq * 65 + nl;
    bf16_t* d = dst + (size_t)row * K + k0 + kq;
#pragma unroll
    for (int g = 0; g < 4; ++g) {
        u32x4 o;
        o.x = pk2(c[(g * 8 + 0) * 65], c[(g * 8 + 1) * 65]); o.y = pk2(c[(g * 8 + 2) * 65], c[(g * 8 + 3) * 65]);
        o.z = pk2(c[(g * 8 + 4) * 65], c[(g * 8 + 5) * 65]); o.w = pk2(c[(g * 8 + 6) * 65], c[(g * 8 + 7) * 65]);
        *(u32x4*)(d + g * 8) = o;
    }
}
DEVI void ph_wprep_dense(const P& p, float* sm) {
    char* ws = ows(p);
    constexpr int TI = (D / 128) * (INW / 64), TO = (D / 128) * (D / 64);
    for (int q = obid(); q < 2 * (TI + TO); q += gridDim.x) {
        int r = q; const int l = r / (TI + TO); r -= l * (TI + TO);
        if (r < TI) { const int kb = r / (INW / 64), nb = r % (INW / 64);
            tr_tile(sm, p.in[I_WIN] + (size_t)l * D * INW, INW, kb * 128, nb * 64, (bf16_t*)(ws + WS_WINT) + (size_t)l * INW * D, D, 0); }
        else { r -= TI; const int kb = r / (D / 64), nb = r % (D / 64);
            tr_tile(sm, p.in[I_WOUT] + (size_t)l * D * D, D, kb * 128, nb * 64, (bf16_t*)(ws + WS_WOUTT) + (size_t)l * D * D, D, 0); }
    }
}
DEVI void ph_wprep_moe(const P& p, int l, float* sm, int b0) {
    char* ws = ows(p);
    constexpr int TG = (D / 128) * (DE / 64), TD_ = (DE / 128) * (D / 64);
    const int nbk = gridDim.x - b0;
    if (obid() < b0) return;
    for (int q = obid() - b0; q < NE * (2 * TG + TD_); q += nbk) {
        const int e = q / (2 * TG + TD_); int r = q - e * (2 * TG + TD_);
        if (r < 2 * TG) { const int up = r >= TG; if (up) r -= TG; const int kb = r / (DE / 64), nb = r % (DE / 64);
            tr_tile(sm, p.in[up ? I_MU_ : I_MG] + ((size_t)(l * NE + e)) * D * DE, DE, kb * 128, nb * 64,
                    (bf16_t*)(ws + WS_WGUT) + (size_t)e * 1024 * D, D, up ? 2 : 1); }
        else { r -= 2 * TG; const int kb = r / (D / 64), nb = r % (D / 64);
            tr_tile(sm, p.in[I_MD] + ((size_t)(l * NE + e)) * DE * D, D, kb * 128, nb * 64,
                    (bf16_t*)(ws + WS_WDT) + (size_t)e * D * DE, DE, 0); }
    }
}

DEVI void gemm128_core(LAS char* lds, const bf16_t* A, int lda, const int* rowidx, int mvalid,
                       const bf16_t* Bt, int ldb, int K, f32x4 (&acc)[4][4]) {
    const int tid = otid(), lane = tid & 63, wid = tid >> 6, wr = wid >> 1, wc = wid & 1, fr = lane & 15, fq = lane >> 4;
    const int srow = tid >> 3, sch = tid & 7;
    const bf16_t* ap[4]; const bf16_t* bp[4];
#pragma unroll
    for (int i = 0; i < 4; ++i) {
        const int r = srow + i * 32;
        const int rr = r < mvalid ? r : 0;
        const int ri = rowidx ? rowidx[rr] : rr;
        const int c = sch ^ ((r >> 1) & 7);
        ap[i] = A + (size_t)ri * lda + c * 8;
        bp[i] = Bt + (size_t)r * ldb + c * 8;
    }
#pragma unroll
    for (int m = 0; m < 4; ++m)
#pragma unroll
        for (int n = 0; n < 4; ++n) acc[m][n] = (f32x4){0.f, 0.f, 0.f, 0.f};
    const int nt = K >> 6;
    const int sw = (fr >> 1) & 7;
    const int aoff = (wr * 64 + fr) * 128, boff = 16384 + (wc * 64 + fr) * 128;
#define GSTAGE(kt, buf) do { _Pragma("unroll") for (int _i = 0; _i < 4; ++_i) { \
        __builtin_amdgcn_global_load_lds((const unsigned*)(ap[_i] + (kt) * 64), (LAS unsigned*)(lds + (buf) * 32768 + tid * 16 + _i * 4096), 16, 0, 0); \
        __builtin_amdgcn_global_load_lds((const unsigned*)(bp[_i] + (kt) * 64), (LAS unsigned*)(lds + (buf) * 32768 + 16384 + tid * 16 + _i * 4096), 16, 0, 0); } } while (0)
    GSTAGE(0, 0);
    for (int kt = 0; kt < nt; ++kt) {
        asm volatile("s_waitcnt vmcnt(0)" ::: "memory");
        __syncthreads();
        if (kt + 1 < nt) GSTAGE(kt + 1, (kt + 1) & 1);
        const LAS char* base = lds + (kt & 1) * 32768;
#pragma unroll
        for (int kk = 0; kk < 2; ++kk) {
            bf16x8 af[4], bfr[4];
            const int co = (((kk * 4 + fq) ^ sw) * 16);
#pragma unroll
            for (int m = 0; m < 4; ++m) af[m] = *(const LAS bf16x8*)(base + aoff + m * 2048 + co);
#pragma unroll
            for (int n = 0; n < 4; ++n) bfr[n] = *(const LAS bf16x8*)(base + boff + n * 2048 + co);
            __builtin_amdgcn_s_setprio(1);
#pragma unroll
            for (int m = 0; m < 4; ++m)
#pragma unroll
                for (int n = 0; n < 4; ++n) acc[m][n] = __builtin_amdgcn_mfma_f32_16x16x32_bf16(bfr[n], af[m], acc[m][n], 0, 0, 0);
            __builtin_amdgcn_s_setprio(0);
        }
    }
#undef GSTAGE
}

DEVI int vblock() { const int g = gridDim.x, b = obid(); return (g & 7) == 0 ? (b & 7) * (g >> 3) + (b >> 3) : b; }
DEVI void ph_inproj(const P& p, int l, float* sm) {
    char* ws = ows(p);
    const bf16_t* hb = (const bf16_t*)(ws + WS_HB);
    const bf16_t* wt = (const bf16_t*)(ws + WS_WINT) + (size_t)l * INW * D;
    bf16_t* proj = (bf16_t*)(ws + WS_PROJ);
    const float2* rope = (const float2*)(ws + WS_ROPE);
    const int tid = otid(), lane = tid & 63, wid = tid >> 6, wr = wid >> 1, wc = wid & 1, fr = lane & 15, fq = lane >> 4;
    constexpr int TN = INW / 128;
    for (int q = vblock(); q < (T / 128) * TN; q += gridDim.x) {
        int mi, ni;
        if (q < 3 * 1024) { const int nbk = q >> 10, w = q & 1023, t = w & 63; mi = (w >> 6) * 8 + (t >> 3); ni = nbk * 8 + (t & 7); }
        else { const int q2 = q - 3 * 1024; mi = q2 / 3; ni = 24 + q2 % 3; }
        f32x4 acc[4][4];
        gemm128_core((LAS char*)sm, hb + (size_t)mi * 128 * D, D, nullptr, 128, wt + (size_t)ni * 128 * D, D, D, acc);
        const int colw = ni * 128 + wc * 64;
#pragma unroll
        for (int m = 0; m < 4; ++m) {
            const int row = mi * 128 + wr * 64 + m * 16 + fr;
            if (colw < 768) {
                const float sc = colw >= 384 ? 0.125f : 1.f;
                const float2* rp = rope + (size_t)(row & (S - 1)) * 32 + fq * 4;
#pragma unroll
                for (int n = 0; n < 2; ++n)
#pragma unroll
                    for (int r = 0; r < 4; ++r) {
                        const float2 cs = rp[n * 16 + r];
                        const float x1 = acc[m][n][r], x2 = acc[m][n + 2][r];
                        acc[m][n][r] = (x1 * cs.x - x2 * cs.y) * sc;
                        acc[m][n + 2][r] = (x1 * cs.y + x2 * cs.x) * sc;
                    }
            }
            bf16_t* o = proj + (size_t)row * INW + colw + fq * 4;
#pragma unroll
            for (int n = 0; n < 4; ++n) { u32x2 w; w.x = pk2(acc[m][n][0], acc[m][n][1]); w.y = pk2(acc[m][n][2], acc[m][n][3]); *(u32x2*)(o + n * 16) = w; }
        }
    }
}

DEVI void ph_outproj(const P& p, int l, float* sm) {
    char* ws = ows(p);
    const bf16_t* yc = (const bf16_t*)(ws + WS_YCAT);
    const bf16_t* wt = (const bf16_t*)(ws + WS_WOUTT) + (size_t)l * D * D;
    bf16_t* mix = (bf16_t*)(ws + WS_MIX);
    const int tid = otid(), lane = tid & 63, wid = tid >> 6, wr = wid >> 1, wc = wid & 1, fr = lane & 15, fq = lane >> 4;
    for (int q = vblock(); q < (T / 128) * 8; q += gridDim.x) {
        const int mi = q >> 3, ni = q & 7;
        f32x4 acc[4][4];
        gemm128_core((LAS char*)sm, yc + (size_t)mi * 128 * D, D, nullptr, 128, wt + (size_t)ni * 128 * D, D, D, acc);
#pragma unroll
        for (int m = 0; m < 4; ++m) {
            bf16_t* o = mix + (size_t)(mi * 128 + wr * 64 + m * 16 + fr) * D + ni * 128 + wc * 64 + fq * 4;
#pragma unroll
            for (int n = 0; n < 4; ++n) { u32x2 w; w.x = pk2(acc[m][n][0], acc[m][n][1]); w.y = pk2(acc[m][n][2], acc[m][n][3]); *(u32x2*)(o + n * 16) = w; }
        }
    }
}

DEVI void ld8bf(const bf16_t* src, float* dst) {
    const u32x4 u = *(const u32x4*)src;
    dst[0] = bflo(u.x); dst[1] = bfhi(u.x); dst[2] = bflo(u.y); dst[3] = bfhi(u.y);
    dst[4] = bflo(u.z); dst[5] = bfhi(u.z); dst[6] = bflo(u.w); dst[7] = bfhi(u.w);
}
DEVI bf16x8 pack8(const float* v) {
    u32x4 u; u.x = pk2(v[0], v[1]); u.y = pk2(v[2], v[3]); u.z = pk2(v[4], v[5]); u.w = pk2(v[6], v[7]);
    return __builtin_bit_cast(bf16x8, u);
}
DEVI void ret_stage_rows(LAS char* img, const bf16_t* proj, size_t tok0, int col0, float logg, int mode, int tid) {
#pragma unroll
    for (int i = 0; i < 4; ++i) {
        const int idx = tid + i * 256, row = idx >> 3, ch = idx & 7;
        float v[8];
        ld8bf(proj + (tok0 + row) * INW + col0 + ch * 8, v);
        const float sc = fexp((mode == 0 ? (float)row : -(float)row) * logg);
#pragma unroll
        for (int j = 0; j < 8; ++j) v[j] *= sc;
        *(LAS bf16x8*)(img + row * 128 + ((ch ^ ((row >> 1) & 7)) * 16)) = pack8(v);
    }
}
DEVI void ret_stage_T(LAS char* img, const bf16_t* proj, size_t tok0, int col0, float logg, int mode, int tid) {
#pragma unroll
    for (int i = 0; i < 4; ++i) {
        const int idx = tid + i * 256, tok = idx >> 3, ch = idx & 7;
        float v[8];
        ld8bf(proj + (tok0 + tok) * INW + col0 + ch * 8, v);
        const float sc = mode == 2 ? fexp((float)(127 - tok) * logg) : 1.f;
        const int ck = (tok >> 5) * 4 + ((tok >> 2) & 3), jj = ((tok >> 4) & 1) * 4 + (tok & 3);
#pragma unroll
        for (int j = 0; j < 8; ++j) {
            const int e = ch * 8 + j;
            *(LAS bf16_t*)(img + e * 256 + ((ck ^ (e & 15)) * 16) + jj * 2) = (bf16_t)f2bf(v[j] * sc);
        }
    }
}
DEVI bf16x8 frag_row(const LAS char* img, int row, int kk, int fq) { return *(const LAS bf16x8*)(img + row * 128 + (((kk * 4 + fq) ^ ((row >> 1) & 7)) * 16)); }
DEVI bf16x8 frag_T(const LAS char* img, int e, int kp, int fq) { return *(const LAS bf16x8*)(img + e * 256 + (((kp * 4 + fq) ^ (e & 15)) * 16)); }

DEVI void ph_ret_kv(const P& p, float* sm, int b0) {
    char* ws = ows(p);
    const bf16_t* proj = (const bf16_t*)(ws + WS_PROJ);
    float* kv = (float*)(ws + WS_KV);
    LAS char* lds = (LAS char*)sm;
    const int tid = otid(), lane = tid & 63, wid = tid >> 6, fr = lane & 15, fq = lane >> 4;
    if (obid() < b0) return;
    for (int item = obid() - b0; item < NBATCH * 64 * 6; item += gridDim.x - b0) {
        const int h = item % 6, n = (item / 6) % 64, b = item / 384;
        const float logg = (float)LOGG[h];
        const size_t tok0 = (size_t)b * S + n * 128;
        __syncthreads();
        ret_stage_T(lds, proj, tok0, 768 + h * 64, logg, 0, tid);
        ret_stage_T(lds + 16384, proj, tok0, 384 + h * 64, logg, 2, tid);
        __syncthreads();
        f32x4 acc[4];
#pragma unroll
        for (int dt = 0; dt < 4; ++dt) acc[dt] = (f32x4){0.f, 0.f, 0.f, 0.f};
#pragma unroll
        for (int kk = 0; kk < 4; ++kk) {
            const bf16x8 av = frag_T(lds, wid * 16 + fr, kk, fq);
#pragma unroll
            for (int dt = 0; dt < 4; ++dt) acc[dt] = __builtin_amdgcn_mfma_f32_16x16x32_bf16(av, frag_T(lds + 16384, dt * 16 + fr, kk, fq), acc[dt], 0, 0, 0);
        }
        float* o = kv + (size_t)item * 4096;
#pragma unroll
        for (int dt = 0; dt < 4; ++dt)
#pragma unroll
            for (int r = 0; r < 4; ++r) o[(wid * 16 + fq * 4 + r) * 64 + dt * 16 + fr] = acc[dt][r];
    }
}

DEVI void ph_ret_scan(const P& p) {
    float* kv = (float*)(ows(p) + WS_KV);
    const int total = NBATCH * 6 * 4096;
    for (int idx = obid() * NT + otid(); idx < total; idx += gridDim.x * NT) {
        const int de = idx & 4095, bh = idx >> 12, h = bh % 6, b = bh / 6;
        const float g = expf(128.f * (float)LOGG[h]);
        float st = 0.f;
        float* base = kv + ((size_t)(b * 64) * 6 + h) * 4096 + de;
        for (int n0 = 0; n0 < 64; n0 += 16) {
            float x[16];
#pragma unroll
            for (int j = 0; j < 16; ++j) x[j] = base[(size_t)(n0 + j) * 6 * 4096];
#pragma unroll
            for (int j = 0; j < 16; ++j) { const float xv = x[j]; x[j] = st; st = st * g + xv; }
#pragma unroll
            for (int j = 0; j < 16; ++j) base[(size_t)(n0 + j) * 6 * 4096] = x[j];
        }
    }
}

DEVI void ph_ret_out(const P& p, float* sm, int b0) {
    char* ws = ows(p);
    const bf16_t* proj = (const bf16_t*)(ws + WS_PROJ);
    const float* kv = (const float*)(ws + WS_KV);
    bf16_t* ycat = (bf16_t*)(ws + WS_YCAT);
    LAS char* lds = (LAS char*)sm;
    const LAS char* qs = lds; const LAS char* ks = lds + 16384; const LAS char* vt = lds + 32768;
    const int tid = otid(), lane = tid & 63, wid = tid >> 6, fr = lane & 15, fq = lane >> 4;
    if (obid() < b0) return;
    for (int item = obid() - b0; item < NBATCH * 64 * 6; item += gridDim.x - b0) {
        const int h = item % 6, n = (item / 6) % 64, b = item / 384;
        const float logg = (float)LOGG[h];
        const float gam = expf(logg);
        const size_t tok0 = (size_t)b * S + n * 128;
        __syncthreads();
        ret_stage_rows(lds, proj, tok0, h * 64, logg, 0, tid);
        ret_stage_rows(lds + 16384, proj, tok0, 384 + h * 64, logg, 1, tid);
        ret_stage_T(lds + 32768, proj, tok0, 768 + h * 64, logg, 0, tid);
        __syncthreads();
        const float* prevT = kv + (size_t)item * 4096;
#pragma unroll 1
        for (int qi = 0; qi < 2; ++qi) {
            const int qt = qi == 0 ? wid : 7 - wid;
            bf16x8 bq[2];
            bq[0] = frag_row(qs, qt * 16 + fr, 0, fq); bq[1] = frag_row(qs, qt * 16 + fr, 1, fq);
            f32x4 acc[4];
#pragma unroll
            for (int et = 0; et < 4; ++et) acc[et] = (f32x4){0.f, 0.f, 0.f, 0.f};
#pragma unroll
            for (int et = 0; et < 4; ++et)
#pragma unroll
                for (int kk = 0; kk < 2; ++kk) {
                    const float* src = prevT + (et * 16 + fr) * 64 + kk * 32 + fq * 8;
                    const float4 x0 = *(const float4*)src, x1 = *(const float4*)(src + 4);
                    const float v8[8] = {x0.x, x0.y, x0.z, x0.w, x1.x, x1.y, x1.z, x1.w};
                    acc[et] = __builtin_amdgcn_mfma_f32_16x16x32_bf16(pack8(v8), bq[kk], acc[et], 0, 0, 0);
                }
#pragma unroll
            for (int et = 0; et < 4; ++et) acc[et] = acc[et] * gam;
            for (int kp = 0; kp <= (qt >> 1); ++kp) {
                float pv[8];
#pragma unroll
                for (int a = 0; a < 2; ++a) {
                    const int kt = 2 * kp + a;
                    f32x4 sT = (f32x4){0.f, 0.f, 0.f, 0.f};
                    if (kt <= qt) {
                        sT = __builtin_amdgcn_mfma_f32_16x16x32_bf16(frag_row(ks, kt * 16 + fr, 0, fq), bq[0], sT, 0, 0, 0);
                        sT = __builtin_amdgcn_mfma_f32_16x16x32_bf16(frag_row(ks, kt * 16 + fr, 1, fq), bq[1], sT, 0, 0, 0);
                        if (kt == qt) {
#pragma unroll
                            for (int r = 0; r < 4; ++r) if (fq * 4 + r > fr) sT[r] = 0.f;
                        }
                    }
                    pv[a * 4 + 0] = sT[0]; pv[a * 4 + 1] = sT[1]; pv[a * 4 + 2] = sT[2]; pv[a * 4 + 3] = sT[3];
                }
                const bf16x8 pf = pack8(pv);
#pragma unroll
                for (int et = 0; et < 4; ++et)
                    acc[et] = __builtin_amdgcn_mfma_f32_16x16x32_bf16(frag_T(vt, et * 16 + fr, kp, fq), pf, acc[et], 0, 0, 0);
            }
            float sum = 0.f;
#pragma unroll
            for (int et = 0; et < 4; ++et) sum += (acc[et][0] + acc[et][1]) + (acc[et][2] + acc[et][3]);
            sum += __shfl_xor(sum, 16); sum += __shfl_xor(sum, 32);
            const float mean = sum * (1.f / 64.f);
            float var = 0.f;
#pragma unroll
            for (int et = 0; et < 4; ++et) { acc[et] = acc[et] - mean; var += (acc[et][0] * acc[et][0] + acc[et][1] * acc[et][1]) + (acc[et][2] * acc[et][2] + acc[et][3] * acc[et][3]); }
            var += __shfl_xor(var, 16); var += __shfl_xor(var, 32);
            const float rstd = 1.f / sqrtf(var * (1.f / 64.f) + LN_EPS);
            const size_t tok = tok0 + qt * 16 + fr;
#pragma unroll
            for (int et = 0; et < 4; ++et) {
                const u32x2 gu = *(const u32x2*)(proj + tok * INW + 1152 + h * 64 + et * 16 + fq * 4);
                const float g0 = bflo(gu.x), g1 = bfhi(gu.x), g2 = bflo(gu.y), g3 = bfhi(gu.y);
                u32x2 w;
                w.x = pk2(acc[et][0] * rstd * siluf_(g0), acc[et][1] * rstd * siluf_(g1));
                w.y = pk2(acc[et][2] * rstd * siluf_(g2), acc[et][3] * rstd * siluf_(g3));
                *(u32x2*)(ycat + tok * D + h * 64 + et * 16 + fq * 4) = w;
            }
        }
    }
}

constexpr int RC = 128, NCH = S / RC;

DEVI float zmix(const bf16_t* pc, int s, int col, const float* mu) {
    const float c = bf2f(pc[col]);
    const float pv = s > 0 ? bf2f(pc[col - INW]) : 0.f;
    return c + (pv - c) * mu[col];
}
DEVI void zmix8(const bf16_t* pc, int s, int col, const float* mu, float* z) {
    float c[8], pv[8];
    ld8bf(pc + col, c);
    if (s > 0) ld8bf(pc + col - INW, pv);
    else {
#pragma unroll
        for (int j = 0; j < 8; ++j) pv[j] = 0.f;
    }
    const float4 m0 = *(const float4*)(mu + col), m1 = *(const float4*)(mu + col + 4);
    const float m[8] = {m0.x, m0.y, m0.z, m0.w, m1.x, m1.y, m1.z, m1.w};
#pragma unroll
    for (int j = 0; j < 8; ++j) z[j] = c[j] + (pv[j] - c[j]) * m[j];
}
DEVI float quad_sum(float x) { x += dpp_mov<0xB1>(x); x += dpp_mov<0x4E>(x); return x; }

DEVI void ph_rwkv_prep(const P& p, int l, float* sm) {
    char* ws = ows(p);
    const bf16_t* proj = (const bf16_t*)(ws + WS_PROJ);
    float* rw = (float*)(ws + WS_RW);
    float* rs = (float*)(ws + WS_RS);
    const size_t A1 = (size_t)T * RW;
    const float* mu = p.in[I_MU] + l * RWSLAB;
    const float* w0 = p.in[I_W0] + l * RW; const float* w2 = p.in[I_W2] + (size_t)l * 64 * RW;
    const float* a0 = p.in[I_A0] + l * RW; const float* a2 = p.in[I_A2] + (size_t)l * 64 * RW;
    const float* k_k = p.in[I_KK] + l * RW; const float* k_a = p.in[I_KA] + l * RW; const float* r_k = p.in[I_RK] + l * RW;
    const int tid = otid(), tau = tid >> 2, cq = tid & 3;
    float* zx = sm;
    float* wx = sm + 4160;
    for (int item = obid(); item < (T / 64) * 6; item += gridDim.x) {
        const int h = item % 6, tile = item / 6;
        const int t = tile * 64 + tau, s = t & (S - 1);
        const int hc = h * 64 + cq * 16;
        float u[16], av[16];
#pragma unroll
        for (int pass = 0; pass < 2; ++pass) {
            __syncthreads();
            for (int i = tid; i < 512; i += NT) {
                const int tt = i >> 3, j8 = (i & 7) * 8;
                const int t2 = tile * 64 + tt;
                float z[8];
                zmix8(proj + (size_t)t2 * INW + C_RWKV, t2 & (S - 1), (pass == 0 ? 1152 : 1216) + j8, mu, z);
#pragma unroll
                for (int j = 0; j < 8; ++j) zx[tt * 65 + j8 + j] = pass == 0 ? ftanh(z[j]) : z[j];
            }
            const float* wsrc = pass == 0 ? w2 : a2;
            for (int i = tid; i < 1024; i += NT) {
                const int j = i >> 4, c4 = (i & 15) * 4;
                *(float4*)(wx + j * 64 + c4) = *(const float4*)(wsrc + (size_t)j * RW + h * 64 + c4);
            }
            __syncthreads();
            float acc[16];
#pragma unroll
            for (int cc = 0; cc < 16; ++cc) acc[cc] = 0.f;
#pragma unroll 4
            for (int j = 0; j < 64; ++j) {
                const float zv = zx[tau * 65 + j];
#pragma unroll
                for (int c4 = 0; c4 < 4; ++c4) {
                    const float4 w4 = *(const float4*)(wx + j * 64 + cq * 16 + c4 * 4);
                    acc[c4 * 4] += zv * w4.x; acc[c4 * 4 + 1] += zv * w4.y; acc[c4 * 4 + 2] += zv * w4.z; acc[c4 * 4 + 3] += zv * w4.w;
                }
            }
#pragma unroll
            for (int cc = 0; cc < 16; ++cc) { if (pass == 0) u[cc] = acc[cc]; else av[cc] = acc[cc]; }
        }
        const bf16_t* pc = proj + (size_t)t * INW + C_RWKV;
        float kr[16], rr[16];
        zmix8(pc, s, 384 + hc, mu, kr); zmix8(pc, s, 384 + hc + 8, mu, kr + 8);
        zmix8(pc, s, hc, mu, rr); zmix8(pc, s, hc + 8, mu, rr + 8);
        float kk[16], n2 = 0.f, rsum = 0.f;
        float dec[16], nb[16], km[16];
#pragma unroll
        for (int cc = 0; cc < 16; ++cc) {
            const int c = hc + cc;
            const float wl = -softplusf_(-(u[cc] + w0[c])) - 0.5f;
            dec[cc] = fexp(-fexp(wl));
            const float a = sigmoidf_(av[cc] + a0[c]);
            kk[cc] = kr[cc] * k_k[c];
            n2 += kk[cc] * kk[cc];
            km[cc] = kr[cc] * (1.f + (a - 1.f) * k_a[c]);
            rsum += rr[cc] * km[cc] * r_k[c];
            av[cc] = a;
        }
        n2 = quad_sum(n2); rsum = quad_sum(rsum);
        const float inv = 1.f / fmaxf(sqrtf(n2), 1e-12f);
#pragma unroll
        for (int cc = 0; cc < 16; ++cc) { kk[cc] *= inv; nb[cc] = -kk[cc] * av[cc]; }
        const size_t o = (size_t)t * RW + hc;
        bf16_t* rwb = (bf16_t*)(rw + A1);
#pragma unroll
        for (int c4 = 0; c4 < 4; ++c4)
            *(float4*)(rw + o + c4 * 4) = make_float4(dec[c4 * 4], dec[c4 * 4 + 1], dec[c4 * 4 + 2], dec[c4 * 4 + 3]);
        *(bf16x8*)(rwb + 0 * A1 + o) = pack8(kk); *(bf16x8*)(rwb + 0 * A1 + o + 8) = pack8(kk + 8);
        *(bf16x8*)(rwb + 1 * A1 + o) = pack8(nb); *(bf16x8*)(rwb + 1 * A1 + o + 8) = pack8(nb + 8);
        *(bf16x8*)(rwb + 2 * A1 + o) = pack8(km); *(bf16x8*)(rwb + 2 * A1 + o + 8) = pack8(km + 8);
        if (cq == 0) rs[(size_t)t * 6 + h] = rsum;
    }
}

struct RwOps { float4 kk, w, nb, k, r; float v0, v1, v2, v3; };
DEVI void rw_load(RwOps& o, const float* sm, const float* smV, int tt, int kq, int rl) {
    o.kk = *(const float4*)(sm + 0 * 2048 + tt * 64 + kq * 4);
    o.w = *(const float4*)(sm + 1 * 2048 + tt * 64 + kq * 4);
    o.nb = *(const float4*)(sm + 2 * 2048 + tt * 64 + kq * 4);
    o.k = *(const float4*)(sm + 3 * 2048 + tt * 64 + kq * 4);
    o.r = *(const float4*)(sm + 4 * 2048 + tt * 64 + kq * 4);
    o.v0 = smV[tt * 64 + rl]; o.v1 = smV[tt * 64 + 16 + rl]; o.v2 = smV[tt * 64 + 32 + rl]; o.v3 = smV[tt * 64 + 48 + rl];
}
DEVI float dot4(const float4& a, const float4& b) { return (a.x * b.x + a.y * b.y) + (a.z * b.z + a.w * b.w); }
DEVI void upd4(float4& s, const RwOps& o, float d, float vv) {
    s.x = s.x * o.w.x + d * o.nb.x + vv * o.k.x; s.y = s.y * o.w.y + d * o.nb.y + vv * o.k.y;
    s.z = s.z * o.w.z + d * o.nb.z + vv * o.k.z; s.w = s.w * o.w.w + d * o.nb.w + vv * o.k.w;
}
#define RED16x4(a, b, c, d) do { \
    a += dpp_mov<0xB1>(a); b += dpp_mov<0xB1>(b); c += dpp_mov<0xB1>(c); d += dpp_mov<0xB1>(d); \
    a += dpp_mov<0x4E>(a); b += dpp_mov<0x4E>(b); c += dpp_mov<0x4E>(c); d += dpp_mov<0x4E>(d); \
    a += dpp_mov<0x141>(a); b += dpp_mov<0x141>(b); c += dpp_mov<0x141>(c); d += dpp_mov<0x141>(d); \
    a += dpp_mov<0x140>(a); b += dpp_mov<0x140>(b); c += dpp_mov<0x140>(c); d += dpp_mov<0x140>(d); } while (0)
DEVI void rw_step4(float4 (&st)[4], const RwOps& o, float& y0, float& y1, float& y2, float& y3) {
    float d0 = dot4(st[0], o.kk), d1 = dot4(st[1], o.kk), d2 = dot4(st[2], o.kk), d3 = dot4(st[3], o.kk);
    RED16x4(d0, d1, d2, d3);
    upd4(st[0], o, d0, o.v0); upd4(st[1], o, d1, o.v1); upd4(st[2], o, d2, o.v2); upd4(st[3], o, d3, o.v3);
    y0 = dot4(st[0], o.r); y1 = dot4(st[1], o.r); y2 = dot4(st[2], o.r); y3 = dot4(st[3], o.r);
    RED16x4(y0, y1, y2, y3);
}
DEVI void ph_rwkv_chunk(const P& p, int l, float* sm) {
    char* ws = ows(p);
    const bf16_t* proj = (const bf16_t*)(ws + WS_PROJ);
    const float* rw = (const float*)(ws + WS_RW);
    const size_t A1 = (size_t)T * RW;
    bf16_t* pt = (bf16_t*)(ws + WS_PT);
    bf16_t* yt = (bf16_t*)(ws + WS_RWY);
    float* pq = (float*)(ws + WS_PQ);
    const float* mu = p.in[I_MU] + l * RWSLAB;
    const int tid = otid(), lane = tid & 63, wv = tid >> 6;
    const int rl = wv * 4 + (lane >> 4), kq = lane & 15;
    float* smV = sm + 5 * 2048;
    float* smY = smV + 2048;
    for (int item = obid(); item < 12 * NCH * 2; item += gridDim.x) {
        const int half = item & 1, c = (item >> 1) % NCH, bh = item / (2 * NCH), b = bh / 6, h = bh % 6;
        float4 st[4];
#pragma unroll
        for (int j = 0; j < 4; ++j) {
            const int row = j * 16 + rl;
            st[j].x = (half == 0 && kq * 4 + 0 == row) ? 1.f : 0.f;
            st[j].y = (half == 0 && kq * 4 + 1 == row) ? 1.f : 0.f;
            st[j].z = (half == 0 && kq * 4 + 2 == row) ? 1.f : 0.f;
            st[j].w = (half == 0 && kq * 4 + 3 == row) ? 1.f : 0.f;
        }
        for (int t0 = c * RC; t0 < (c + 1) * RC; t0 += 32) {
            __syncthreads();
            for (int i = tid; i < 512; i += NT) {
                const int tt = i >> 4, k4 = (i & 15) * 4;
                *(float4*)(sm + 1 * 2048 + tt * 64 + k4) = *(const float4*)(rw + ((size_t)b * S + t0 + tt) * RW + h * 64 + k4);
            }
            {
                const int tt = tid >> 3, k8 = (tid & 7) * 8;
                const bf16_t* rwb = (const bf16_t*)(rw + A1) + ((size_t)b * S + t0 + tt) * RW + h * 64 + k8;
                ld8bf(rwb + 0 * A1, sm + 0 * 2048 + tt * 64 + k8);
                ld8bf(rwb + 1 * A1, sm + 2 * 2048 + tt * 64 + k8);
                ld8bf(rwb + 2 * A1, sm + 3 * 2048 + tt * 64 + k8);
            }
            {
                const int tt = tid >> 3, k8 = (tid & 7) * 8;
                const bf16_t* pc = proj + ((size_t)b * S + t0 + tt) * INW + C_RWKV;
                float z[8];
                zmix8(pc, t0 + tt, h * 64 + k8, mu, z);
#pragma unroll
                for (int j = 0; j < 8; ++j) sm[4 * 2048 + tt * 64 + k8 + j] = z[j];
                if (half) zmix8(pc, t0 + tt, 768 + h * 64 + k8, mu, z);
#pragma unroll
                for (int j = 0; j < 8; ++j) smV[tt * 64 + k8 + j] = half ? z[j] : 0.f;
            }
            __syncthreads();
            RwOps cur, nxt;
            rw_load(cur, sm, smV, 0, kq, rl);
#pragma unroll 2
            for (int tt = 0; tt < 32; ++tt) {
                rw_load(nxt, sm, smV, (tt + 1) & 31, kq, rl);
                float y0, y1, y2, y3;
                rw_step4(st, cur, y0, y1, y2, y3);
                if (kq < 4) smY[tt * 64 + kq * 16 + rl] = kq == 0 ? y0 : (kq == 1 ? y1 : (kq == 2 ? y2 : y3));
                cur = nxt;
            }
            __syncthreads();
            {
                bf16_t* dst = half ? yt : pt;
                const int tt = tid >> 3, k8 = (tid & 7) * 8;
                *(bf16x8*)(dst + ((size_t)b * S + t0 + tt) * RW + h * 64 + k8) = pack8(smY + tt * 64 + k8);
            }
        }
#pragma unroll
        for (int j = 0; j < 4; ++j)
            *(float4*)(pq + ((size_t)((bh * NCH + c) * 2 + half)) * 4096 + (j * 16 + rl) * 64 + kq * 4) = st[j];
    }
}

DEVI f32x4 mma_tile(f32x4 acc, const float* A, int a_rs, int a_cs, const float* B, int b_rs, int b_cs, int K, int lr, int lq) {
#pragma unroll 4
    for (int ks = 0; ks < K; ks += 4) {
        const float a = A[lr * a_rs + (ks + lq) * a_cs];
        const float b = B[(ks + lq) * b_rs + lr * b_cs];
        acc = __builtin_amdgcn_mfma_f32_16x16x4f32(a, b, acc, 0, 0, 0);
    }
    return acc;
}
constexpr int WB = 16;
DEVI void ph_rwkv_chunk_wy(const P& p, int l, float* sm) {
    char* ws = ows(p);
    const bf16_t* proj = (const bf16_t*)(ws + WS_PROJ);
    const float* rw = (const float*)(ws + WS_RW);
    const size_t A1 = (size_t)T * RW;
    bf16_t* pt = (bf16_t*)(ws + WS_PT);
    bf16_t* yt = (bf16_t*)(ws + WS_RWY);
    float* pq = (float*)(ws + WS_PQ);
    const float* mu = p.in[I_MU] + l * RWSLAB;
    const int tid = otid(), lane = tid & 63, wid = tid >> 6, lr = lane & 15, lq = lane >> 4;
    float* rKK = sm;
    float* rW = sm + 1024; float* rNB = sm + 2048; float* rK = sm + 3072; float* rR = sm + 4096;
    float* xt = sm + 5120;
    float* At = sm + 6144;
    float* Bt = At + 1040; float* Kt = At + 2080; float* Rt = At + 3120;
    float* Sm = sm + 10304;
    float* WL = sm + 14464;
    float* Eb = sm;
    float* Lab = sm + 1040; float* Lak = Lab + 272; float* Lrb = Lak + 272; float* Lrk = Lrb + 272;
    float* Tm = Lrk + 272;
    for (int item = obid(); item < 12 * NCH * 2; item += gridDim.x) {
        const int half = item & 1, c = (item >> 1) % NCH, bh = item / (2 * NCH), b = bh / 6, h = bh % 6;
        __syncthreads();
        for (int i = tid; i < 64 * 64; i += NT) { const int r = i >> 6, k = i & 63; Sm[r * 65 + k] = (half == 0 && r == k) ? 1.f : 0.f; }
        for (int t0 = c * RC; t0 < (c + 1) * RC; t0 += WB) {
            __syncthreads();
            {
                const int tt = tid >> 4, k4 = (tid & 15) * 4;
                *(float4*)(rW + tt * 64 + k4) = *(const float4*)(rw + ((size_t)b * S + t0 + tt) * RW + h * 64 + k4);
            }
            if (tid < WB * 8) {
                const int tt = tid >> 3, k8 = (tid & 7) * 8;
                const bf16_t* rwb = (const bf16_t*)(rw + A1) + ((size_t)b * S + t0 + tt) * RW + h * 64 + k8;
                ld8bf(rwb + 0 * A1, rKK + tt * 64 + k8);
                ld8bf(rwb + 1 * A1, rNB + tt * 64 + k8);
                ld8bf(rwb + 2 * A1, rK + tt * 64 + k8);
                const bf16_t* pc = proj + ((size_t)b * S + t0 + tt) * INW + C_RWKV;
                float z[8];
                zmix8(pc, t0 + tt, h * 64 + k8, mu, z);
#pragma unroll
                for (int j = 0; j < 8; ++j) rR[tt * 64 + k8 + j] = z[j];
                if (half) zmix8(pc, t0 + tt, 768 + h * 64 + k8, mu, z);
#pragma unroll
                for (int j = 0; j < 8; ++j) xt[tt * 64 + k8 + j] = half ? z[j] : 0.f;
            }
            __syncthreads();
            {
                const int k = tid & 63, q = tid >> 6;
                float wv[16];
#pragma unroll
                for (int t = 0; t < 16; ++t) wv[t] = rW[t * 64 + k];
                float Wp = 1.f;
#pragma unroll
                for (int t = 0; t < 12; ++t) Wp *= (t < 4 * q) ? wv[t] : 1.f;
#pragma unroll
                for (int j = 0; j < 4; ++j) {
                    const int t = 4 * q + j;
                    const float w_t = q == 0 ? wv[j] : (q == 1 ? wv[4 + j] : (q == 2 ? wv[8 + j] : wv[12 + j]));
                    const float Wt = Wp * w_t, inv = frcp(Wt);
                    At[t * 65 + k] = Wp * rKK[t * 64 + k];
                    Bt[t * 65 + k] = rNB[t * 64 + k] * inv;
                    Kt[t * 65 + k] = rK[t * 64 + k] * inv;
                    Rt[t * 65 + k] = Wt * rR[t * 64 + k];
                    Wp = Wt;
                }
                if (q == 3) WL[k] = Wp;
            }
            __syncthreads();
            f32x4 e = (f32x4){0.f, 0.f, 0.f, 0.f}, y = e;
            {
                const float* ga = (wid < 2) ? At : Rt;
                const float* gb = (wid & 1) ? Kt : Bt;
                f32x4 g = (f32x4){0.f, 0.f, 0.f, 0.f};
                const float* sb = Sm + 16 * wid * 65;
#pragma unroll 4
                for (int ks = 0; ks < 64; ks += 4) {
                    const float ag = ga[lr * 65 + ks + lq], bg = gb[ks + lq + lr * 65];
                    const float a1 = At[lr * 65 + ks + lq], a2 = Rt[lr * 65 + ks + lq], bs = sb[ks + lq + lr * 65];
                    g = __builtin_amdgcn_mfma_f32_16x16x4f32(ag, bg, g, 0, 0, 0);
                    e = __builtin_amdgcn_mfma_f32_16x16x4f32(a1, bs, e, 0, 0, 0);
                    y = __builtin_amdgcn_mfma_f32_16x16x4f32(a2, bs, y, 0, 0, 0);
                }
                float* gd = wid == 0 ? Lab : (wid == 1 ? Lak : (wid == 2 ? Lrb : Lrk));
#pragma unroll
                for (int r = 0; r < 4; ++r) {
                    const int t = 4 * lq + r;
                    const bool keep = wid < 2 ? (lr < t) : (lr <= t);
                    gd[t * 17 + lr] = keep ? g[r] : 0.f;
                }
            }
            __syncthreads();
            if (half) {
                e = mma_tile(e, Lak, 17, 1, xt + 16 * wid, 64, 1, 16, lr, lq);
                y = mma_tile(y, Lrk, 17, 1, xt + 16 * wid, 64, 1, 16, lr, lq);
            }
#pragma unroll
            for (int r = 0; r < 4; ++r) Eb[(4 * lq + r) * 65 + 16 * wid + lr] = e[r];
            if (tid < 16) {
                float tc[16];
#pragma unroll
                for (int t = 0; t < 16; ++t) tc[t] = (t == tid) ? 1.f : 0.f;
#pragma unroll
                for (int j = 0; j < 15; ++j) {
                    const float tj = tc[j];
#pragma unroll
                    for (int t = j + 1; t < 16; ++t) tc[t] += Lab[t * 17 + j] * tj;
                }
#pragma unroll
                for (int t = 0; t < 16; ++t) Tm[t * 17 + tid] = tc[t];
            }
            __syncthreads();
            {
                f32x4 d = mma_tile((f32x4){0.f, 0.f, 0.f, 0.f}, Tm, 17, 1, Eb + 16 * wid, 65, 1, 16, lr, lq);
#pragma unroll
                for (int r = 0; r < 4; ++r) Eb[(4 * lq + r) * 65 + 16 * wid + lr] = d[r];
                y = mma_tile(y, Lrb, 17, 1, Eb + 16 * wid, 65, 1, 16, lr, lq);
                bf16_t* dst = (half ? yt : pt) + ((size_t)b * S + t0) * RW + h * 64 + 16 * wid + lr;
#pragma unroll
                for (int r = 0; r < 4; ++r) dst[(size_t)(4 * lq + r) * RW] = (bf16_t)f2bf(y[r]);
            }
            __syncthreads();
            {
                f32x4 sa[4];
#pragma unroll
                for (int n = 0; n < 4; ++n)
#pragma unroll
                    for (int r = 0; r < 4; ++r) sa[n][r] = Sm[(16 * wid + 4 * lq + r) * 65 + 16 * n + lr];
#pragma unroll
                for (int i = 0; i < 4; ++i) {
                    const float ad = Eb[(4 * i + lq) * 65 + 16 * wid + lr];
                    const float ax = xt[(4 * i + lq) * 64 + 16 * wid + lr];
#pragma unroll
                    for (int n = 0; n < 4; ++n) {
                        sa[n] = __builtin_amdgcn_mfma_f32_16x16x4f32(ad, Bt[(4 * i + lq) * 65 + 16 * n + lr], sa[n], 0, 0, 0);
                        if (half) sa[n] = __builtin_amdgcn_mfma_f32_16x16x4f32(ax, Kt[(4 * i + lq) * 65 + 16 * n + lr], sa[n], 0, 0, 0);
                    }
                }
#pragma unroll
                for (int n = 0; n < 4; ++n) {
                    const float wl = WL[16 * n + lr];
#pragma unroll
                    for (int r = 0; r < 4; ++r) Sm[(16 * wid + 4 * lq + r) * 65 + 16 * n + lr] = sa[n][r] * wl;
                }
            }
        }
        __syncthreads();
        float* o = pq + ((size_t)((bh * NCH + c) * 2 + half)) * 4096;
        for (int i = tid; i < 64 * 64; i += NT) o[i] = Sm[(i >> 6) * 65 + (i & 63)];
    }
}

DEVI void ph_rwkv_seq(const P& p, float* sm) {
    char* ws = ows(p);
    const float* pq = (const float*)(ws + WS_PQ);
    float* s0buf = (float*)(ws + WS_S0);
    const int tid = otid(), lane = tid & 63, wid = tid >> 6, lr = lane & 15, lq = lane >> 4;
    float* psm = sm;
    float* ssm = sm + 8192;
    if (obid() >= 48) return;
    const int bh = obid() >> 2, vg = obid() & 3;
    f32x4 st = (f32x4){0.f, 0.f, 0.f, 0.f};
    __syncthreads();
    {
        const float* P0 = pq + ((size_t)(bh * NCH) * 2) * 4096;
#pragma unroll
        for (int i = 0; i < 4; ++i) *(float4*)(psm + (tid + i * 256) * 4) = *(const float4*)(P0 + (tid + i * 256) * 4);
    }
    for (int c = 0; c < NCH; ++c) {
        float* s0t = s0buf + (size_t)(bh * NCH + c) * 4096;
        float* sc = ssm + (c & 1) * 1088;
#pragma unroll
        for (int r = 0; r < 4; ++r) {
            s0t[(16 * wid + lr) * 64 + vg * 16 + 4 * lq + r] = st[r];
            sc[(16 * wid + lr) * 17 + 4 * lq + r] = st[r];
        }
        __syncthreads();
        const int cn = c + 1 < NCH ? c + 1 : c;
        const float* Pn = pq + ((size_t)(bh * NCH + cn) * 2) * 4096;
        const float4 pre0 = *(const float4*)(Pn + (tid + 0 * 256) * 4), pre1 = *(const float4*)(Pn + (tid + 1 * 256) * 4);
        const float4 pre2 = *(const float4*)(Pn + (tid + 2 * 256) * 4), pre3 = *(const float4*)(Pn + (tid + 3 * 256) * 4);
        const float* qsrc = pq + ((size_t)(bh * NCH + c) * 2 + 1) * 4096 + (vg * 16 + 4 * lq) * 64 + 16 * wid + lr;
        const float q0 = qsrc[0], q1 = qsrc[64], q2 = qsrc[128], q3 = qsrc[192];
        const float* pc = psm + (c & 1) * 4096;
        f32x4 acc0 = (f32x4){0.f, 0.f, 0.f, 0.f}, acc1 = (f32x4){0.f, 0.f, 0.f, 0.f};
#pragma unroll
        for (int ks = 0; ks < 16; ks += 2) {
            const float a0 = sc[(4 * ks + lq) * 17 + lr], b0 = pc[(4 * ks + lq) * 64 + 16 * wid + lr];
            const float a1 = sc[(4 * ks + 4 + lq) * 17 + lr], b1 = pc[(4 * ks + 4 + lq) * 64 + 16 * wid + lr];
            acc0 = __builtin_amdgcn_mfma_f32_16x16x4f32(a0, b0, acc0, 0, 0, 0);
            acc1 = __builtin_amdgcn_mfma_f32_16x16x4f32(a1, b1, acc1, 0, 0, 0);
        }
        st[0] = acc0[0] + acc1[0] + q0; st[1] = acc0[1] + acc1[1] + q1; st[2] = acc0[2] + acc1[2] + q2; st[3] = acc0[3] + acc1[3] + q3;
        {
            float* pn = psm + ((c + 1) & 1) * 4096;
            *(float4*)(pn + (tid + 0 * 256) * 4) = pre0; *(float4*)(pn + (tid + 1 * 256) * 4) = pre1;
            *(float4*)(pn + (tid + 2 * 256) * 4) = pre2; *(float4*)(pn + (tid + 3 * 256) * 4) = pre3;
        }
    }
}

DEVI void ph_rwkv_post(const P& p, int l, float* sm) {
    char* ws = ows(p);
    const bf16_t* proj = (const bf16_t*)(ws + WS_PROJ);
    const bf16_t* pt = (const bf16_t*)(ws + WS_PT);
    const bf16_t* yt = (const bf16_t*)(ws + WS_RWY);
    const float* s0buf = (const float*)(ws + WS_S0);
    const float* rs = (const float*)(ws + WS_RS);
    bf16_t* ycat = (bf16_t*)(ws + WS_YCAT);
    const float* mu = p.in[I_MU] + l * RWSLAB;
    const float* g2 = p.in[I_G2] + (size_t)l * 128 * RW;
    const float* gng = p.in[I_GNG] + l * RW; const float* gnb = p.in[I_GNB] + l * RW;
    const int tid = otid(), tau = tid >> 2, vq = tid & 3;
    float* xs = sm;
    float* ms = sm + 4160;
    for (int item = obid(); item < 12 * (S / 64); item += gridDim.x) {
        const int tile = item % (S / 64), bh = item / (S / 64), b = bh / 6, h = bh % 6;
        const int s = tile * 64 + tau;
        const size_t t = (size_t)b * S + s;
        const int c = (tile * 64) / RC;
        const int hv = h * 64 + vq * 16;
        __syncthreads();
        for (int i = tid; i < 1024; i += NT) {
            const int tt = i >> 4, i4 = (i & 15) * 4;
            const float4 x = ld4bf(pt + ((size_t)b * S + tile * 64 + tt) * RW + h * 64 + i4);
            xs[tt * 65 + i4] = x.x; xs[tt * 65 + i4 + 1] = x.y; xs[tt * 65 + i4 + 2] = x.z; xs[tt * 65 + i4 + 3] = x.w;
            *(float4*)(ms + i * 4) = *(const float4*)(s0buf + (size_t)(bh * NCH + c) * 4096 + i * 4);
        }
        __syncthreads();
        float y[16];
#pragma unroll
        for (int c4 = 0; c4 < 4; ++c4) {
            const float4 x = ld4bf(yt + t * RW + hv + c4 * 4);
            y[c4 * 4] = x.x; y[c4 * 4 + 1] = x.y; y[c4 * 4 + 2] = x.z; y[c4 * 4 + 3] = x.w;
        }
#pragma unroll 4
        for (int i = 0; i < 64; ++i) {
            const float pv = xs[tau * 65 + i];
#pragma unroll
            for (int c4 = 0; c4 < 4; ++c4) {
                const float4 m4 = *(const float4*)(ms + i * 64 + vq * 16 + c4 * 4);
                y[c4 * 4] += pv * m4.x; y[c4 * 4 + 1] += pv * m4.y; y[c4 * 4 + 2] += pv * m4.z; y[c4 * 4 + 3] += pv * m4.w;
            }
        }
        float g[16];
#pragma unroll
        for (int cc = 0; cc < 16; ++cc) g[cc] = 0.f;
        for (int jh = 0; jh < 2; ++jh) {
            __syncthreads();
            for (int i = tid; i < 512; i += NT) {
                const int tt = i >> 3, j8 = (i & 7) * 8;
                const int s2 = tile * 64 + tt;
                float z[8];
                zmix8(proj + ((size_t)b * S + s2) * INW + C_RWKV, s2, 1280 + jh * 64 + j8, mu, z);
#pragma unroll
                for (int j = 0; j < 8; ++j) xs[tt * 65 + j8 + j] = sigmoidf_(z[j]);
            }
            for (int i = tid; i < 1024; i += NT) {
                const int j = i >> 4, c4 = (i & 15) * 4;
                *(float4*)(ms + j * 64 + c4) = *(const float4*)(g2 + (size_t)(jh * 64 + j) * RW + h * 64 + c4);
            }
            __syncthreads();
#pragma unroll 4
            for (int j = 0; j < 64; ++j) {
                const float zv = xs[tau * 65 + j];
#pragma unroll
                for (int c4 = 0; c4 < 4; ++c4) {
                    const float4 m4 = *(const float4*)(ms + j * 64 + vq * 16 + c4 * 4);
                    g[c4 * 4] += zv * m4.x; g[c4 * 4 + 1] += zv * m4.y; g[c4 * 4 + 2] += zv * m4.z; g[c4 * 4 + 3] += zv * m4.w;
                }
            }
        }
        float sum = 0.f;
#pragma unroll
        for (int cc = 0; cc < 16; ++cc) sum += y[cc];
        const float mean = quad_sum(sum) * (1.f / 64.f);
        float var = 0.f;
#pragma unroll
        for (int cc = 0; cc < 16; ++cc) { y[cc] -= mean; var += y[cc] * y[cc]; }
        const float rstd = 1.f / sqrtf(quad_sum(var) * (1.f / 64.f) + 64e-5f);
        const float rsv = rs[t * 6 + h];
        float vv[16];
        const bf16_t* pc = proj + t * INW + C_RWKV;
        zmix8(pc, s, 768 + hv, mu, vv); zmix8(pc, s, 768 + hv + 8, mu, vv + 8);
        float o[16];
#pragma unroll
        for (int cc = 0; cc < 16; ++cc) o[cc] = (y[cc] * rstd * gng[hv + cc] + gnb[hv + cc] + rsv * vv[cc]) * g[cc];
        u32x4 w0, w1;
        w0.x = pk2(o[0], o[1]); w0.y = pk2(o[2], o[3]); w0.z = pk2(o[4], o[5]); w0.w = pk2(o[6], o[7]);
        w1.x = pk2(o[8], o[9]); w1.y = pk2(o[10], o[11]); w1.z = pk2(o[12], o[13]); w1.w = pk2(o[14], o[15]);
        bf16_t* op = ycat + t * D + 384 + hv;
        *(u32x4*)op = w0; *(u32x4*)(op + 8) = w1;
    }
}

DEVI void ph_lru_prep(const P& p, int l, float* sm) {
    char* ws = ows(p);
    const bf16_t* proj = (const bf16_t*)(ws + WS_PROJ);
    float* la = (float*)(ws + WS_LA); float* lb = (float*)(ws + WS_LB);
    float* ca = (float*)(ws + WS_LC); float* cb2 = ca + NBATCH * 128 * LW;
    const float* cw = p.in[I_CW] + l * 4 * LW; const float* cb = p.in[I_CB] + l * LW;
    const float* wa = p.in[I_WA] + (size_t)l * 4 * 4096; const float* ba = p.in[I_BA] + l * LW;
    const float* wx = p.in[I_WX] + (size_t)l * 4 * 4096; const float* bx = p.in[I_BX] + l * LW;
    const float* lam = p.in[I_LAM] + l * LW;
    const int tid = otid(), tau = tid >> 2, jq = tid & 3;
    float* xs = sm;
    float* was = sm + 4160;
    float* wxs = sm + 8256;
    for (int item = obid(); item < (T / 64) * 4; item += gridDim.x) {
        const int hb = item & 3, tile = item >> 2;
        const int t = tile * 64 + tau, s = t & (S - 1);
        const int ch0 = hb * 64 + jq * 16;
        __syncthreads();
        float xc[16];
        {
            float raw[4][16];
#pragma unroll
            for (int q = 0; q < 4; ++q) {
                if (s - 3 + q >= 0) {
                    const bf16_t* src = proj + (size_t)(t - 3 + q) * INW + C_LRU + ch0;
                    ld8bf(src, raw[q]); ld8bf(src + 8, raw[q] + 8);
                } else {
#pragma unroll
                    for (int j = 0; j < 16; ++j) raw[q][j] = 0.f;
                }
            }
#pragma unroll
            for (int j = 0; j < 16; ++j) {
                const int ch = ch0 + j;
                xc[j] = cb[ch] + cw[ch] * raw[0][j] + cw[LW + ch] * raw[1][j] + cw[2 * LW + ch] * raw[2][j] + cw[3 * LW + ch] * raw[3][j];
                xs[tau * 65 + jq * 16 + j] = xc[j];
            }
        }
        for (int i = tid; i < 1024; i += NT) {
            *(float4*)(was + i * 4) = *(const float4*)(wa + (size_t)hb * 4096 + i * 4);
            *(float4*)(wxs + i * 4) = *(const float4*)(wx + (size_t)hb * 4096 + i * 4);
        }
        __syncthreads();
        float ra[16], ia[16];
#pragma unroll
        for (int j = 0; j < 16; ++j) { ra[j] = ba[ch0 + j]; ia[j] = bx[ch0 + j]; }
#pragma unroll 2
        for (int i = 0; i < 64; ++i) {
            const float xv = xs[tau * 65 + i];
#pragma unroll
            for (int c4 = 0; c4 < 4; ++c4) {
                const float4 a4 = *(const float4*)(was + i * 64 + jq * 16 + c4 * 4);
                const float4 x4 = *(const float4*)(wxs + i * 64 + jq * 16 + c4 * 4);
                ra[c4 * 4] += xv * a4.x; ra[c4 * 4 + 1] += xv * a4.y; ra[c4 * 4 + 2] += xv * a4.z; ra[c4 * 4 + 3] += xv * a4.w;
                ia[c4 * 4] += xv * x4.x; ia[c4 * 4 + 1] += xv * x4.y; ia[c4 * 4 + 2] += xv * x4.z; ia[c4 * 4 + 3] += xv * x4.w;
            }
        }
        __syncthreads();
#pragma unroll
        for (int j = 0; j < 16; ++j) {
            const float r = sigmoidf_(ra[j]), ig = sigmoidf_(ia[j]);
            const float lga = -8.f * r * softplusf_(-lam[ch0 + j]);
            ra[j] = fexp(lga);
            ia[j] = sqrtf(-expm1f(2.f * lga)) * (ig * xc[j]);
            was[tau * 64 + jq * 16 + j] = ra[j];
            wxs[tau * 64 + jq * 16 + j] = ia[j];
        }
#pragma unroll
        for (int c4 = 0; c4 < 4; ++c4) {
            *(float4*)(la + (size_t)t * LW + ch0 + c4 * 4) = make_float4(ra[c4 * 4], ra[c4 * 4 + 1], ra[c4 * 4 + 2], ra[c4 * 4 + 3]);
            *(float4*)(lb + (size_t)t * LW + ch0 + c4 * 4) = make_float4(ia[c4 * 4], ia[c4 * 4 + 1], ia[c4 * 4 + 2], ia[c4 * 4 + 3]);
        }
        __syncthreads();
        if (tid < 64) {
            float A = 1.f, Bv = 0.f;
            for (int tt = 0; tt < 64; ++tt) { const float a = was[tt * 64 + tid]; A *= a; Bv = a * Bv + wxs[tt * 64 + tid]; }
            ca[(size_t)tile * LW + hb * 64 + tid] = A; cb2[(size_t)tile * LW + hb * 64 + tid] = Bv;
        }
    }
}
DEVI void ph_lru_carry(const P& p) {
    char* ws = ows(p);
    const float* ca = (const float*)(ws + WS_LC); const float* cb = ca + NBATCH * 128 * LW;
    float* hin = (float*)(ws + WS_LC) + 2 * NBATCH * 128 * LW;
    for (int idx = obid() * NT + otid(); idx < NBATCH * LW; idx += gridDim.x * NT) {
        const int c = idx & 255, b = idx >> 8;
        float h = 0.f;
        for (int n0 = 0; n0 < 128; n0 += 16) {
            float a[16], bb[16];
#pragma unroll
            for (int j = 0; j < 16; ++j) { const int o = (b * 128 + n0 + j) * LW + c; a[j] = ca[o]; bb[j] = cb[o]; }
#pragma unroll
            for (int j = 0; j < 16; ++j) { const float hv = h; h = a[j] * h + bb[j]; a[j] = hv; }
#pragma unroll
            for (int j = 0; j < 16; ++j) hin[(b * 128 + n0 + j) * LW + c] = a[j];
        }
    }
}
DEVI void ph_lru_out(const P& p, int b0) {
    char* ws = ows(p);
    const bf16_t* proj = (const bf16_t*)(ws + WS_PROJ);
    const float* la = (const float*)(ws + WS_LA); const float* lb = (const float*)(ws + WS_LB);
    const float* hin = (const float*)(ws + WS_LC) + 2 * NBATCH * 128 * LW;
    bf16_t* ycat = (bf16_t*)(ws + WS_YCAT);
    const int c = otid();
    if (obid() < b0) return;
    for (int tile = obid() - b0; tile < T / 64; tile += gridDim.x - b0) {
        float h = hin[(size_t)tile * LW + c];
#pragma unroll 4
        for (int i = 0; i < 64; ++i) {
            const size_t tok = (size_t)tile * 64 + i;
            h = la[tok * LW + c] * h + lb[tok * LW + c];
            ycat[tok * D + 768 + c] = (bf16_t)f2bf(h * gelu_tanh(bf2f(proj[tok * INW + C_LRU + 256 + c])));
        }
    }
}

DEVI void ph_ln1_router(const P& p, int l, float* sm) {
    char* ws = ows(p);
    const bf16_t* mix = (const bf16_t*)(ws + WS_MIX);
    bf16_t* x1b = (bf16_t*)(ws + WS_X1B);
    int* cnt = (int*)(ws + WS_CNT) + l * NE;
    int* list = (int*)(ws + WS_LIST);
    int* tinfo = (int*)(ws + WS_TINFO);
    float* tw = (float*)(ws + WS_TW);
    const float* wg = p.in[I_MWG] + (size_t)l * D * 4; const float* bg = p.in[I_MBG] + l * 4;
    const float* we = p.in[I_MWE] + (size_t)l * D * NE; const float* be = p.in[I_MBE] + l * NE;
    const int tid = otid(), lane = tid & 63, wid = tid >> 6;
    float* xs = sm;
    float* part = sm + 8192;
    float* lgs = sm + 8192 + 1280;
    for (int rb = obid(); rb < T / 8; rb += gridDim.x) {
        __syncthreads();
#pragma unroll 1
        for (int rr = 0; rr < 2; ++rr) {
            const int r = wid * 2 + rr, row = rb * 8 + r;
            float4 v[4];
            ln_row<true>((const bf16_t*)(ws + WS_HB) + (size_t)row * D, ALPHA, mix + (size_t)row * D, nullptr, 0.f, nullptr, 0.f,
                          p.in[I_LN1G] + l * D, p.in[I_LN1B] + l * D, v, lane);
            store_row_bf(x1b + (size_t)row * D, v, lane);
            store_row(xs + r * 1024, v, lane);
        }
        __syncthreads();
        if (lane < 36) {
            const float* wcol = lane < 4 ? wg + lane : we + (lane - 4);
            const int stride = lane < 4 ? 4 : NE;
            float acc[8];
#pragma unroll
            for (int r = 0; r < 8; ++r) acc[r] = 0.f;
#pragma unroll 2
            for (int e4 = 0; e4 < 64; ++e4) {
                const int e = wid * 256 + e4 * 4;
                const float w0 = wcol[(size_t)(e + 0) * stride], w1 = wcol[(size_t)(e + 1) * stride];
                const float w2 = wcol[(size_t)(e + 2) * stride], w3 = wcol[(size_t)(e + 3) * stride];
#pragma unroll
                for (int r = 0; r < 8; ++r) {
                    const float4 x = *(const float4*)(xs + r * 1024 + e);
                    acc[r] += (x.x * w0 + x.y * w1) + (x.z * w2 + x.w * w3);
                }
            }
#pragma unroll
            for (int r = 0; r < 8; ++r) part[(wid * 8 + r) * 40 + lane] = acc[r];
        }
        __syncthreads();
        for (int i = tid; i < 288; i += NT) {
            const int r = i / 36, o = i % 36;
            const float bias = o < 4 ? bg[o] : be[o - 4];
            lgs[r * 40 + o] = ((part[(0 * 8 + r) * 40 + o] + part[(1 * 8 + r) * 40 + o]) + (part[(2 * 8 + r) * 40 + o] + part[(3 * 8 + r) * 40 + o])) + bias;
        }
        __syncthreads();
        if (tid < 8) {
            const float* L = lgs + tid * 40;
            const int row = rb * 8 + tid;
            int gs = 0; float gm = L[0];
            for (int g = 1; g < 4; ++g) if (L[g] > gm) { gm = L[g]; gs = g; }
            float den = 0.f;
            for (int g = 0; g < 4; ++g) den += expf(L[g] - gm);
            const float ggate = 1.f / den;
            const float* el = L + 4 + gs * 8;
            int i1 = 0; float m1 = el[0];
            for (int j = 1; j < 8; ++j) if (el[j] > m1) { m1 = el[j]; i1 = j; }
            int i2 = -1; float m2 = -3.0e38f;
            for (int j = 0; j < 8; ++j) if (j != i1 && el[j] > m2) { m2 = el[j]; i2 = j; }
            const float p2 = expf(m2 - m1);
            const float wt1 = ggate / (1.f + p2), wt2 = ggate * p2 / (1.f + p2);
            const int e1 = gs * 8 + i1, e2 = gs * 8 + i2;
            const int pos1 = atomicAdd(&cnt[e1], 1);
            const int pos2 = atomicAdd(&cnt[e2], 1);
            list[(size_t)e1 * T + pos1] = row;
            list[(size_t)e2 * T + pos2] = row;
            tinfo[row * 4 + 0] = e1; tinfo[row * 4 + 1] = pos1; tinfo[row * 4 + 2] = e2; tinfo[row * 4 + 3] = pos2;
            tw[row * 2 + 0] = wt1; tw[row * 2 + 1] = wt2;
        }
    }
}

DEVI void ph_moe(const P& p, int l, float* sm, int which) {
    char* ws = ows(p);
    const int* cnt = (const int*)(ws + WS_CNT) + l * NE;
    const int* list = (const int*)(ws + WS_LIST);
    const bf16_t* x1b = (const bf16_t*)(ws + WS_X1B);
    bf16_t* hid = (bf16_t*)(ws + WS_HID);
    bf16_t* out2 = (bf16_t*)(ws + WS_OUT2);
    const bf16_t* wgu = (const bf16_t*)(ws + WS_WGUT);
    const bf16_t* wd = (const bf16_t*)(ws + WS_WDT);
    const int tid = otid(), lane = tid & 63, wid = tid >> 6, wr = wid >> 1, wc = wid & 1, fr = lane & 15, fq = lane >> 4;
    int q = vblock();
    int tbase = 0, off = 0;
    int* cnts = (int*)(sm + 16384 + 32);
    __syncthreads();
    if (tid < NE) cnts[tid] = cnt[tid];
    __syncthreads();
    for (int e = 0; e < NE; ++e) {
        const int ne = cnts[e];
        const int tiles = ((ne + 127) >> 7) * 8;
        while (q < tbase + tiles) {
            const int lt = q - tbase, mi = lt >> 3, ni = lt & 7;
            const int mvalid = min(128, ne - mi * 128);
            f32x4 acc[4][4];
            if (which == 0) {
                gemm128_core((LAS char*)sm, x1b, D, list + (size_t)e * T + mi * 128, mvalid,
                             wgu + ((size_t)e * 1024 + ni * 128) * D, D, D, acc);
#pragma unroll
                for (int m = 0; m < 4; ++m) {
                    const int r = wr * 64 + m * 16 + fr;
                    if (r < mvalid) {
                        bf16_t* o = hid + (size_t)(off + mi * 128 + r) * DE + ni * 64 + wc * 32 + fq * 4;
#pragma unroll
                        for (int n = 0; n < 2; ++n) {
                            u32x2 w;
                            w.x = pk2(siluf_(acc[m][n][0]) * acc[m][n + 2][0], siluf_(acc[m][n][1]) * acc[m][n + 2][1]);
                            w.y = pk2(siluf_(acc[m][n][2]) * acc[m][n + 2][2], siluf_(acc[m][n][3]) * acc[m][n + 2][3]);
                            *(u32x2*)(o + n * 16) = w;
                        }
                    }
                }
            } else {
                gemm128_core((LAS char*)sm, hid + (size_t)(off + mi * 128) * DE, DE, nullptr, mvalid,
                             wd + ((size_t)e * D + ni * 128) * DE, DE, DE, acc);
#pragma unroll
                for (int m = 0; m < 4; ++m) {
                    const int r = wr * 64 + m * 16 + fr;
                    if (r < mvalid) {
                        bf16_t* o = out2 + (size_t)(off + mi * 128 + r) * D + ni * 128 + wc * 64 + fq * 4;
#pragma unroll
                        for (int n = 0; n < 4; ++n) { u32x2 w; w.x = pk2(acc[m][n][0], acc[m][n][1]); w.y = pk2(acc[m][n][2], acc[m][n][3]); *(u32x2*)(o + n * 16) = w; }
                    }
                }
            }
            q += gridDim.x;
        }
        tbase += tiles; off += ne;
    }
}

DEVI void ph_ln2(const P& p, int l, float* sm) {
    char* ws = ows(p);
    const int* cnt = (const int*)(ws + WS_CNT) + l * NE;
    const int* tinfo = (const int*)(ws + WS_TINFO);
    const float* tw = (const float*)(ws + WS_TW);
    const bf16_t* x1 = (const bf16_t*)(ws + WS_X1B);
    const bf16_t* out2 = (const bf16_t*)(ws + WS_OUT2);
    bf16_t* hb = (bf16_t*)(ws + WS_HB);
    int* offs = (int*)sm;
    const int tid = otid(), lane = tid & 63;
    __syncthreads();
    if (tid < NE) offs[64 + tid] = cnt[tid];
    __syncthreads();
    if (tid == 0) { int o = 0; for (int e = 0; e < NE; ++e) { offs[e] = o; o += offs[64 + e]; } }
    __syncthreads();
    const int gw = (obid() * NT + tid) >> 6, nw = gridDim.x * (NT / 64);
    for (int row = gw; row < T; row += nw) {
        const int e1 = tinfo[row * 4], p1 = tinfo[row * 4 + 1], e2 = tinfo[row * 4 + 2], p2 = tinfo[row * 4 + 3];
        const bf16_t* o0 = out2 + (size_t)(offs[e1] + p1) * D;
        const bf16_t* o1 = out2 + (size_t)(offs[e2] + p2) * D;
        float4 v[4];
        ln_row<true>(x1 + (size_t)row * D, ALPHA, nullptr, o0, tw[row * 2], o1, tw[row * 2 + 1],
               p.in[I_LN2G] + l * D, p.in[I_LN2B] + l * D, v, lane);
        if (l == 0) store_row_bf(hb + (size_t)row * D, v, lane);
        else store_row(p.out + (size_t)row * D, v, lane);
    }
}

#define XB_TMO      128
#define XB_XCNT(j)  (256  + 64 * (j))
#define XB_XSUB(j)  (1280 + 64 * (j))
#define XB_XGEN(j)  (2304 + 64 * (j))
#define XB_TOP      3328
#define XB_TOPGEN   3392
#define XCD_BAR_WORDS 3456
#define XB_SPIN_CAP (1u << 18)
DEVI unsigned xb_ld(unsigned* p)              { return __hip_atomic_load(p, __ATOMIC_RELAXED, __HIP_MEMORY_SCOPE_AGENT); }
DEVI unsigned xb_add(unsigned* p, unsigned v) { return __hip_atomic_fetch_add(p, v, __ATOMIC_RELAXED, __HIP_MEMORY_SCOPE_AGENT); }
DEVI unsigned xb_xcc_id() { return (unsigned)__builtin_amdgcn_s_getreg((3 << 11) | 20) & 0xFu; }
#define XB_SPIN(cond, bar) do { unsigned _sp = 0; while (cond) { __builtin_amdgcn_s_sleep(1); \
    if ((++_sp & 255u) == 0u) { if (xb_ld(&(bar)[XB_TMO])) break; if (_sp > XB_SPIN_CAP) { atomicAdd(&(bar)[XB_TMO], 1u); break; } } } } while (0)
struct XcdBarrier { unsigned* bar; unsigned x; volatile LAS unsigned* st; };
DEVI XcdBarrier xcd_barrier_post(unsigned* bar, volatile LAS unsigned* st) {
    XcdBarrier b; b.bar = bar; b.x = xb_xcc_id(); b.st = st;
    if (threadIdx.x == 0) (void)xb_add(&bar[XB_XCNT(b.x)], 1u);
    return b;
}
DEVI void xcd_barrier_complete(unsigned* bar, unsigned x, unsigned& nloc, unsigned& nx) {
    const unsigned G = gridDim.x * gridDim.y * gridDim.z;
    unsigned sum, cnt, mine, sp = 0u;
    for (;;) {
        sum = 0u; cnt = 0u; mine = 0u;
#pragma unroll
        for (unsigned j = 0; j < 16; ++j) { const unsigned c = xb_ld(&bar[XB_XCNT(j)]); sum += c; cnt += (c > 0u) ? 1u : 0u; mine = (j == x) ? c : mine; }
        if (sum == G) break;
        __builtin_amdgcn_s_sleep(1);
        if ((++sp & 255u) == 0u) { if (xb_ld(&bar[XB_TMO])) break; if (sp > XB_SPIN_CAP) { atomicAdd(&bar[XB_TMO], 1u); break; } }
    }
    nloc = mine > 0u ? mine : 1u; nx = cnt > 0u ? cnt : 1u;
}
DEVI void xcd_barrier(const XcdBarrier& b) {
    asm volatile("s_waitcnt vmcnt(0)" ::: "memory");
    __syncthreads();
    if (threadIdx.x == 0) {
        unsigned* bar = b.bar;
        __builtin_amdgcn_s_waitcnt(0);
        unsigned nloc = b.st[0], nx = b.st[1];
        if (nloc == 0u) { xcd_barrier_complete(bar, b.x, nloc, nx); b.st[0] = nloc; b.st[1] = nx; }
        const unsigned old = xb_add(&bar[XB_XSUB(b.x)], 1u);
        const unsigned gen = old / nloc;
        if (old + 1u == (gen + 1u) * nloc) {
            __builtin_amdgcn_fence(__ATOMIC_RELEASE, "agent");
            asm volatile("s_waitcnt vmcnt(0)" ::: "memory");
            const unsigned og = xb_add(&bar[XB_TOP], 1u);
            const unsigned tg = og / nx;
            if (og + 1u == (tg + 1u) * nx) xb_add(&bar[XB_TOPGEN], 1u);
            else XB_SPIN(xb_ld(&bar[XB_TOPGEN]) == tg, bar);
            __builtin_amdgcn_fence(__ATOMIC_ACQUIRE, "agent");
            xb_add(&bar[XB_XGEN(b.x)], 1u);
            asm volatile("s_waitcnt vmcnt(0)" ::: "memory");
        } else {
            XB_SPIN(xb_ld(&bar[XB_XGEN(b.x)]) == gen, bar);
            __builtin_amdgcn_fence(__ATOMIC_ACQUIRE, "agent");
            asm volatile("s_waitcnt vmcnt(0)" ::: "memory");
        }
    }
    __syncthreads();
}

#ifndef PROBE
#define PROBE 0
#endif
constexpr int LDS_BYTES = 65536 + 256;

__global__ void __launch_bounds__(NT, 2) k_mega(P p) {
    extern __shared__ __attribute__((aligned(16))) float sm[];
    volatile LAS unsigned* ctl = (volatile LAS unsigned*)((LAS char*)sm + 65536);
    if (threadIdx.x < 16) ctl[threadIdx.x] = 0u;
    __syncthreads();
    const XcdBarrier bar = xcd_barrier_post((unsigned*)(p.ws + WS_BAR), ctl);
#define GSYNC() xcd_barrier(bar)
    ph_ln_in(p);
    ph_wprep_dense(p, sm);
    GSYNC();
    if (PROBE & 128) { ph_ln_in(p); GSYNC(); }
    if (PROBE & 256) { ph_wprep_dense(p, sm); GSYNC(); }
    for (int l = 0; l < 2; ++l) {
        ph_inproj(p, l, sm); GSYNC();
        if (PROBE & 1) { ph_inproj(p, l, sm); GSYNC(); }
        ph_rwkv_prep(p, l, sm);
        ph_lru_prep(p, l, sm);
        ph_ret_kv(p, sm, 0); GSYNC();
        if (PROBE & 2) { ph_rwkv_prep(p, l, sm); GSYNC(); }
        if (PROBE & 2048) { ph_lru_prep(p, l, sm); GSYNC(); }
        if (PROBE & 4096) { ph_ret_kv(p, sm, 0); GSYNC(); }
        if (PROBE & 4) { ph_rwkv_chunk_wy(p, l, sm); GSYNC(); }
        if (PROBE & 8) { ph_wprep_moe(p, l, sm, 0); GSYNC(); }
        ph_rwkv_chunk_wy(p, l, sm);
        ph_wprep_moe(p, l, sm, 0);
        ph_ret_scan(p);
        ph_lru_carry(p); GSYNC();
        ph_rwkv_seq(p, sm);
        ph_ret_out(p, sm, 48);
        ph_lru_out(p, 48); GSYNC();
        if (PROBE & 16) { ph_rwkv_seq(p, sm); ph_ret_out(p, sm, 48); ph_lru_out(p, 48); GSYNC(); }
        if (PROBE & 8192) { ph_rwkv_seq(p, sm); GSYNC(); }
        if (PROBE & 16384) { ph_ret_out(p, sm, 48); GSYNC(); }
        if (PROBE & 32768) { ph_lru_out(p, 48); GSYNC(); }
        ph_rwkv_post(p, l, sm); GSYNC();
        if (PROBE & 32) { ph_rwkv_post(p, l, sm); GSYNC(); }
        ph_outproj(p, l, sm); GSYNC();
        if (PROBE & 1) { ph_outproj(p, l, sm); GSYNC(); }
        ph_ln1_router(p, l, sm); GSYNC();
        ph_moe(p, l, sm, 0); GSYNC();
        if (PROBE & 1) { ph_moe(p, l, sm, 0); GSYNC(); }
        ph_moe(p, l, sm, 1); GSYNC();
        if (PROBE & 1) { ph_moe(p, l, sm, 1); GSYNC(); }
        ph_ln2(p, l, sm); GSYNC();
        if (PROBE & 64) { ph_ln2(p, l, sm); GSYNC(); }
        if (PROBE & 512) { for (int i = 0; i < 10; ++i) GSYNC(); }
        if (PROBE & 1024) { ph_ret_scan(p); ph_lru_carry(p); GSYNC(); ph_ret_scan(p); ph_lru_carry(p); GSYNC(); }
    }
#undef GSYNC
}

extern "C" void kernel_launch(void* const* d_in, const int* in_sizes, int n_in, void* d_out, int out_size,
                              void* d_ws, size_t ws_size, hipStream_t stream) {
    if (n_in != 34 || ws_size < WS_END) { fprintf(stderr, "kernel_launch: bad args n_in=%d ws=%zu need %zu\n", n_in, ws_size, (size_t)WS_END); return; }
    P p{};
    for (int i = 0; i < 34; ++i) p.in[i] = (const float*)d_in[i];
    p.out = (float*)d_out; p.ws = (char*)d_ws;
    static int grid_blocks = 0;
    if (!grid_blocks) {
        int dev = 0, cus = 0, per_cu = 0;
        (void)hipGetDevice(&dev);
        (void)hipDeviceGetAttribute(&cus, hipDeviceAttributeMultiprocessorCount, dev);
        (void)hipFuncSetAttribute((const void*)k_mega, hipFuncAttributeMaxDynamicSharedMemorySize, LDS_BYTES);
        (void)hipOccupancyMaxActiveBlocksPerMultiprocessor(&per_cu, k_mega, NT, LDS_BYTES);
        if (per_cu < 1) per_cu = 1;
        if (per_cu > 2) per_cu = 2;
        grid_blocks = cus * per_cu;
        fprintf(stderr, "kernel_launch: cus=%d per_cu=%d grid=%d\n", cus, per_cu, grid_blocks);
    }
    (void)hipMemsetAsync((char*)d_ws + WS_CTL, 0, CTL_BYTES, stream);
    void* args[] = {&p};
    hipError_t e = hipLaunchCooperativeKernel((void*)k_mega, dim3(grid_blocks), dim3(NT), args, LDS_BYTES, stream);
    if (e != hipSuccess) fprintf(stderr, "cooperative launch failed: %s (grid %d)\n", hipGetErrorString(e), grid_blocks);
}
```

```cpp
#include <hip/hip_runtime.h>
#include <cstdio>
#include <cstdint>

#define DEVI __device__ __forceinline__

constexpr int D = 1024, NBATCH = 2, S = 8192, T = NBATCH * S;
constexpr int INW = 3456;
constexpr int C_RWKV = 1536, C_LRU = 2944;
constexpr int RW = 384;
constexpr int RWSLAB = 1408;
constexpr int LW = 256;
constexpr int NE = 32, DE = 512;
constexpr int NT = 256;
constexpr float ALPHA = 1.4142135623730951f;
constexpr float LN_EPS = 1e-5f;

constexpr size_t al256(size_t x) { return (x + 255) & ~(size_t)255; }
constexpr size_t WS_WINT = 0;
constexpr size_t WS_WOUTT = al256(WS_WINT + (size_t)2 * INW * D * 2);
constexpr size_t WS_WGUT = al256(WS_WOUTT + (size_t)2 * D * D * 2);
constexpr size_t WS_WDT = al256(WS_WGUT + (size_t)NE * 1024 * D * 2);
constexpr size_t WS_ROPE = al256(WS_WDT + (size_t)NE * D * DE * 2);
constexpr size_t WS_HB = al256(WS_ROPE + (size_t)S * 32 * 8);
constexpr size_t WS_PROJ = al256(WS_HB + (size_t)T * D * 2);
constexpr size_t SZ_PROJ = (size_t)T * INW * 2;
constexpr size_t WS_YCAT = al256(WS_PROJ + SZ_PROJ);
constexpr size_t WS_RW = al256(WS_YCAT + (size_t)T * D * 2);
constexpr size_t SZ_RW1 = (size_t)T * RW * 4;
constexpr size_t WS_RWY = al256(WS_RW + 4 * SZ_RW1);
constexpr size_t WS_LA = al256(WS_RWY + SZ_RW1);
constexpr size_t SZ_L1 = (size_t)T * LW * 4;
constexpr size_t WS_LB = al256(WS_LA + SZ_L1);
constexpr size_t WS_KV = al256(WS_LB + SZ_L1);
constexpr size_t SZ_KV = (size_t)NBATCH * 64 * 6 * 4096 * 4;
constexpr size_t WS_PQ = al256(WS_KV + SZ_KV);
constexpr size_t WS_S0 = al256(WS_PQ + (size_t)12 * 64 * 2 * 4096 * 4);
constexpr size_t WS_RS = al256(WS_S0 + (size_t)12 * 64 * 4096 * 4);
constexpr size_t WS_LC = al256(WS_RS + (size_t)T * 6 * 4);
constexpr size_t SZ_LC1 = (size_t)NBATCH * 128 * LW * 4;
constexpr size_t WS_CTL = al256(WS_LC + 3 * SZ_LC1);
constexpr size_t WS_BAR = WS_CTL;
constexpr int CS = 64;
constexpr size_t WS_CNT = WS_CTL + 16384;
constexpr size_t CTL_BYTES = 16384 + (size_t)2 * NE * CS * 4;
constexpr size_t WS_LIST = al256(WS_CNT + (size_t)2 * NE * CS * 4);
constexpr size_t WS_TINFO = al256(WS_LIST + (size_t)NE * T * 4);
constexpr size_t WS_TW = al256(WS_TINFO + (size_t)T * 16);
constexpr size_t WS_WRT = al256(WS_TW + (size_t)T * 8);
constexpr size_t WS_END = al256(WS_WRT + (size_t)2 * D * 48 * 4);
constexpr size_t WS_MIX = WS_RW;
constexpr size_t WS_OUT2 = WS_RW;
constexpr size_t WS_X1 = WS_PROJ;
constexpr size_t WS_X1B = WS_PROJ + (size_t)T * D * 4;
constexpr size_t WS_HID = WS_RW + (size_t)2 * T * D * 2;
static_assert(WS_X1B + (size_t)T * D * 2 <= WS_PROJ + SZ_PROJ, "X1/X1b fit in PROJ");
constexpr size_t WS_PT = WS_RW + 3 * SZ_RW1;
static_assert(WS_OUT2 + (size_t)2 * T * D * 4 <= WS_KV, "OUT2 fits in RW..LB");
static_assert(WS_HID + (size_t)2 * T * DE * 2 <= WS_RW + 4 * SZ_RW1, "HID fits in RW");
static_assert(WS_END <= (size_t)536870912, "workspace budget");

typedef unsigned short bf16_t;
typedef short bf16x8 __attribute__((ext_vector_type(8)));
typedef float f32x4 __attribute__((ext_vector_type(4)));
typedef unsigned u32x2 __attribute__((ext_vector_type(2)));
typedef unsigned u32x4 __attribute__((ext_vector_type(4)));
#define LAS __attribute__((address_space(3)))
constexpr int CTLF = 16384 + 3200;

struct P {
    const float* in[36];
};

DEVI const float* pin(const P& p, int i) { int z = 0; asm volatile("" : "+s"(z)); return p.in[i + z]; }
DEVI char* ows(const P& p) { int z = 0; asm volatile("" : "+s"(z)); return (char*)const_cast<float*>(p.in[35 + z]); }
enum { I_X = 0, I_LNG, I_LNB, I_WIN, I_WOUT, I_MU, I_W0, I_W2, I_A0, I_A2, I_G2, I_KK, I_KA, I_RK, I_GNG, I_GNB,
       I_CW, I_CB, I_WA, I_BA, I_WX, I_BX, I_LAM, I_LN1G, I_LN1B, I_MWG, I_MBG, I_MWE, I_MBE, I_MG, I_MU_, I_MD, I_LN2G, I_LN2B };

DEVI int otid() { int t = threadIdx.x; asm volatile("" : "+v"(t)); return t; }
DEVI int obid() { int b = blockIdx.x; asm volatile("" : "+s"(b)); return b; }
struct P;
template <int CTRL> DEVI float dpp_mov(float v) { return __builtin_bit_cast(float, __builtin_amdgcn_update_dpp(0, __builtin_bit_cast(int, v), CTRL, 0xF, 0xF, true)); }
DEVI float red16(float x) {
    x += dpp_mov<0xB1>(x);
    x += dpp_mov<0x4E>(x);
    x += dpp_mov<0x141>(x);
    x += dpp_mov<0x140>(x);
    return x;
}
DEVI float wave_sum(float v) {
    v = red16(v);
    const float r0 = __builtin_bit_cast(float, __builtin_amdgcn_readlane(__builtin_bit_cast(int, v), 0));
    const float r1 = __builtin_bit_cast(float, __builtin_amdgcn_readlane(__builtin_bit_cast(int, v), 16));
    const float r2 = __builtin_bit_cast(float, __builtin_amdgcn_readlane(__builtin_bit_cast(int, v), 32));
    const float r3 = __builtin_bit_cast(float, __builtin_amdgcn_readlane(__builtin_bit_cast(int, v), 48));
    return (r0 + r1) + (r2 + r3);
}
DEVI float fexp(float x) { return __builtin_amdgcn_exp2f(x * 1.4426950408889634f); }
DEVI float frcp(float x) { return __builtin_amdgcn_rcpf(x); }
DEVI float sigmoidf_(float x) { return frcp(1.f + fexp(-x)); }
DEVI float siluf_(float x) { return x * frcp(1.f + fexp(-x)); }
DEVI float softplusf_(float x) { return fmaxf(x, 0.f) + __builtin_amdgcn_logf(1.f + fexp(-fabsf(x))) * 0.6931471805599453f; }
DEVI float ftanh(float x) { const float e = fexp(-2.f * fabsf(x)); const float t = (1.f - e) * frcp(1.f + e); return x < 0.f ? -t : t; }
DEVI float gelu_tanh(float x) { return 0.5f * x * (1.f + ftanh(0.7978845608028654f * (x + 0.044715f * x * x * x))); }
typedef __bf16 bf16v2 __attribute__((ext_vector_type(2)));
typedef float f32v2 __attribute__((ext_vector_type(2)));
DEVI unsigned pk2(float lo, float hi) { const f32v2 f = {lo, hi}; return __builtin_bit_cast(unsigned, __builtin_convertvector(f, bf16v2)); }
DEVI unsigned f2bf(float f) { return pk2(f, 0.f) & 0xffffu; }
DEVI float bf2f(bf16_t x) { return __uint_as_float((unsigned)x << 16); }
DEVI float bflo(unsigned u) { return __uint_as_float(u << 16); }
DEVI float bfhi(unsigned u) { return __uint_as_float(u & 0xffff0000u); }
__device__ const double LOGG[6] = {-0.0317486983145803, -0.015748356968139168, -0.007843177461025893,
                                   -0.003913899321136329, -0.0019550348358033506, -0.0009770396478266127};

DEVI void rope_sincos(int s, int i, float& sn, float& cs) {
    double inv = 1.0;
    for (int q = 0; q < i; ++q) inv *= 0.7498942093324559;
    const double ang = (double)s * inv;
    const double n = rint(ang * 0.6366197723675814);
    const double r = fma(-n, 1.5707963267948966, ang);
    const int q = (int)(((long long)n) & 3);
    const double r2 = r * r;
    const double sp = r * (1.0 + r2 * (-1.0 / 6 + r2 * (1.0 / 120 + r2 * (-1.0 / 5040 + r2 * (1.0 / 362880 + r2 * (-1.0 / 39916800))))));
    const double cp = 1.0 + r2 * (-0.5 + r2 * (1.0 / 24 + r2 * (-1.0 / 720 + r2 * (1.0 / 40320 + r2 * (-1.0 / 3628800 + r2 * (1.0 / 479001600))))));
    double s_, c_;
    if (q == 0) { s_ = sp; c_ = cp; } else if (q == 1) { s_ = cp; c_ = -sp; } else if (q == 2) { s_ = -sp; c_ = -cp; } else { s_ = -cp; c_ = sp; }
    sn = (float)s_; cs = (float)c_;
}

DEVI float4 ld4bf(const bf16_t* p) { const u32x2 u = *(const u32x2*)p; return make_float4(bflo(u.x), bfhi(u.x), bflo(u.y), bfhi(u.y)); }
template <bool ABF>
DEVI void ln_row(const void* a, float alpha, const bf16_t* m, const bf16_t* o0, float w0, const bf16_t* o1, float w1,
                 const float* g, const float* bb, float4 (&v)[4], int lane) {
    float s = 0.f;
#pragma unroll
    for (int j = 0; j < 4; ++j) {
        const int e = (j * 64 + lane) * 4;
        float4 x = ABF ? ld4bf((const bf16_t*)a + e) : *(const float4*)((const float*)a + e);
        x.x *= alpha; x.y *= alpha; x.z *= alpha; x.w *= alpha;
        if (m) { const float4 y = ld4bf(m + e); x.x += y.x; x.y += y.y; x.z += y.z; x.w += y.w; }
        if (o0) {
            const float4 y0 = ld4bf(o0 + e); const float4 y1 = ld4bf(o1 + e);
            x.x += w0 * y0.x + w1 * y1.x; x.y += w0 * y0.y + w1 * y1.y; x.z += w0 * y0.z + w1 * y1.z; x.w += w0 * y0.w + w1 * y1.w;
        }
        v[j] = x; s += (x.x + x.y) + (x.z + x.w);
    }
    const float mean = wave_sum(s) * (1.f / D);
    float q = 0.f;
#pragma unroll
    for (int j = 0; j < 4; ++j) {
        v[j].x -= mean; v[j].y -= mean; v[j].z -= mean; v[j].w -= mean;
        q += (v[j].x * v[j].x + v[j].y * v[j].y) + (v[j].z * v[j].z + v[j].w * v[j].w);
    }
    const float rstd = 1.f / sqrtf(wave_sum(q) * (1.f / D) + LN_EPS);
#pragma unroll
    for (int j = 0; j < 4; ++j) {
        const int e = (j * 64 + lane) * 4;
        const float4 gg = *(const float4*)(g + e); const float4 b4 = *(const float4*)(bb + e);
        v[j].x = v[j].x * rstd * gg.x + b4.x; v[j].y = v[j].y * rstd * gg.y + b4.y;
        v[j].z = v[j].z * rstd * gg.z + b4.z; v[j].w = v[j].w * rstd * gg.w + b4.w;
    }
}
DEVI void store_row(float* o, const float4 (&v)[4], int lane) {
#pragma unroll
    for (int j = 0; j < 4; ++j) *(float4*)(o + (j * 64 + lane) * 4) = v[j];
}

DEVI void store_row_bf(bf16_t* o, const float4 (&v)[4], int lane) {
#pragma unroll
    for (int j = 0; j < 4; ++j) { u32x2 w; w.x = pk2(v[j].x, v[j].y); w.y = pk2(v[j].z, v[j].w); *(u32x2*)(o + (j * 64 + lane) * 4) = w; }
}

DEVI void ph_ln_in(const P& p) {
    const int tid = otid(), lane = tid & 63;
    const int gw = (obid() * NT + tid) >> 6, nw = gridDim.x * (NT / 64);
    char* ws = ows(p);
    bf16_t* hb = (bf16_t*)(ws + WS_HB);
    const float* xin = pin(p, I_X); const float* lng = pin(p, I_LNG); const float* lnb = pin(p, I_LNB);
    {
        const float* wgp = pin(p, I_MWG); const float* wep = pin(p, I_MWE);
        float* wrt = (float*)(ws + WS_WRT);
        for (int i = obid() * NT + tid; i < 2 * D * 48; i += gridDim.x * NT) {
            const int e = i & 3, ln = (i >> 2) & 63, g = (i >> 8) & 15, rest = i >> 12, t = rest % 3, lw = rest / 3;
            const int o = 16 * t + (ln & 15), lk = (lw >> 2) * D + (lw & 3) * 256 + 4 * (4 * g + e) + (ln >> 4);
            wrt[i] = o < 4 ? wgp[(size_t)lk * 4 + o] : (o < 36 ? wep[(size_t)lk * NE + (o - 4)] : 0.f);
        }
    }
    for (int row = gw; row < T; row += nw) {
        float4 v[4];
        ln_row<false>(xin + (size_t)row * D, 1.f, nullptr, nullptr, 0.f, nullptr, 0.f, lng, lnb, v, lane);
        store_row_bf(hb + (size_t)row * D, v, lane);
    }
    float2* rope = (float2*)(ws + WS_ROPE);
    for (int idx = obid() * NT + tid; idx < S * 32; idx += gridDim.x * NT) {
        float sn, cs; rope_sincos(idx >> 5, idx & 31, sn, cs);
        rope[idx] = make_float2(cs, sn);
    }
}

DEVI void tr_tile(float* sm, const float* W, int N, int k0, int n0, bf16_t* dst, int K, int map) {
    const int tid = otid();
    __syncthreads();
    float4 v[8];
#pragma unroll
    for (int i = 0; i < 8; ++i) {
        const int k = (tid >> 4) + i * 16, n4 = (tid & 15) * 4;
        { const f32x4 t = __builtin_nontemporal_load((const f32x4*)(W + (size_t)(k0 + k) * N + n0 + n4)); v[i] = make_float4(t[0], t[1], t[2], t[3]); }
    }
#pragma unroll
    for (int i = 0; i < 8; ++i) {
        const int k = (tid >> 4) + i * 16, n4 = (tid & 15) * 4;
        sm[k * 65 + n4] = v[i].x; sm[k * 65 + n4 + 1] = v[i].y; sm[k * 65 + n4 + 2] = v[i].z; sm[k * 65 + n4 + 3] = v[i].w;
    }
    __syncthreads();
    const int nl = tid >> 2, kq = (tid & 3) * 32;
    const int n = n0 + nl;
    const int row = map == 0 ? n : (64 * (n >> 5) + (n & 31) + (map == 2 ? 32 : 0));
    const float* c = sm + kq * 65 + nl;
    bf16_t* d = dst + (size_t)row * K + k0 + kq;
#pragma unroll
    for (int g = 0; g < 4; ++g) {
        u32x4 o;
        o.x = pk2(c[(g * 8 + 0) * 65], c[(g * 8 + 1) * 65]); o.y = pk2(c[(g * 8 + 2) * 65], c[(g * 8 + 3) * 65]);
        o.z = pk2(c[(g * 8 + 4) * 65], c[(g * 8 + 5) * 65]); o.w = pk2(c[(g * 8 + 6) * 65], c[(g * 8 + 7) * 65]);
        *(u32x4*)(d + g * 8) = o;
    }
}
DEVI void ph_wprep_dense(const P& p, float* sm) {
    char* ws = ows(p);
    constexpr int TI = (D / 128) * (INW / 64), TO = (D / 128) * (D / 64);
    const float* win = pin(p, I_WIN); const float* wout = pin(p, I_WOUT);
    for (int q = obid(); q < 2 * (TI + TO); q += gridDim.x) {
        int r = q; const int l = r / (TI + TO); r -= l * (TI + TO);
        if (r < TI) { const int kb = r / (INW / 64), nb = r % (INW / 64);
            tr_tile(sm, win + (size_t)l * D * INW, INW, kb * 128, nb * 64, (bf16_t*)(ws + WS_WINT) + (size_t)l * INW * D, D, 0); }
        else { r -= TI; const int kb = r / (D / 64), nb = r % (D / 64);
            tr_tile(sm, wout + (size_t)l * D * D, D, kb * 128, nb * 64, (bf16_t*)(ws + WS_WOUTT) + (size_t)l * D * D, D, 0); }
    }
}
DEVI void ph_wprep_moe(const P& p, int l, float* sm, int b0) {
    char* ws = ows(p);
    constexpr int TG = (D / 128) * (DE / 64), TD_ = (DE / 128) * (D / 64);
    const int nbk = gridDim.x - b0;
    constexpr int NHV = 6, NIT = NE * (2 * TG + TD_);
    const int ob = obid();
    const bool hv = ob < b0;
    const float* mg = pin(p, I_MG); const float* mup = pin(p, I_MU_); const float* md = pin(p, I_MD);
    for (int q = hv ? ob * NHV : b0 * NHV + (ob - b0); q < (hv ? (ob + 1) * NHV : NIT); q += hv ? 1 : nbk) {
        const int e = q / (2 * TG + TD_); int r = q - e * (2 * TG + TD_);
        if (r < 2 * TG) { const int up = r >= TG; if (up) r -= TG; const int kb = r / (DE / 64), nb = r % (DE / 64);
            tr_tile(sm, (up ? mup : mg) + ((size_t)(l * NE + e)) * D * DE, DE, kb * 128, nb * 64,
                    (bf16_t*)(ws + WS_WGUT) + (size_t)e * 1024 * D, D, up ? 2 : 1); }
        else { r -= 2 * TG; const int kb = r / (D / 64), nb = r % (D / 64);
            tr_tile(sm, md + ((size_t)(l * NE + e)) * DE * D, D, kb * 128, nb * 64,
                    (bf16_t*)(ws + WS_WDT) + (size_t)e * D * DE, DE, 0); }
    }
}

DEVI void gemm128_core(LAS char* lds, const bf16_t* A, int lda, const int* rowidx, int mvalid,
                       const bf16_t* Bt, int ldb, int K, f32x4 (&acc)[4][4]) {
    const int tid = otid(), lane = tid & 63, wid = tid >> 6, wr = wid >> 1, wc = wid & 1, fr = lane & 15, fq = lane >> 4;
    const int srow = tid >> 3, sch = tid & 7;
    const bf16_t* ap[4]; const bf16_t* bp[4];
#pragma unroll
    for (int i = 0; i < 4; ++i) {
        const int r = srow + i * 32;
        const int rr = r < mvalid ? r : 0;
        const int ri = rowidx ? rowidx[rr] : rr;
        const int c = sch ^ ((r >> 1) & 7);
        ap[i] = A + (size_t)ri * lda + c * 8;
        bp[i] = Bt + (size_t)r * ldb + c * 8;
    }
#pragma unroll
    for (int m = 0; m < 4; ++m)
#pragma unroll
        for (int n = 0; n < 4; ++n) acc[m][n] = (f32x4){0.f, 0.f, 0.f, 0.f};
    const int nt = K >> 6;
    const int sw = (fr >> 1) & 7;
    const int aoff = (wr * 64 + fr) * 128, boff = 16384 + (wc * 64 + fr) * 128;
#define GSTAGE(kt, buf) do { _Pragma("unroll") for (int _i = 0; _i < 4; ++_i) { \
        __builtin_amdgcn_global_load_lds((const unsigned*)(ap[_i] + (kt) * 64), (LAS unsigned*)(lds + (buf) * 32768 + tid * 16 + _i * 4096), 16, 0, 0); \
        __builtin_amdgcn_global_load_lds((const unsigned*)(bp[_i] + (kt) * 64), (LAS unsigned*)(lds + (buf) * 32768 + 16384 + tid * 16 + _i * 4096), 16, 0, 0); } } while (0)
    GSTAGE(0, 0);
#pragma unroll 4
    for (int kt = 0; kt < nt; ++kt) {
        asm volatile("s_waitcnt vmcnt(0)" ::: "memory");
        __syncthreads();
        if (kt + 1 < nt) GSTAGE(kt + 1, (kt + 1) & 1);
        const LAS char* base = lds + (kt & 1) * 32768;
#pragma unroll
        for (int kk = 0; kk < 2; ++kk) {
            bf16x8 af[4], bfr[4];
            const int co = (((kk * 4 + fq) ^ sw) * 16);
#pragma unroll
            for (int m = 0; m < 4; ++m) af[m] = *(const LAS bf16x8*)(base + aoff + m * 2048 + co);
#pragma unroll
            for (int n = 0; n < 4; ++n) bfr[n] = *(const LAS bf16x8*)(base + boff + n * 2048 + co);
            __builtin_amdgcn_s_setprio(1);
#pragma unroll
            for (int m = 0; m < 4; ++m)
#pragma unroll
                for (int n = 0; n < 4; ++n) acc[m][n] = __builtin_amdgcn_mfma_f32_16x16x32_bf16(bfr[n], af[m], acc[m][n], 0, 0, 0);
            __builtin_amdgcn_s_setprio(0);
        }
    }
#undef GSTAGE
}

template <int MT>
DEVI void gemm_core_mt(LAS char* lds, const bf16_t* A, int lda, const int* rowidx, int mvalid,
                       const bf16_t* Bt, int ldb, int K, f32x4 (&acc)[MT][4]) {
    const int tid = otid(), lane = tid & 63, wid = tid >> 6, wr = wid >> 1, wc = wid & 1, fr = lane & 15, fq = lane >> 4;
    const int srow = tid >> 3, sch = tid & 7;
    const bf16_t* ap[MT]; const bf16_t* bp[4];
#pragma unroll
    for (int i = 0; i < 4; ++i) {
        const int r = srow + i * 32;
        const int c = sch ^ ((r >> 1) & 7);
        bp[i] = Bt + (size_t)r * ldb + c * 8;
        if (i < MT) {
            const int rr = r < mvalid ? r : 0;
            const int ri = rowidx ? rowidx[rr] : rr;
            ap[i] = A + (size_t)ri * lda + c * 8;
        }
    }
#pragma unroll
    for (int m = 0; m < MT; ++m)
#pragma unroll
        for (int n = 0; n < 4; ++n) acc[m][n] = (f32x4){0.f, 0.f, 0.f, 0.f};
    const int nt = K >> 6;
    const int sw = (fr >> 1) & 7;
    const int aoff = (wr * 16 * MT + fr) * 128, boff = 16384 + (wc * 64 + fr) * 128;
#define GSTAGE_MT(kt, buf) do { \
        _Pragma("unroll") for (int _i = 0; _i < MT; ++_i) \
            __builtin_amdgcn_global_load_lds((const unsigned*)(ap[_i] + (kt) * 64), (LAS unsigned*)(lds + (buf) * 32768 + tid * 16 + _i * 4096), 16, 0, 0); \
        _Pragma("unroll") for (int _i = 0; _i < 4; ++_i) \
            __builtin_amdgcn_global_load_lds((const unsigned*)(bp[_i] + (kt) * 64), (LAS unsigned*)(lds + (buf) * 32768 + 16384 + tid * 16 + _i * 4096), 16, 0, 0); } while (0)
    GSTAGE_MT(0, 0);
#pragma unroll 4
    for (int kt = 0; kt < nt; ++kt) {
        asm volatile("s_waitcnt vmcnt(0)" ::: "memory");
        __syncthreads();
        if (kt + 1 < nt) GSTAGE_MT(kt + 1, (kt + 1) & 1);
        const LAS char* base = lds + (kt & 1) * 32768;
#pragma unroll
        for (int kk = 0; kk < 2; ++kk) {
            bf16x8 af[MT], bfr[4];
            const int co = (((kk * 4 + fq) ^ sw) * 16);
#pragma unroll
            for (int m = 0; m < MT; ++m) af[m] = *(const LAS bf16x8*)(base + aoff + m * 2048 + co);
#pragma unroll
            for (int n = 0; n < 4; ++n) bfr[n] = *(const LAS bf16x8*)(base + boff + n * 2048 + co);
            __builtin_amdgcn_s_setprio(1);
#pragma unroll
            for (int m = 0; m < MT; ++m)
#pragma unroll
                for (int n = 0; n < 4; ++n) acc[m][n] = __builtin_amdgcn_mfma_f32_16x16x32_bf16(bfr[n], af[m], acc[m][n], 0, 0, 0);
            __builtin_amdgcn_s_setprio(0);
        }
    }
#undef GSTAGE_MT
}

DEVI int vblock() { const int g = gridDim.x, b = obid(); return (g & 7) == 0 ? (b & 7) * (g >> 3) + (b >> 3) : b; }
DEVI void ph_inproj(const P& p, int l, float* sm) {
    char* ws = ows(p);
    const bf16_t* hb = (const bf16_t*)(ws + WS_HB);
    const bf16_t* wt = (const bf16_t*)(ws + WS_WINT) + (size_t)l * INW * D;
    bf16_t* proj = (bf16_t*)(ws + WS_PROJ);
    const float2* rope = (const float2*)(ws + WS_ROPE);
    const int tid = otid(), lane = tid & 63, wid = tid >> 6, wr = wid >> 1, wc = wid & 1, fr = lane & 15, fq = lane >> 4;
    constexpr int TN = INW / 128;
    for (int q = vblock(); q < (T / 128) * TN; q += gridDim.x) {
        int mi, ni;
        if (q < 3 * 1024) { const int nbk = q >> 10, w = q & 1023, t = w & 63; mi = (w >> 6) * 8 + (t >> 3); ni = nbk * 8 + (t & 7); }
        else { const int q2 = q - 3 * 1024; mi = q2 / 3; ni = 24 + q2 % 3; }
        f32x4 acc[4][4];
        gemm128_core((LAS char*)sm, hb + (size_t)mi * 128 * D, D, nullptr, 128, wt + (size_t)ni * 128 * D, D, D, acc);
        const int colw = ni * 128 + wc * 64;
#pragma unroll
        for (int m = 0; m < 4; ++m) {
            const int row = mi * 128 + wr * 64 + m * 16 + fr;
            if (colw < 768) {
                const float sc = colw >= 384 ? 0.125f : 1.f;
                const float2* rp = rope + (size_t)(row & (S - 1)) * 32 + fq * 4;
#pragma unroll
                for (int n = 0; n < 2; ++n)
#pragma unroll
                    for (int r = 0; r < 4; ++r) {
                        const float2 cs = rp[n * 16 + r];
                        const float x1 = acc[m][n][r], x2 = acc[m][n + 2][r];
                        acc[m][n][r] = (x1 * cs.x - x2 * cs.y) * sc;
                        acc[m][n + 2][r] = (x1 * cs.y + x2 * cs.x) * sc;
                    }
            }
            bf16_t* o = proj + (size_t)row * INW + colw + fq * 4;
#pragma unroll
            for (int n = 0; n < 4; ++n) { u32x2 w; w.x = pk2(acc[m][n][0], acc[m][n][1]); w.y = pk2(acc[m][n][2], acc[m][n][3]); *(u32x2*)(o + n * 16) = w; }
        }
    }
}

DEVI void ph_outproj(const P& p, int l, float* sm) {
    char* ws = ows(p);
    const bf16_t* yc = (const bf16_t*)(ws + WS_YCAT);
    const bf16_t* wt = (const bf16_t*)(ws + WS_WOUTT) + (size_t)l * D * D;
    bf16_t* mix = (bf16_t*)(ws + WS_MIX);
    const int tid = otid(), lane = tid & 63, wid = tid >> 6, wr = wid >> 1, wc = wid & 1, fr = lane & 15, fq = lane >> 4;
    for (int q = vblock(); q < (T / 128) * 8; q += gridDim.x) {
        const int mi = q >> 3, ni = q & 7;
        f32x4 acc[4][4];
        gemm128_core((LAS char*)sm, yc + (size_t)mi * 128 * D, D, nullptr, 128, wt + (size_t)ni * 128 * D, D, D, acc);
#pragma unroll
        for (int m = 0; m < 4; ++m) {
            bf16_t* o = mix + (size_t)(mi * 128 + wr * 64 + m * 16 + fr) * D + ni * 128 + wc * 64 + fq * 4;
#pragma unroll
            for (int n = 0; n < 4; ++n) { u32x2 w; w.x = pk2(acc[m][n][0], acc[m][n][1]); w.y = pk2(acc[m][n][2], acc[m][n][3]); *(u32x2*)(o + n * 16) = w; }
        }
    }
}

DEVI void ld8bf(const bf16_t* src, float* dst) {
    const u32x4 u = *(const u32x4*)src;
    dst[0] = bflo(u.x); dst[1] = bfhi(u.x); dst[2] = bflo(u.y); dst[3] = bfhi(u.y);
    dst[4] = bflo(u.z); dst[5] = bfhi(u.z); dst[6] = bflo(u.w); dst[7] = bfhi(u.w);
}
DEVI bf16x8 pack8(const float* v) {
    u32x4 u; u.x = pk2(v[0], v[1]); u.y = pk2(v[2], v[3]); u.z = pk2(v[4], v[5]); u.w = pk2(v[6], v[7]);
    return __builtin_bit_cast(bf16x8, u);
}
DEVI void ret_stage_rows(LAS char* img, const bf16_t* proj, size_t tok0, int col0, float logg, int mode, int tid) {
#pragma unroll
    for (int i = 0; i < 4; ++i) {
        const int idx = tid + i * 256, row = idx >> 3, ch = idx & 7;
        float v[8];
        ld8bf(proj + (tok0 + row) * INW + col0 + ch * 8, v);
        const float sc = fexp((mode == 0 ? (float)row : -(float)row) * logg);
#pragma unroll
        for (int j = 0; j < 8; ++j) v[j] *= sc;
        *(LAS bf16x8*)(img + row * 128 + ((ch ^ ((row >> 1) & 7)) * 16)) = pack8(v);
    }
}
DEVI void ret_stage_T(LAS char* img, const bf16_t* proj, size_t tok0, int col0, float logg, int mode, int tid) {
#pragma unroll
    for (int i = 0; i < 4; ++i) {
        const int idx = tid + i * 256, tok = idx >> 3, ch = idx & 7;
        float v[8];
        ld8bf(proj + (tok0 + tok) * INW + col0 + ch * 8, v);
        const float sc = mode == 2 ? fexp((float)(127 - tok) * logg) : 1.f;
        const int ck = (tok >> 5) * 4 + ((tok >> 2) & 3), jj = ((tok >> 4) & 1) * 4 + (tok & 3);
#pragma unroll
        for (int j = 0; j < 8; ++j) {
            const int e = ch * 8 + j;
            *(LAS bf16_t*)(img + e * 256 + ((ck ^ (e & 15)) * 16) + jj * 2) = (bf16_t)f2bf(v[j] * sc);
        }
    }
}
DEVI bf16x8 frag_row(const LAS char* img, int row, int kk, int fq) { return *(const LAS bf16x8*)(img + row * 128 + (((kk * 4 + fq) ^ ((row >> 1) & 7)) * 16)); }
DEVI bf16x8 frag_T(const LAS char* img, int e, int kp, int fq) { return *(const LAS bf16x8*)(img + e * 256 + (((kp * 4 + fq) ^ (e & 15)) * 16)); }

DEVI void ph_ret_kv(const P& p, float* sm, int b0) {
    char* ws = ows(p);
    const bf16_t* proj = (const bf16_t*)(ws + WS_PROJ);
    float* kv = (float*)(ws + WS_KV);
    LAS char* lds = (LAS char*)sm;
    const int tid = otid(), lane = tid & 63, wid = tid >> 6, fr = lane & 15, fq = lane >> 4;
    if (obid() < b0) return;
    for (int item = obid() - b0; item < NBATCH * 64 * 6; item += gridDim.x - b0) {
        const int h = item % 6, n = (item / 6) % 64, b = item / 384;
        const float logg = (float)LOGG[h];
        const size_t tok0 = (size_t)b * S + n * 128;
        __syncthreads();
        ret_stage_T(lds, proj, tok0, 768 + h * 64, logg, 0, tid);
        ret_stage_T(lds + 16384, proj, tok0, 384 + h * 64, logg, 2, tid);
        __syncthreads();
        f32x4 acc[4];
#pragma unroll
        for (int dt = 0; dt < 4; ++dt) acc[dt] = (f32x4){0.f, 0.f, 0.f, 0.f};
#pragma unroll
        for (int kk = 0; kk < 4; ++kk) {
            const bf16x8 av = frag_T(lds, wid * 16 + fr, kk, fq);
#pragma unroll
            for (int dt = 0; dt < 4; ++dt) acc[dt] = __builtin_amdgcn_mfma_f32_16x16x32_bf16(av, frag_T(lds + 16384, dt * 16 + fr, kk, fq), acc[dt], 0, 0, 0);
        }
        float* o = kv + (size_t)item * 4096;
#pragma unroll
        for (int dt = 0; dt < 4; ++dt)
#pragma unroll
            for (int r = 0; r < 4; ++r) o[(wid * 16 + fq * 4 + r) * 64 + dt * 16 + fr] = acc[dt][r];
    }
}

DEVI void ph_ret_scan(const P& p, int b0) {
    float* kv = (float*)(ows(p) + WS_KV);
    const int total = NBATCH * 6 * 4096;
    const int ob = obid() - b0;
    if (ob < 0) return;
    for (int idx = ob * NT + otid(); idx < total; idx += (gridDim.x - b0) * NT) {
        const int de = idx & 4095, bh = idx >> 12, h = bh % 6, b = bh / 6;
        const float g = expf(128.f * (float)LOGG[h]);
        float st = 0.f;
        float* base = kv + ((size_t)(b * 64) * 6 + h) * 4096 + de;
        for (int n0 = 0; n0 < 64; n0 += 16) {
            float x[16];
#pragma unroll
            for (int j = 0; j < 16; ++j) x[j] = base[(size_t)(n0 + j) * 6 * 4096];
#pragma unroll
            for (int j = 0; j < 16; ++j) { const float xv = x[j]; x[j] = st; st = st * g + xv; }
#pragma unroll
            for (int j = 0; j < 16; ++j) base[(size_t)(n0 + j) * 6 * 4096] = x[j];
        }
    }
}

DEVI void ph_ret_out(const P& p, float* sm, int b0) {
    char* ws = ows(p);
    const bf16_t* proj = (const bf16_t*)(ws + WS_PROJ);
    const float* kv = (const float*)(ws + WS_KV);
    bf16_t* ycat = (bf16_t*)(ws + WS_YCAT);
    LAS char* lds = (LAS char*)sm;
    const LAS char* qs = lds; const LAS char* ks = lds + 16384; const LAS char* vt = lds + 32768;
    const int tid = otid(), lane = tid & 63, wid = tid >> 6, fr = lane & 15, fq = lane >> 4;
    if (obid() < b0) return;
    constexpr int NLT = T / 64, NIT = NBATCH * 64 * 6;
    const int j = obid() - b0, nrest = (int)gridDim.x - b0 - NLT;
    const bool lt = nrest > 0 && j < NLT;
    const int R = NIT - NLT - 2 * nrest;
    const bool bal = nrest > 0 && R >= 0 && 2 * R <= NLT;
    const int nent = bal ? (lt ? (j < 2 * R ? 2 : 1) : 2) : 1 << 20;
    for (int en = 0; en < nent; ++en) {
        int item, qlo = 0, qhi = 2;
        if (bal) {
            if (lt) { item = en == 0 ? j : NLT + 2 * nrest + (j >> 1); if (en == 1) { qlo = j & 1; qhi = qlo + 1; } }
            else item = NLT + (j - NLT) + en * nrest;
        } else {
            item = j + en * (nrest > 0 ? (lt ? NIT : nrest) : (int)gridDim.x - b0);
            if (item >= NIT) break;
        }
        const int h = item % 6, n = (item / 6) % 64, b = item / 384;
        const float logg = (float)LOGG[h];
        const float gam = expf(logg);
        const size_t tok0 = (size_t)b * S + n * 128;
        __syncthreads();
        ret_stage_rows(lds, proj, tok0, h * 64, logg, 0, tid);
        ret_stage_rows(lds + 16384, proj, tok0, 384 + h * 64, logg, 1, tid);
        ret_stage_T(lds + 32768, proj, tok0, 768 + h * 64, logg, 0, tid);
        const float* prevT = kv + (size_t)item * 4096;
        bf16x8 pvf[4][2];
#pragma unroll
        for (int et = 0; et < 4; ++et)
#pragma unroll
            for (int kk = 0; kk < 2; ++kk) {
                const float* src = prevT + (et * 16 + fr) * 64 + kk * 32 + fq * 8;
                const f32x4 x0 = *(const f32x4*)src, x1 = *(const f32x4*)(src + 4);
                u32x4 u; u.x = pk2(x0[0], x0[1]); u.y = pk2(x0[2], x0[3]); u.z = pk2(x1[0], x1[1]); u.w = pk2(x1[2], x1[3]);
                pvf[et][kk] = __builtin_bit_cast(bf16x8, u);
            }
        __syncthreads();
#pragma unroll 2
        for (int qi = qlo; qi < qhi; ++qi) {
            const int qt = qi == 0 ? wid : 7 - wid;
            bf16x8 bq[2];
            bq[0] = frag_row(qs, qt * 16 + fr, 0, fq); bq[1] = frag_row(qs, qt * 16 + fr, 1, fq);
            const size_t tok = tok0 + qt * 16 + fr;
            const u32x2 gu0 = *(const u32x2*)(proj + tok * INW + 1152 + h * 64 + fq * 4), gu1 = *(const u32x2*)(proj + tok * INW + 1152 + h * 64 + 16 + fq * 4);
            const u32x2 gu2 = *(const u32x2*)(proj + tok * INW + 1152 + h * 64 + 32 + fq * 4), gu3 = *(const u32x2*)(proj + tok * INW + 1152 + h * 64 + 48 + fq * 4);
            f32x4 acc[4];
#pragma unroll
            for (int et = 0; et < 4; ++et) acc[et] = (f32x4){0.f, 0.f, 0.f, 0.f};
#pragma unroll
            for (int et = 0; et < 4; ++et)
#pragma unroll
                for (int kk = 0; kk < 2; ++kk) acc[et] = __builtin_amdgcn_mfma_f32_16x16x32_bf16(pvf[et][kk], bq[kk], acc[et], 0, 0, 0);
#pragma unroll
            for (int et = 0; et < 4; ++et) acc[et] = acc[et] * gam;
            for (int kp = 0; kp <= (qt >> 1); ++kp) {
                float pv[8];
#pragma unroll
                for (int a = 0; a < 2; ++a) {
                    const int kt = 2 * kp + a;
                    f32x4 sT = (f32x4){0.f, 0.f, 0.f, 0.f};
                    if (kt <= qt) {
                        sT = __builtin_amdgcn_mfma_f32_16x16x32_bf16(frag_row(ks, kt * 16 + fr, 0, fq), bq[0], sT, 0, 0, 0);
                        sT = __builtin_amdgcn_mfma_f32_16x16x32_bf16(frag_row(ks, kt * 16 + fr, 1, fq), bq[1], sT, 0, 0, 0);
                        if (kt == qt) {
#pragma unroll
                            for (int r = 0; r < 4; ++r) if (fq * 4 + r > fr) sT[r] = 0.f;
                        }
                    }
                    pv[a * 4 + 0] = sT[0]; pv[a * 4 + 1] = sT[1]; pv[a * 4 + 2] = sT[2]; pv[a * 4 + 3] = sT[3];
                }
                const bf16x8 pf = pack8(pv);
#pragma unroll
                for (int et = 0; et < 4; ++et)
                    acc[et] = __builtin_amdgcn_mfma_f32_16x16x32_bf16(frag_T(vt, et * 16 + fr, kp, fq), pf, acc[et], 0, 0, 0);
            }
            float sum = 0.f;
#pragma unroll
            for (int et = 0; et < 4; ++et) sum += (acc[et][0] + acc[et][1]) + (acc[et][2] + acc[et][3]);
            sum += __shfl_xor(sum, 16); sum += __shfl_xor(sum, 32);
            const float mean = sum * (1.f / 64.f);
            float var = 0.f;
#pragma unroll
            for (int et = 0; et < 4; ++et) { acc[et] = acc[et] - mean; var += (acc[et][0] * acc[et][0] + acc[et][1] * acc[et][1]) + (acc[et][2] * acc[et][2] + acc[et][3] * acc[et][3]); }
            var += __shfl_xor(var, 16); var += __shfl_xor(var, 32);
            const float rstd = 1.f / sqrtf(var * (1.f / 64.f) + LN_EPS);
#pragma unroll
            for (int et = 0; et < 4; ++et) {
                const u32x2 gu = et == 0 ? gu0 : (et == 1 ? gu1 : (et == 2 ? gu2 : gu3));
                const float g0 = bflo(gu.x), g1 = bfhi(gu.x), g2 = bflo(gu.y), g3 = bfhi(gu.y);
                u32x2 w;
                w.x = pk2(acc[et][0] * rstd * siluf_(g0), acc[et][1] * rstd * siluf_(g1));
                w.y = pk2(acc[et][2] * rstd * siluf_(g2), acc[et][3] * rstd * siluf_(g3));
                *(u32x2*)(ycat + tok * D + h * 64 + et * 16 + fq * 4) = w;
            }
        }
    }
}

constexpr int RC = 128, NCH = S / RC;

DEVI float zmix(const bf16_t* pc, int s, int col, const float* mu) {
    const float c = bf2f(pc[col]);
    const float pv = s > 0 ? bf2f(pc[col - INW]) : 0.f;
    return c + (pv - c) * mu[col];
}
DEVI void zmix8(const bf16_t* pc, int s, int col, const float* mu, float* z) {
    float c[8], pv[8];
    ld8bf(pc + col, c);
    if (s > 0) ld8bf(pc + col - INW, pv);
    else {
#pragma unroll
        for (int j = 0; j < 8; ++j) pv[j] = 0.f;
    }
    const float4 m0 = *(const float4*)(mu + col), m1 = *(const float4*)(mu + col + 4);
    const float m[8] = {m0.x, m0.y, m0.z, m0.w, m1.x, m1.y, m1.z, m1.w};
#pragma unroll
    for (int j = 0; j < 8; ++j) z[j] = c[j] + (pv[j] - c[j]) * m[j];
}
DEVI float quad_sum(float x) { x += dpp_mov<0xB1>(x); x += dpp_mov<0x4E>(x); return x; }

DEVI void mma64(f32x4 (&acc)[4], const float* A, int ap, const float* B, int wid, int lr, int lq) {
#pragma unroll
    for (int kb = 0; kb < 2; ++kb) {
        const bf16x8 av = pack8(A + (16 * wid + lr) * ap + 32 * kb + 8 * lq);
        const float* b = B + (32 * kb + 8 * lq) * 64 + lr;
#pragma unroll
        for (int n = 0; n < 4; ++n) {
            float vb[8];
#pragma unroll
            for (int j = 0; j < 8; ++j) vb[j] = b[j * 64 + 16 * n];
            acc[n] = __builtin_amdgcn_mfma_f32_16x16x32_bf16(av, pack8(vb), acc[n], 0, 0, 0);
        }
    }
}
DEVI void mma64_store(float* Ct, const f32x4 (&acc)[4], int wid, int lr, int lq) {
#pragma unroll
    for (int n = 0; n < 4; ++n)
#pragma unroll
        for (int r = 0; r < 4; ++r) Ct[(16 * wid + 4 * lq + r) * 68 + 16 * n + lr] = acc[n][r];
}
DEVI void ph_rwkv_prep(const P& p, int l, float* sm) {
    char* ws = ows(p);
    const bf16_t* proj = (const bf16_t*)(ws + WS_PROJ);
    float* rw = (float*)(ws + WS_RW);
    float* rs = (float*)(ws + WS_RS);
    const size_t A1 = (size_t)T * RW;
    const float* mu = pin(p, I_MU) + l * RWSLAB;
    const float* w0 = pin(p, I_W0) + l * RW; const float* w2 = pin(p, I_W2) + (size_t)l * 64 * RW;
    const float* a0 = pin(p, I_A0) + l * RW; const float* a2 = pin(p, I_A2) + (size_t)l * 64 * RW;
    const float* k_k = pin(p, I_KK) + l * RW; const float* k_a = pin(p, I_KA) + l * RW; const float* r_k = pin(p, I_RK) + l * RW;
    const int tid = otid(), tau = tid >> 2, cq = tid & 3, lane = tid & 63, wid = tid >> 6, lr = lane & 15, lq = lane >> 4;
    float* zx0 = sm;
    float* wx0 = sm + 4352;
    float* zx1 = sm + 8448;
    float* wx1 = sm + 12800;
    const int sj8 = (tid & 7) * 8, stt = tid >> 3, swj = tid >> 4, swc = (tid & 15) * 4;
    u32x4 zc[2][2], zp[2][2]; f32x4 wv[4][2];
#define PREP_PF(IT) do { const int _h = (IT) % 6, _tile = (IT) / 6; \
        _Pragma("unroll") for (int e = 0; e < 2; ++e) { const int _t2 = _tile * 64 + stt + 32 * e; \
            const bf16_t* _pc = proj + (size_t)_t2 * INW + C_RWKV + 1152 + sj8; \
            _Pragma("unroll") for (int hf = 0; hf < 2; ++hf) { zc[e][hf] = *(const u32x4*)(_pc + 64 * hf); \
                zp[e][hf] = (u32x4){0u, 0u, 0u, 0u}; if ((_t2 & (S - 1)) > 0) zp[e][hf] = *(const u32x4*)(_pc + 64 * hf - INW); } } \
        _Pragma("unroll") for (int k = 0; k < 4; ++k) { \
            wv[k][0] = *(const f32x4*)(w2 + (size_t)(swj + 16 * k) * RW + _h * 64 + swc); wv[k][1] = *(const f32x4*)(a2 + (size_t)(swj + 16 * k) * RW + _h * 64 + swc); } } while (0)
#define PREP_MIX(DST, C, PV, M0, M1, F) do { float* _d = (DST); float _c, _p; \
        _c = bflo((C).x); _p = bflo((PV).x); _d[0] = F(_c + (_p - _c) * (M0)[0]); _c = bfhi((C).x); _p = bfhi((PV).x); _d[1] = F(_c + (_p - _c) * (M0)[1]); \
        _c = bflo((C).y); _p = bflo((PV).y); _d[2] = F(_c + (_p - _c) * (M0)[2]); _c = bfhi((C).y); _p = bfhi((PV).y); _d[3] = F(_c + (_p - _c) * (M0)[3]); \
        _c = bflo((C).z); _p = bflo((PV).z); _d[4] = F(_c + (_p - _c) * (M1)[0]); _c = bfhi((C).z); _p = bfhi((PV).z); _d[5] = F(_c + (_p - _c) * (M1)[1]); \
        _c = bflo((C).w); _p = bflo((PV).w); _d[6] = F(_c + (_p - _c) * (M1)[2]); _c = bfhi((C).w); _p = bfhi((PV).w); _d[7] = F(_c + (_p - _c) * (M1)[3]); } while (0)
#define PREP_ID(x) (x)
    if (obid() < (T / 64) * 6) PREP_PF(obid());
    for (int item = obid(); item < (T / 64) * 6; item += gridDim.x) {
        const int h = item % 6, tile = item / 6;
        const int t = tile * 64 + tau, s = t & (S - 1);
        const int hc = h * 64 + cq * 16;
        float u[16], av[16];
        __syncthreads();
        {
            const f32x4 m0a = *(const f32x4*)(mu + 1152 + sj8), m0b = *(const f32x4*)(mu + 1152 + sj8 + 4);
            const f32x4 m1a = *(const f32x4*)(mu + 1216 + sj8), m1b = *(const f32x4*)(mu + 1216 + sj8 + 4);
#pragma unroll
            for (int e = 0; e < 2; ++e) {
                PREP_MIX(zx0 + (stt + 32 * e) * 68 + sj8, zc[e][0], zp[e][0], m0a, m0b, ftanh);
                PREP_MIX(zx1 + (stt + 32 * e) * 68 + sj8, zc[e][1], zp[e][1], m1a, m1b, PREP_ID);
            }
        }
#pragma unroll
        for (int k = 0; k < 4; ++k) { *(f32x4*)(wx0 + (swj + 16 * k) * 64 + swc) = wv[k][0]; *(f32x4*)(wx1 + (swj + 16 * k) * 64 + swc) = wv[k][1]; }
        if (item + (int)gridDim.x < (T / 64) * 6) PREP_PF(item + gridDim.x);
        const bf16_t* pc = proj + (size_t)t * INW + C_RWKV;
        float kr[16], rr[16];
        zmix8(pc, s, 384 + hc, mu, kr); zmix8(pc, s, 384 + hc + 8, mu, kr + 8);
        zmix8(pc, s, hc, mu, rr); zmix8(pc, s, hc + 8, mu, rr + 8);
        __syncthreads();
        {
            f32x4 ra0[4], ra1[4];
#pragma unroll
            for (int n = 0; n < 4; ++n) { ra0[n] = (f32x4){0.f, 0.f, 0.f, 0.f}; ra1[n] = ra0[n]; }
            mma64(ra0, zx0, 68, wx0, wid, lr, lq);
            mma64(ra1, zx1, 68, wx1, wid, lr, lq);
            __syncthreads();
            mma64_store(zx0, ra0, wid, lr, lq);
            mma64_store(zx1, ra1, wid, lr, lq);
        }
        __syncthreads();
#pragma unroll
        for (int c4 = 0; c4 < 4; ++c4) {
            const float4 a = *(const float4*)(zx0 + tau * 68 + cq * 16 + c4 * 4), b2 = *(const float4*)(zx1 + tau * 68 + cq * 16 + c4 * 4);
            u[c4 * 4] = a.x; u[c4 * 4 + 1] = a.y; u[c4 * 4 + 2] = a.z; u[c4 * 4 + 3] = a.w;
            av[c4 * 4] = b2.x; av[c4 * 4 + 1] = b2.y; av[c4 * 4 + 2] = b2.z; av[c4 * 4 + 3] = b2.w;
        }
        float kk[16], n2 = 0.f, rsum = 0.f;
        float dec[16], nb[16], km[16];
#pragma unroll
        for (int cc = 0; cc < 16; ++cc) {
            const int c = hc + cc;
            const float wl = -softplusf_(-(u[cc] + w0[c])) - 0.5f;
            dec[cc] = fexp(-fexp(wl));
            const float a = sigmoidf_(av[cc] + a0[c]);
            kk[cc] = kr[cc] * k_k[c];
            n2 += kk[cc] * kk[cc];
            km[cc] = kr[cc] * (1.f + (a - 1.f) * k_a[c]);
            rsum += rr[cc] * km[cc] * r_k[c];
            av[cc] = a;
        }
        n2 = quad_sum(n2); rsum = quad_sum(rsum);
        const float inv = 1.f / fmaxf(sqrtf(n2), 1e-12f);
#pragma unroll
        for (int cc = 0; cc < 16; ++cc) { kk[cc] *= inv; nb[cc] = -kk[cc] * av[cc]; }
        const size_t o = (size_t)t * RW + hc;
        bf16_t* rwb = (bf16_t*)(rw + A1);
#pragma unroll
        for (int c4 = 0; c4 < 4; ++c4)
            *(float4*)(rw + o + c4 * 4) = make_float4(dec[c4 * 4], dec[c4 * 4 + 1], dec[c4 * 4 + 2], dec[c4 * 4 + 3]);
        *(bf16x8*)(rwb + 0 * A1 + o) = pack8(kk); *(bf16x8*)(rwb + 0 * A1 + o + 8) = pack8(kk + 8);
        *(bf16x8*)(rwb + 1 * A1 + o) = pack8(nb); *(bf16x8*)(rwb + 1 * A1 + o + 8) = pack8(nb + 8);
        *(bf16x8*)(rwb + 2 * A1 + o) = pack8(km); *(bf16x8*)(rwb + 2 * A1 + o + 8) = pack8(km + 8);
        if (cq == 0) rs[(size_t)t * 6 + h] = rsum;
    }
#undef PREP_PF
#undef PREP_MIX
#undef PREP_ID
}

struct RwOps { float4 kk, w, nb, k, r; float v0, v1, v2, v3; };
DEVI void rw_load(RwOps& o, const float* sm, const float* smV, int tt, int kq, int rl) {
    o.kk = *(const float4*)(sm + 0 * 2048 + tt * 64 + kq * 4);
    o.w = *(const float4*)(sm + 1 * 2048 + tt * 64 + kq * 4);
    o.nb = *(const float4*)(sm + 2 * 2048 + tt * 64 + kq * 4);
    o.k = *(const float4*)(sm + 3 * 2048 + tt * 64 + kq * 4);
    o.r = *(const float4*)(sm + 4 * 2048 + tt * 64 + kq * 4);
    o.v0 = smV[tt * 64 + rl]; o.v1 = smV[tt * 64 + 16 + rl]; o.v2 = smV[tt * 64 + 32 + rl]; o.v3 = smV[tt * 64 + 48 + rl];
}
DEVI float dot4(const float4& a, const float4& b) { return (a.x * b.x + a.y * b.y) + (a.z * b.z + a.w * b.w); }
DEVI void upd4(float4& s, const RwOps& o, float d, float vv) {
    s.x = s.x * o.w.x + d * o.nb.x + vv * o.k.x; s.y = s.y * o.w.y + d * o.nb.y + vv * o.k.y;
    s.z = s.z * o.w.z + d * o.nb.z + vv * o.k.z; s.w = s.w * o.w.w + d * o.nb.w + vv * o.k.w;
}
#define RED16x4(a, b, c, d) do { \
    a += dpp_mov<0xB1>(a); b += dpp_mov<0xB1>(b); c += dpp_mov<0xB1>(c); d += dpp_mov<0xB1>(d); \
    a += dpp_mov<0x4E>(a); b += dpp_mov<0x4E>(b); c += dpp_mov<0x4E>(c); d += dpp_mov<0x4E>(d); \
    a += dpp_mov<0x141>(a); b += dpp_mov<0x141>(b); c += dpp_mov<0x141>(c); d += dpp_mov<0x141>(d); \
    a += dpp_mov<0x140>(a); b += dpp_mov<0x140>(b); c += dpp_mov<0x140>(c); d += dpp_mov<0x140>(d); } while (0)
DEVI void rw_step4(float4 (&st)[4], const RwOps& o, float& y0, float& y1, float& y2, float& y3) {
    float d0 = dot4(st[0], o.kk), d1 = dot4(st[1], o.kk), d2 = dot4(st[2], o.kk), d3 = dot4(st[3], o.kk);
    RED16x4(d0, d1, d2, d3);
    upd4(st[0], o, d0, o.v0); upd4(st[1], o, d1, o.v1); upd4(st[2], o, d2, o.v2); upd4(st[3], o, d3, o.v3);
    y0 = dot4(st[0], o.r); y1 = dot4(st[1], o.r); y2 = dot4(st[2], o.r); y3 = dot4(st[3], o.r);
    RED16x4(y0, y1, y2, y3);
}
DEVI void ph_rwkv_chunk(const P& p, int l, float* sm) {
    char* ws = ows(p);
    const bf16_t* proj = (const bf16_t*)(ws + WS_PROJ);
    const float* rw = (const float*)(ws + WS_RW);
    const size_t A1 = (size_t)T * RW;
    bf16_t* pt = (bf16_t*)(ws + WS_PT);
    bf16_t* yt = (bf16_t*)(ws + WS_RWY);
    float* pq = (float*)(ws + WS_PQ);
    const float* mu = pin(p, I_MU) + l * RWSLAB;
    const int tid = otid(), lane = tid & 63, wv = tid >> 6;
    const int rl = wv * 4 + (lane >> 4), kq = lane & 15;
    float* smV = sm + 5 * 2048;
    float* smY = smV + 2048;
    for (int item = obid(); item < 12 * NCH * 2; item += gridDim.x) {
        const int half = item & 1, c = (item >> 1) % NCH, bh = item / (2 * NCH), b = bh / 6, h = bh % 6;
        float4 st[4];
#pragma unroll
        for (int j = 0; j < 4; ++j) {
            const int row = j * 16 + rl;
            st[j].x = (half == 0 && kq * 4 + 0 == row) ? 1.f : 0.f;
            st[j].y = (half == 0 && kq * 4 + 1 == row) ? 1.f : 0.f;
            st[j].z = (half == 0 && kq * 4 + 2 == row) ? 1.f : 0.f;
            st[j].w = (half == 0 && kq * 4 + 3 == row) ? 1.f : 0.f;
        }
        for (int t0 = c * RC; t0 < (c + 1) * RC; t0 += 32) {
            __syncthreads();
            for (int i = tid; i < 512; i += NT) {
                const int tt = i >> 4, k4 = (i & 15) * 4;
                *(float4*)(sm + 1 * 2048 + tt * 64 + k4) = *(const float4*)(rw + ((size_t)b * S + t0 + tt) * RW + h * 64 + k4);
            }
            {
                const int tt = tid >> 3, k8 = (tid & 7) * 8;
                const bf16_t* rwb = (const bf16_t*)(rw + A1) + ((size_t)b * S + t0 + tt) * RW + h * 64 + k8;
                ld8bf(rwb + 0 * A1, sm + 0 * 2048 + tt * 64 + k8);
                ld8bf(rwb + 1 * A1, sm + 2 * 2048 + tt * 64 + k8);
                ld8bf(rwb + 2 * A1, sm + 3 * 2048 + tt * 64 + k8);
            }
            {
                const int tt = tid >> 3, k8 = (tid & 7) * 8;
                const bf16_t* pc = proj + ((size_t)b * S + t0 + tt) * INW + C_RWKV;
                float z[8];
                zmix8(pc, t0 + tt, h * 64 + k8, mu, z);
#pragma unroll
                for (int j = 0; j < 8; ++j) sm[4 * 2048 + tt * 64 + k8 + j] = z[j];
                if (half) zmix8(pc, t0 + tt, 768 + h * 64 + k8, mu, z);
#pragma unroll
                for (int j = 0; j < 8; ++j) smV[tt * 64 + k8 + j] = half ? z[j] : 0.f;
            }
            __syncthreads();
            RwOps cur, nxt;
            rw_load(cur, sm, smV, 0, kq, rl);
#pragma unroll 2
            for (int tt = 0; tt < 32; ++tt) {
                rw_load(nxt, sm, smV, (tt + 1) & 31, kq, rl);
                float y0, y1, y2, y3;
                rw_step4(st, cur, y0, y1, y2, y3);
                if (kq < 4) smY[tt * 64 + kq * 16 + rl] = kq == 0 ? y0 : (kq == 1 ? y1 : (kq == 2 ? y2 : y3));
                cur = nxt;
            }
            __syncthreads();
            {
                bf16_t* dst = half ? yt : pt;
                const int tt = tid >> 3, k8 = (tid & 7) * 8;
                *(bf16x8*)(dst + ((size_t)b * S + t0 + tt) * RW + h * 64 + k8) = pack8(smY + tt * 64 + k8);
            }
        }
#pragma unroll
        for (int j = 0; j < 4; ++j)
            *(float4*)(pq + ((size_t)((bh * NCH + c) * 2 + half)) * 4096 + (j * 16 + rl) * 64 + kq * 4) = st[j];
    }
}

DEVI f32x4 mma_tile(f32x4 acc, const float* A, int a_rs, int a_cs, const float* B, int b_rs, int b_cs, int K, int lr, int lq) {
#pragma unroll 4
    for (int ks = 0; ks < K; ks += 4) {
        const float a = A[lr * a_rs + (ks + lq) * a_cs];
        const float b = B[(ks + lq) * b_rs + lr * b_cs];
        acc = __builtin_amdgcn_mfma_f32_16x16x4f32(a, b, acc, 0, 0, 0);
    }
    return acc;
}
constexpr int WB = 16;
DEVI void ph_rwkv_chunk_wy(const P& p, int l, float* sm) {
    char* ws = ows(p);
    const bf16_t* proj = (const bf16_t*)(ws + WS_PROJ);
    const float* rw = (const float*)(ws + WS_RW);
    const size_t A1 = (size_t)T * RW;
    bf16_t* pt = (bf16_t*)(ws + WS_PT);
    bf16_t* yt = (bf16_t*)(ws + WS_RWY);
    float* pq = (float*)(ws + WS_PQ);
    const float* mu = pin(p, I_MU) + l * RWSLAB;
    const int tid = otid(), lane = tid & 63, wid = tid >> 6, lr = lane & 15, lq = lane >> 4;
    float* rKK = sm;
    float* rW = sm + 1024; float* rNB = sm + 2048; float* rK = sm + 3072; float* rR = sm + 4096;
    float* xt = sm + 5120;
    float* At = sm + 6144;
    float* Bt = At + 1088; float* Kt = At + 2176; float* Rt = At + 3264;
    float* SmP = sm + 10496;
    float* WL = sm + 14848;
    float* SmQ = sm + 14912;
    float* muS = sm + 19264;
    float* EbP = sm;
    float* Lab = sm + 1088; float* Lak = Lab + 272; float* Lrb = Lak + 272; float* Lrk = Lrb + 272;
    float* Tm = Lrk + 272;
    float* EbQ = sm + 2448;
    for (int item = obid(); item < 12 * NCH; item += gridDim.x) {
        const int c = item % NCH, bh = item / NCH, b = bh / 6, h = bh % 6;
        __syncthreads();
        for (int i = tid; i < 64 * 64; i += NT) { const int r = i >> 6, k = i & 63; SmP[r * 68 + k] = (r == k) ? 1.f : 0.f; SmQ[r * 68 + k] = 0.f; }
        const int stt = tid >> 3, sk8 = (tid & 7) * 8;
        if (tid < 128) muS[tid] = mu[(tid < 64 ? 0 : 768 - 64) + h * 64 + tid];
        f32x4 pfW; u32x4 pfKK, pfNB, pfK, pfRc, pfRp, pfXc, pfXp;
#define WY_LOAD(T0) do { \
            pfW = *(const f32x4*)(rw + ((size_t)b * S + (T0) + (tid >> 4)) * RW + h * 64 + (tid & 15) * 4); \
            pfRp = (u32x4){0u, 0u, 0u, 0u}; pfXp = pfRp; \
            if (tid < WB * 8) { \
                const bf16_t* rwb = (const bf16_t*)(rw + A1) + ((size_t)b * S + (T0) + stt) * RW + h * 64 + sk8; \
                pfKK = *(const u32x4*)(rwb); pfNB = *(const u32x4*)(rwb + A1); pfK = *(const u32x4*)(rwb + 2 * A1); \
                const bf16_t* pc = proj + ((size_t)b * S + (T0) + stt) * INW + C_RWKV + h * 64 + sk8; \
                pfRc = *(const u32x4*)(pc); pfXc = *(const u32x4*)(pc + 768); \
                if ((T0) + stt > 0) { pfRp = *(const u32x4*)(pc - INW); pfXp = *(const u32x4*)(pc + 768 - INW); } } } while (0)
#define WY_ST8(DST, U) do { float* _d = (DST); _d[0] = bflo((U).x); _d[1] = bfhi((U).x); _d[2] = bflo((U).y); _d[3] = bfhi((U).y); \
            _d[4] = bflo((U).z); _d[5] = bfhi((U).z); _d[6] = bflo((U).w); _d[7] = bfhi((U).w); } while (0)
#define WY_MIX8(DST, C, PV, M0, M1) do { float* _d = (DST); float _c, _p; \
            _c = bflo((C).x); _p = bflo((PV).x); _d[0] = _c + (_p - _c) * (M0)[0]; _c = bfhi((C).x); _p = bfhi((PV).x); _d[1] = _c + (_p - _c) * (M0)[1]; \
            _c = bflo((C).y); _p = bflo((PV).y); _d[2] = _c + (_p - _c) * (M0)[2]; _c = bfhi((C).y); _p = bfhi((PV).y); _d[3] = _c + (_p - _c) * (M0)[3]; \
            _c = bflo((C).z); _p = bflo((PV).z); _d[4] = _c + (_p - _c) * (M1)[0]; _c = bfhi((C).z); _p = bfhi((PV).z); _d[5] = _c + (_p - _c) * (M1)[1]; \
            _c = bflo((C).w); _p = bflo((PV).w); _d[6] = _c + (_p - _c) * (M1)[2]; _c = bfhi((C).w); _p = bfhi((PV).w); _d[7] = _c + (_p - _c) * (M1)[3]; } while (0)
        WY_LOAD(c * RC);
        for (int t0 = c * RC; t0 < (c + 1) * RC; t0 += WB) {
            __syncthreads();
            *(f32x4*)(rW + (tid >> 4) * 64 + (tid & 15) * 4) = pfW;
            if (tid < WB * 8) {
                WY_ST8(rKK + stt * 64 + sk8, pfKK); WY_ST8(rNB + stt * 64 + sk8, pfNB); WY_ST8(rK + stt * 64 + sk8, pfK);
                const f32x4 mr0 = *(const f32x4*)(muS + sk8), mr1 = *(const f32x4*)(muS + sk8 + 4), mx0 = *(const f32x4*)(muS + 64 + sk8), mx1 = *(const f32x4*)(muS + 64 + sk8 + 4);
                WY_MIX8(rR + stt * 64 + sk8, pfRc, pfRp, mr0, mr1);
                WY_MIX8(xt + stt * 64 + sk8, pfXc, pfXp, mx0, mx1);
            }
            if (t0 + WB < (c + 1) * RC) WY_LOAD(t0 + WB);
            __syncthreads();
            {
                const int k = tid & 63, q = tid >> 6;
                float wv[16];
#pragma unroll
                for (int t = 0; t < 16; ++t) wv[t] = rW[t * 64 + k];
                float Wp = 1.f;
#pragma unroll
                for (int t = 0; t < 12; ++t) Wp *= (t < 4 * q) ? wv[t] : 1.f;
#pragma unroll
                for (int j = 0; j < 4; ++j) {
                    const int t = 4 * q + j;
                    const float w_t = q == 0 ? wv[j] : (q == 1 ? wv[4 + j] : (q == 2 ? wv[8 + j] : wv[12 + j]));
                    const float Wt = Wp * w_t, inv = frcp(Wt);
                    At[t * 68 + k] = Wp * rKK[t * 64 + k];
                    Bt[t * 68 + k] = rNB[t * 64 + k] * inv;
                    Kt[t * 68 + k] = rK[t * 64 + k] * inv;
                    Rt[t * 68 + k] = Wt * rR[t * 64 + k];
                    Wp = Wt;
                }
                if (q == 3) WL[k] = Wp;
            }
            __syncthreads();
            f32x4 eP = (f32x4){0.f, 0.f, 0.f, 0.f}, yP = eP, eQ = eP, yQ = eP;
            {
                const float* ga = (wid < 2) ? At : Rt;
                const float* gb = (wid & 1) ? Kt : Bt;
                f32x4 g = (f32x4){0.f, 0.f, 0.f, 0.f};
                const float* sbP = SmP + 16 * wid * 68;
                const float* sbQ = SmQ + 16 * wid * 68;
#pragma unroll
                for (int kb = 0; kb < 2; ++kb) {
                    const int ko = lr * 68 + 32 * kb + 8 * lq;
                    const bf16x8 vag = pack8(ga + ko), vbg = pack8(gb + ko), va1 = pack8(At + ko), va2 = pack8(Rt + ko), vsP = pack8(sbP + ko), vsQ = pack8(sbQ + ko);
                    g = __builtin_amdgcn_mfma_f32_16x16x32_bf16(vag, vbg, g, 0, 0, 0);
                    eP = __builtin_amdgcn_mfma_f32_16x16x32_bf16(va1, vsP, eP, 0, 0, 0);
                    yP = __builtin_amdgcn_mfma_f32_16x16x32_bf16(va2, vsP, yP, 0, 0, 0);
                    eQ = __builtin_amdgcn_mfma_f32_16x16x32_bf16(va1, vsQ, eQ, 0, 0, 0);
                    yQ = __builtin_amdgcn_mfma_f32_16x16x32_bf16(va2, vsQ, yQ, 0, 0, 0);
                }
                float* gd = wid == 0 ? Lab : (wid == 1 ? Lak : (wid == 2 ? Lrb : Lrk));
#pragma unroll
                for (int r = 0; r < 4; ++r) {
                    const int t = 4 * lq + r;
                    const bool keep = wid < 2 ? (lr < t) : (lr <= t);
                    gd[t * 17 + lr] = keep ? g[r] : 0.f;
                }
            }
            __syncthreads();
            eQ = mma_tile(eQ, Lak, 17, 1, xt + 16 * wid, 64, 1, 16, lr, lq);
            yQ = mma_tile(yQ, Lrk, 17, 1, xt + 16 * wid, 64, 1, 16, lr, lq);
#pragma unroll
            for (int r = 0; r < 4; ++r) { EbP[(4 * lq + r) * 68 + 16 * wid + lr] = eP[r]; EbQ[(4 * lq + r) * 68 + 16 * wid + lr] = eQ[r]; }
            if (tid < 16) {
                float tc[16];
#pragma unroll
                for (int t = 0; t < 16; ++t) tc[t] = (t == tid) ? 1.f : 0.f;
#pragma unroll
                for (int j = 0; j < 15; ++j) {
                    const float tj = tc[j];
#pragma unroll
                    for (int t = j + 1; t < 16; ++t) tc[t] += Lab[t * 17 + j] * tj;
                }
#pragma unroll
                for (int t = 0; t < 16; ++t) Tm[t * 17 + tid] = tc[t];
            }
            __syncthreads();
            {
                const f32x4 z4 = (f32x4){0.f, 0.f, 0.f, 0.f};
                const f32x4 dP = mma_tile(z4, Tm, 17, 1, EbP + 16 * wid, 68, 1, 16, lr, lq);
                const f32x4 dQ = mma_tile(z4, Tm, 17, 1, EbQ + 16 * wid, 68, 1, 16, lr, lq);
#pragma unroll
                for (int r = 0; r < 4; ++r) { EbP[(4 * lq + r) * 68 + 16 * wid + lr] = dP[r]; EbQ[(4 * lq + r) * 68 + 16 * wid + lr] = dQ[r]; }
                yP = mma_tile(yP, Lrb, 17, 1, EbP + 16 * wid, 68, 1, 16, lr, lq);
                yQ = mma_tile(yQ, Lrb, 17, 1, EbQ + 16 * wid, 68, 1, 16, lr, lq);
                const size_t o = ((size_t)b * S + t0) * RW + h * 64 + 16 * wid + lr;
#pragma unroll
                for (int r = 0; r < 4; ++r) { pt[o + (size_t)(4 * lq + r) * RW] = (bf16_t)f2bf(yP[r]); yt[o + (size_t)(4 * lq + r) * RW] = (bf16_t)f2bf(yQ[r]); }
            }
            __syncthreads();
            {
                f32x4 sP[4], sQ[4];
#pragma unroll
                for (int n = 0; n < 4; ++n)
#pragma unroll
                    for (int r = 0; r < 4; ++r) { sP[n][r] = SmP[(16 * wid + 4 * lq + r) * 68 + 16 * n + lr]; sQ[n][r] = SmQ[(16 * wid + 4 * lq + r) * 68 + 16 * n + lr]; }
                {
                    const int ts = 8 * (lq & 1);
                    float va[8], vp[8];
#pragma unroll
                    for (int j = 0; j < 8; ++j) {
                        va[j] = lq < 2 ? EbQ[(ts + j) * 68 + 16 * wid + lr] : xt[(ts + j) * 64 + 16 * wid + lr];
                        vp[j] = lq < 2 ? EbP[(ts + j) * 68 + 16 * wid + lr] : 0.f;
                    }
                    const bf16x8 aQ = pack8(va), aP = pack8(vp);
                    const float* bsrc = lq < 2 ? Bt : Kt;
#pragma unroll
                    for (int n = 0; n < 4; ++n) {
                        float vb[8];
#pragma unroll
                        for (int j = 0; j < 8; ++j) vb[j] = bsrc[(ts + j) * 68 + 16 * n + lr];
                        const bf16x8 bb = pack8(vb);
                        sP[n] = __builtin_amdgcn_mfma_f32_16x16x32_bf16(aP, bb, sP[n], 0, 0, 0);
                        sQ[n] = __builtin_amdgcn_mfma_f32_16x16x32_bf16(aQ, bb, sQ[n], 0, 0, 0);
                    }
                }
#pragma unroll
                for (int n = 0; n < 4; ++n) {
                    const float wl = WL[16 * n + lr];
#pragma unroll
                    for (int r = 0; r < 4; ++r) { SmP[(16 * wid + 4 * lq + r) * 68 + 16 * n + lr] = sP[n][r] * wl; SmQ[(16 * wid + 4 * lq + r) * 68 + 16 * n + lr] = sQ[n][r] * wl; }
                }
            }
        }
        __syncthreads();
        float* o = pq + ((size_t)((bh * NCH + c) * 2)) * 4096;
        for (int i = tid; i < 64 * 64; i += NT) { ((bf16_t*)o)[i] = (bf16_t)f2bf(SmP[(i & 63) * 68 + (i >> 6)]); o[4096 + i] = SmQ[(i & 63) * 68 + (i >> 6)]; }
    }
#undef WY_LOAD
#undef WY_ST8
#undef WY_MIX8
}

DEVI void ph_rwkv_seq(const P& p, float* sm) {
    char* ws = ows(p);
    const float* pq = (const float*)(ws + WS_PQ);
    float* s0buf = (float*)(ws + WS_S0);
    const int tid = otid(), lane = tid & 63, wid = tid >> 6, lr = lane & 15, lq = lane >> 4;
    bf16_t* psm = (bf16_t*)sm;
    bf16_t* ssm = psm + 3 * 64 * 72;
    if (obid() >= 48) return;
    const int bh = obid() >> 2, vg = obid() & 3;
    f32x4 st = (f32x4){0.f, 0.f, 0.f, 0.f};
    const float* pbase = pq + (size_t)(bh * NCH) * 2 * 4096;
    const size_t qoff = 4096 + (size_t)(16 * wid + lr) * 64 + vg * 16 + 4 * lq;
#define PRB(f) ((((f) >> 3) * 72) + (((f) & 7) * 8))
#define SEQ_LOAD(X, C) do { const int _c = (C) < NCH ? (C) : NCH - 1; const float* _P = pbase + (size_t)_c * 8192; \
        X##0 = *(const u32x4*)((const bf16_t*)_P + (tid + 0 * 256) * 8); X##1 = *(const u32x4*)((const bf16_t*)_P + (tid + 1 * 256) * 8); \
        X##q = *(const f32x4*)(_P + qoff); } while (0)
#define SEQ_STEP(C, X) do { \
        float* s0t = s0buf + (size_t)(bh * NCH + (C)) * 4096; \
        bf16_t* sc = ssm + ((C) & 1) * 1152; \
        _Pragma("unroll") for (int r = 0; r < 4; ++r) { s0t[(16 * wid + lr) * 64 + vg * 16 + 4 * lq + r] = st[r]; sc[(4 * lq + r) * 72 + 16 * wid + lr] = (bf16_t)f2bf(st[r]); } \
        __syncthreads(); \
        const bf16_t* pc = psm + ((C) % 3) * 4608; \
        const bf16x8 a0 = *(const bf16x8*)(sc + lr * 72 + 8 * lq), a1 = *(const bf16x8*)(sc + lr * 72 + 32 + 8 * lq); \
        const bf16x8 b0 = *(const bf16x8*)(pc + (16 * wid + lr) * 72 + 8 * lq), b1 = *(const bf16x8*)(pc + (16 * wid + lr) * 72 + 32 + 8 * lq); \
        f32x4 acc0 = qcur; \
        acc0 = __builtin_amdgcn_mfma_f32_16x16x32_bf16(a0, b0, acc0, 0, 0, 0); \
        acc0 = __builtin_amdgcn_mfma_f32_16x16x32_bf16(a1, b1, acc0, 0, 0, 0); \
        st = acc0; \
        { bf16_t* pn = psm + (((C) + 1) % 3) * 4608;     \
          *(u32x4*)(pn + PRB(tid + 0 * 256)) = X##0; *(u32x4*)(pn + PRB(tid + 1 * 256)) = X##1; qcur = X##q; } \
        SEQ_LOAD(X, (C) + 5); } while (0)
    u32x4 A0, A1, B0, B1, C0, C1, E0, E1; f32x4 Aq, Bq, Cq, Eq, qcur;
    __syncthreads();
    {
        SEQ_LOAD(A, 0);
        *(u32x4*)(psm + PRB(tid + 0 * 256)) = A0; *(u32x4*)(psm + PRB(tid + 1 * 256)) = A1; qcur = Aq;
        SEQ_LOAD(A, 1); SEQ_LOAD(B, 2); SEQ_LOAD(C, 3); SEQ_LOAD(E, 4);
    }
    for (int c = 0; c < NCH; c += 4) { SEQ_STEP(c, A); SEQ_STEP(c + 1, B); SEQ_STEP(c + 2, C); SEQ_STEP(c + 3, E); }
#undef SEQ_LOAD
#undef SEQ_STEP
#undef PRB
}

DEVI void ph_rwkv_post(const P& p, int l, float* sm) {
    char* ws = ows(p);
    const bf16_t* proj = (const bf16_t*)(ws + WS_PROJ);
    const bf16_t* pt = (const bf16_t*)(ws + WS_PT);
    const bf16_t* yt = (const bf16_t*)(ws + WS_RWY);
    const float* s0buf = (const float*)(ws + WS_S0);
    const float* rs = (const float*)(ws + WS_RS);
    bf16_t* ycat = (bf16_t*)(ws + WS_YCAT);
    const float* mu = pin(p, I_MU) + l * RWSLAB;
    const float* g2 = pin(p, I_G2) + (size_t)l * 128 * RW;
    const float* gng = pin(p, I_GNG) + l * RW; const float* gnb = pin(p, I_GNB) + l * RW;
    const int tid = otid(), lane = tid & 63, wid = tid >> 6, lr = lane & 15, lq = lane >> 4, tau = tid >> 2, vq = tid & 3;
    float* xs = sm;
    float* ms = sm + 4352;
    float* xs1 = sm + 8448;
    float* ms1 = sm + 12800;
    float* gt = xs1;
    const int sj8 = (tid & 7) * 8, stt = tid >> 3, swj = tid >> 4, swc = (tid & 15) * 4;
    u32x4 zc[2][2], zp[2][2]; f32x4 wv[4][2];
#define POST_PF(IT) do { const int _tile = (IT) % (S / 64), _bh = (IT) / (S / 64), _b = _bh / 6, _h = _bh % 6; \
        _Pragma("unroll") for (int e = 0; e < 2; ++e) { const int _s2 = _tile * 64 + stt + 32 * e; \
            const bf16_t* _pc = proj + ((size_t)_b * S + _s2) * INW + C_RWKV + 1280 + sj8; \
            _Pragma("unroll") for (int hf = 0; hf < 2; ++hf) { zc[e][hf] = *(const u32x4*)(_pc + 64 * hf); \
                zp[e][hf] = (u32x4){0u, 0u, 0u, 0u}; if (_s2 > 0) zp[e][hf] = *(const u32x4*)(_pc + 64 * hf - INW); } } \
        _Pragma("unroll") for (int k = 0; k < 4; ++k) _Pragma("unroll") for (int hf = 0; hf < 2; ++hf) \
            wv[k][hf] = *(const f32x4*)(g2 + (size_t)(64 * hf + swj + 16 * k) * RW + _h * 64 + swc); } while (0)
#define POST_MIX(DST, C, PV, M0, M1) do { float* _d = (DST); float _c, _p; \
        _c = bflo((C).x); _p = bflo((PV).x); _d[0] = sigmoidf_(_c + (_p - _c) * (M0)[0]); _c = bfhi((C).x); _p = bfhi((PV).x); _d[1] = sigmoidf_(_c + (_p - _c) * (M0)[1]); \
        _c = bflo((C).y); _p = bflo((PV).y); _d[2] = sigmoidf_(_c + (_p - _c) * (M0)[2]); _c = bfhi((C).y); _p = bfhi((PV).y); _d[3] = sigmoidf_(_c + (_p - _c) * (M0)[3]); \
        _c = bflo((C).z); _p = bflo((PV).z); _d[4] = sigmoidf_(_c + (_p - _c) * (M1)[0]); _c = bfhi((C).z); _p = bfhi((PV).z); _d[5] = sigmoidf_(_c + (_p - _c) * (M1)[1]); \
        _c = bflo((C).w); _p = bflo((PV).w); _d[6] = sigmoidf_(_c + (_p - _c) * (M1)[2]); _c = bfhi((C).w); _p = bfhi((PV).w); _d[7] = sigmoidf_(_c + (_p - _c) * (M1)[3]); } while (0)
    if (obid() < 12 * (S / 64)) POST_PF(obid());
    for (int item = obid(); item < 12 * (S / 64); item += gridDim.x) {
        const int tile = item % (S / 64), bh = item / (S / 64), b = bh / 6, h = bh % 6;
        const int s = tile * 64 + tau;
        const size_t t = (size_t)b * S + s;
        const int c = (tile * 64) / RC;
        const int hv = h * 64 + vq * 16;
        __syncthreads();
        {
            const f32x4 mg0a = *(const f32x4*)(mu + 1280 + sj8), mg0b = *(const f32x4*)(mu + 1280 + sj8 + 4);
            const f32x4 mg1a = *(const f32x4*)(mu + 1344 + sj8), mg1b = *(const f32x4*)(mu + 1344 + sj8 + 4);
#pragma unroll
            for (int e = 0; e < 2; ++e) {
                POST_MIX(xs + (stt + 32 * e) * 68 + sj8, zc[e][0], zp[e][0], mg0a, mg0b);
                POST_MIX(xs1 + (stt + 32 * e) * 68 + sj8, zc[e][1], zp[e][1], mg1a, mg1b);
            }
        }
#pragma unroll
        for (int k = 0; k < 4; ++k) { *(f32x4*)(ms + (swj + 16 * k) * 64 + swc) = wv[k][0]; *(f32x4*)(ms1 + (swj + 16 * k) * 64 + swc) = wv[k][1]; }
        if (item + (int)gridDim.x < 12 * (S / 64)) POST_PF(item + gridDim.x);
#define POST_LD(K, PV, SV) const u32x2 PV = *(const u32x2*)(pt + ((size_t)b * S + tile * 64 + ((tid + (K) * NT) >> 4)) * RW + h * 64 + ((tid + (K) * NT) & 15) * 4); \
        const f32x4 SV = *(const f32x4*)(s0buf + (size_t)(bh * NCH + c) * 4096 + (tid + (K) * NT) * 4)
        POST_LD(0, ptr0, s0r0); POST_LD(1, ptr1, s0r1); POST_LD(2, ptr2, s0r2); POST_LD(3, ptr3, s0r3);
#undef POST_LD
        const u32x2 ytr0 = *(const u32x2*)(yt + t * RW + hv), ytr1 = *(const u32x2*)(yt + t * RW + hv + 4), ytr2 = *(const u32x2*)(yt + t * RW + hv + 8), ytr3 = *(const u32x2*)(yt + t * RW + hv + 12);
        const float rsv = rs[t * 6 + h];
        float vv[16];
        const bf16_t* pc = proj + t * INW + C_RWKV;
        zmix8(pc, s, 768 + hv, mu, vv); zmix8(pc, s, 768 + hv + 8, mu, vv + 8);
        __syncthreads();
        f32x4 ga[4];
#pragma unroll
        for (int n = 0; n < 4; ++n) ga[n] = (f32x4){0.f, 0.f, 0.f, 0.f};
        mma64(ga, xs, 68, ms, wid, lr, lq);
        mma64(ga, xs1, 68, ms1, wid, lr, lq);
        __syncthreads();
        mma64_store(gt, ga, wid, lr, lq);
#define POST_ST(K, PV, SV) do { const int _i = tid + (K) * NT, _tt = _i >> 4, _i4 = (_i & 15) * 4; \
            xs[_tt * 68 + _i4] = bflo(PV.x); xs[_tt * 68 + _i4 + 1] = bfhi(PV.x); xs[_tt * 68 + _i4 + 2] = bflo(PV.y); xs[_tt * 68 + _i4 + 3] = bfhi(PV.y); \
            *(f32x4*)(ms + _i * 4) = SV; } while (0)
        POST_ST(0, ptr0, s0r0); POST_ST(1, ptr1, s0r1); POST_ST(2, ptr2, s0r2); POST_ST(3, ptr3, s0r3);
#undef POST_ST
        __syncthreads();
        f32x4 ya[4];
#pragma unroll
        for (int n = 0; n < 4; ++n) ya[n] = (f32x4){0.f, 0.f, 0.f, 0.f};
        mma64(ya, xs, 68, ms, wid, lr, lq);
        __syncthreads();
        mma64_store(xs, ya, wid, lr, lq);
        __syncthreads();
        float y[16], g[16];
#define POST_RD(C4, YV) do { \
            const float4 yy = *(const float4*)(xs + tau * 68 + vq * 16 + (C4) * 4); \
            const float4 gg = *(const float4*)(gt + tau * 68 + vq * 16 + (C4) * 4); \
            y[(C4) * 4] = bflo(YV.x) + yy.x; y[(C4) * 4 + 1] = bfhi(YV.x) + yy.y; y[(C4) * 4 + 2] = bflo(YV.y) + yy.z; y[(C4) * 4 + 3] = bfhi(YV.y) + yy.w; \
            g[(C4) * 4] = gg.x; g[(C4) * 4 + 1] = gg.y; g[(C4) * 4 + 2] = gg.z; g[(C4) * 4 + 3] = gg.w; } while (0)
        POST_RD(0, ytr0); POST_RD(1, ytr1); POST_RD(2, ytr2); POST_RD(3, ytr3);
#undef POST_RD
        float sum = 0.f;
#pragma unroll
        for (int cc = 0; cc < 16; ++cc) sum += y[cc];
        const float mean = quad_sum(sum) * (1.f / 64.f);
        float var = 0.f;
#pragma unroll
        for (int cc = 0; cc < 16; ++cc) { y[cc] -= mean; var += y[cc] * y[cc]; }
        const float rstd = 1.f / sqrtf(quad_sum(var) * (1.f / 64.f) + 64e-5f);
        float o[16];
#pragma unroll
        for (int cc = 0; cc < 16; ++cc) o[cc] = (y[cc] * rstd * gng[hv + cc] + gnb[hv + cc] + rsv * vv[cc]) * g[cc];
        u32x4 w0, w1;
        w0.x = pk2(o[0], o[1]); w0.y = pk2(o[2], o[3]); w0.z = pk2(o[4], o[5]); w0.w = pk2(o[6], o[7]);
        w1.x = pk2(o[8], o[9]); w1.y = pk2(o[10], o[11]); w1.z = pk2(o[12], o[13]); w1.w = pk2(o[14], o[15]);
        bf16_t* op = ycat + t * D + 384 + hv;
        *(u32x4*)op = w0; *(u32x4*)(op + 8) = w1;
    }
#undef POST_PF
#undef POST_MIX
}

DEVI void ph_lru_prep(const P& p, int l, float* sm) {
    char* ws = ows(p);
    const bf16_t* proj = (const bf16_t*)(ws + WS_PROJ);
    float* la = (float*)(ws + WS_LA); float* lb = (float*)(ws + WS_LB);
    float* ca = (float*)(ws + WS_LC); float* cb2 = ca + NBATCH * 128 * LW;
    const float* cw = pin(p, I_CW) + l * 4 * LW; const float* cb = pin(p, I_CB) + l * LW;
    const float* wa = pin(p, I_WA) + (size_t)l * 4 * 4096; const float* ba = pin(p, I_BA) + l * LW;
    const float* wx = pin(p, I_WX) + (size_t)l * 4 * 4096; const float* bx = pin(p, I_BX) + l * LW;
    const float* lam = pin(p, I_LAM) + l * LW;
    const int tid = otid(), tau = tid >> 2, jq = tid & 3;
    float* xs = sm;
    float* was = sm + 4352;
    float* wxs = sm + 8448;
    float* prm = sm + 12544;
    int hbp = -1;
    u32x4 rawp[4][2]; f32x4 wpa[4], wpx[4];
#define LRU_PF(IT) do { const int _hb = (IT) & 3, _t = ((IT) >> 2) * 64 + tau, _s = _t & (S - 1); \
        _Pragma("unroll") for (int q = 0; q < 4; ++q) { rawp[q][0] = (u32x4){0u, 0u, 0u, 0u}; rawp[q][1] = rawp[q][0]; \
            if (_s - 3 + q >= 0) { const bf16_t* _src = proj + (size_t)(_t - 3 + q) * INW + C_LRU + _hb * 64 + jq * 16; \
                rawp[q][0] = *(const u32x4*)_src; rawp[q][1] = *(const u32x4*)(_src + 8); } } \
        _Pragma("unroll") for (int k = 0; k < 4; ++k) { wpa[k] = *(const f32x4*)(wa + (size_t)_hb * 4096 + (tid + k * NT) * 4); \
            wpx[k] = *(const f32x4*)(wx + (size_t)_hb * 4096 + (tid + k * NT) * 4); } } while (0)
    if (obid() < (T / 64) * 4) LRU_PF(obid());
    for (int item = obid(); item < (T / 64) * 4; item += gridDim.x) {
        const int hb = item & 3, tile = item >> 2;
        if (hb != hbp) {
            __syncthreads();
            for (int i = tid; i < 512; i += NT) {
                const int q = i >> 6, ch = hb * 64 + (i & 63);
                prm[i] = q == 0 ? cb[ch] : (q < 5 ? cw[(q - 1) * LW + ch] : (q == 5 ? ba[ch] : (q == 6 ? bx[ch] : softplusf_(-lam[ch]))));
            }
            hbp = hb;
        }
        const int t = tile * 64 + tau, s = t & (S - 1);
        const int ch0 = hb * 64 + jq * 16;
        __syncthreads();
        float xc[16];
        {
            float raw[4][16];
#pragma unroll
            for (int q = 0; q < 4; ++q)
#pragma unroll
                for (int hf = 0; hf < 2; ++hf) {
                    const u32x4 u = rawp[q][hf];
                    raw[q][hf * 8 + 0] = bflo(u.x); raw[q][hf * 8 + 1] = bfhi(u.x); raw[q][hf * 8 + 2] = bflo(u.y); raw[q][hf * 8 + 3] = bfhi(u.y);
                    raw[q][hf * 8 + 4] = bflo(u.z); raw[q][hf * 8 + 5] = bfhi(u.z); raw[q][hf * 8 + 6] = bflo(u.w); raw[q][hf * 8 + 7] = bfhi(u.w);
                }
#pragma unroll
            for (int j = 0; j < 16; ++j) {
                const int cl = jq * 16 + j;
                xc[j] = prm[cl] + prm[64 + cl] * raw[0][j] + prm[128 + cl] * raw[1][j] + prm[192 + cl] * raw[2][j] + prm[256 + cl] * raw[3][j];
                xs[tau * 68 + jq * 16 + j] = xc[j];
            }
        }
#pragma unroll
        for (int k = 0; k < 4; ++k) { *(f32x4*)(was + (tid + k * NT) * 4) = wpa[k]; *(f32x4*)(wxs + (tid + k * NT) * 4) = wpx[k]; }
        if (item + (int)gridDim.x < (T / 64) * 4) LRU_PF(item + gridDim.x);
        __syncthreads();
        float ra[16], ia[16];
        {
            const int lane = tid & 63, wid = tid >> 6, lr = lane & 15, lq = lane >> 4;
            f32x4 accA[4], accX[4];
#pragma unroll
            for (int n = 0; n < 4; ++n) { accA[n] = (f32x4){0.f, 0.f, 0.f, 0.f}; accX[n] = accA[n]; }
            mma64(accA, xs, 68, was, wid, lr, lq);
            mma64(accX, xs, 68, wxs, wid, lr, lq);
            __syncthreads();
            mma64_store(sm, accA, wid, lr, lq);
            mma64_store(sm + 4352, accX, wid, lr, lq);
            __syncthreads();
#pragma unroll
            for (int c4 = 0; c4 < 4; ++c4) {
                const float4 a4 = *(const float4*)(sm + tau * 68 + jq * 16 + c4 * 4);
                const float4 x4 = *(const float4*)(sm + 4352 + tau * 68 + jq * 16 + c4 * 4);
                const float4 pa = *(const float4*)(prm + 320 + jq * 16 + c4 * 4), px = *(const float4*)(prm + 384 + jq * 16 + c4 * 4);
                ra[c4 * 4] = a4.x + pa.x; ra[c4 * 4 + 1] = a4.y + pa.y; ra[c4 * 4 + 2] = a4.z + pa.z; ra[c4 * 4 + 3] = a4.w + pa.w;
                ia[c4 * 4] = x4.x + px.x; ia[c4 * 4 + 1] = x4.y + px.y; ia[c4 * 4 + 2] = x4.z + px.z; ia[c4 * 4 + 3] = x4.w + px.w;
            }
        }
        __syncthreads();
#pragma unroll
        for (int j = 0; j < 16; ++j) {
            const float r = sigmoidf_(ra[j]), ig = sigmoidf_(ia[j]);
            const float lga = -8.f * r * prm[448 + jq * 16 + j];
            ra[j] = fexp(lga);
            ia[j] = sqrtf(-expm1f(2.f * lga)) * (ig * xc[j]);
            was[tau * 64 + jq * 16 + j] = ra[j];
            wxs[tau * 64 + jq * 16 + j] = ia[j];
        }
#pragma unroll
        for (int c4 = 0; c4 < 4; ++c4) {
            *(float4*)(la + (size_t)t * LW + ch0 + c4 * 4) = make_float4(ra[c4 * 4], ra[c4 * 4 + 1], ra[c4 * 4 + 2], ra[c4 * 4 + 3]);
            *(float4*)(lb + (size_t)t * LW + ch0 + c4 * 4) = make_float4(ia[c4 * 4], ia[c4 * 4 + 1], ia[c4 * 4 + 2], ia[c4 * 4 + 3]);
        }
        __syncthreads();
        if (tid < 64) {
            float A = 1.f, Bv = 0.f;
            for (int t0 = 0; t0 < 64; t0 += 16) {
                float a[16], bq[16];
#pragma unroll
                for (int j = 0; j < 16; ++j) { a[j] = was[(t0 + j) * 64 + tid]; bq[j] = wxs[(t0 + j) * 64 + tid]; }
#pragma unroll
                for (int j = 0; j < 16; ++j) { A *= a[j]; Bv = a[j] * Bv + bq[j]; }
            }
            ca[(size_t)tile * LW + hb * 64 + tid] = A; cb2[(size_t)tile * LW + hb * 64 + tid] = Bv;
        }
    }
#undef LRU_PF
}
DEVI void ph_lru_carry(const P& p, int b0) {
    char* ws = ows(p);
    const float* ca = (const float*)(ws + WS_LC); const float* cb = ca + NBATCH * 128 * LW;
    float* hin = (float*)(ws + WS_LC) + 2 * NBATCH * 128 * LW;
    const int ob = obid() - b0;
    if (ob < 0) return;
    for (int idx = ob * NT + otid(); idx < NBATCH * LW; idx += (gridDim.x - b0) * NT) {
        const int c = idx & 255, b = idx >> 8;
        float h = 0.f;
        for (int n0 = 0; n0 < 128; n0 += 16) {
            float a[16], bb[16];
#pragma unroll
            for (int j = 0; j < 16; ++j) { const int o = (b * 128 + n0 + j) * LW + c; a[j] = ca[o]; bb[j] = cb[o]; }
#pragma unroll
            for (int j = 0; j < 16; ++j) { const float hv = h; h = a[j] * h + bb[j]; a[j] = hv; }
#pragma unroll
            for (int j = 0; j < 16; ++j) hin[(b * 128 + n0 + j) * LW + c] = a[j];
        }
    }
}
DEVI void ph_lru_out(const P& p, int b0) {
    char* ws = ows(p);
    const bf16_t* proj = (const bf16_t*)(ws + WS_PROJ);
    const float* la = (const float*)(ws + WS_LA); const float* lb = (const float*)(ws + WS_LB);
    const float* hin = (const float*)(ws + WS_LC) + 2 * NBATCH * 128 * LW;
    bf16_t* ycat = (bf16_t*)(ws + WS_YCAT);
    const int c = otid();
    if (obid() < b0) return;
    for (int tile = obid() - b0; tile < T / 64; tile += gridDim.x - b0) {
        float h = hin[(size_t)tile * LW + c];
        float a0[16], b0r[16], g0[16], a1[16], b1r[16], g1[16];
#define LRU_LD(A, B, G, I0) _Pragma("unroll") for (int j = 0; j < 16; ++j) { const size_t tok = (size_t)tile * 64 + (I0) + j; \
            A[j] = la[tok * LW + c]; B[j] = lb[tok * LW + c]; G[j] = bf2f(proj[tok * INW + C_LRU + 256 + c]); }
#define LRU_CH(A, B, G, I0) _Pragma("unroll") for (int j = 0; j < 16; ++j) { h = A[j] * h + B[j]; \
            ycat[((size_t)tile * 64 + (I0) + j) * D + 768 + c] = (bf16_t)f2bf(h * gelu_tanh(G[j])); }
        LRU_LD(a0, b0r, g0, 0);
        LRU_LD(a1, b1r, g1, 16); LRU_CH(a0, b0r, g0, 0);
        LRU_LD(a0, b0r, g0, 32); LRU_CH(a1, b1r, g1, 16);
        LRU_LD(a1, b1r, g1, 48); LRU_CH(a0, b0r, g0, 32);
        LRU_CH(a1, b1r, g1, 48);
#undef LRU_LD
#undef LRU_CH
    }
}

DEVI void ph_ln1_router(const P& p, int l, float* sm) {
    char* ws = ows(p);
    const bf16_t* mix = (const bf16_t*)(ws + WS_MIX);
    bf16_t* x1b = (bf16_t*)(ws + WS_X1B);
    int* cnt = (int*)(ws + WS_CNT) + l * NE * CS;
    int* list = (int*)(ws + WS_LIST);
    int* tinfo = (int*)(ws + WS_TINFO);
    float* tw = (float*)(ws + WS_TW);
    const float* wg = pin(p, I_MWG) + (size_t)l * D * 4; const float* bg = pin(p, I_MBG) + l * 4;
    const float* we = pin(p, I_MWE) + (size_t)l * D * NE; const float* be = pin(p, I_MBE) + l * NE;
    const float* ln1g = pin(p, I_LN1G) + l * D; const float* ln1b = pin(p, I_LN1B) + l * D;
    const int tid = otid(), lane = tid & 63, wid = tid >> 6;
    float* xs = sm;
    float* part = sm + 16384;
    float* lgs = part + 2560;
    const int lr = lane & 15, lq = lane >> 4;
    const f32x4* bq = (const f32x4*)(ws + WS_WRT) + (size_t)(l * 4 + wid) * 3 * 16 * 64 + lane;
    u32x2 ha[4][4], hm[4][4];
#define LN1_LOAD(RB) do { \
        const bf16_t* _hb = (const bf16_t*)(ws + WS_HB) + (size_t)((RB) * 16 + wid * 4) * D; const bf16_t* _mx = mix + (size_t)((RB) * 16 + wid * 4) * D; \
        _Pragma("unroll") for (int rr = 0; rr < 4; ++rr) _Pragma("unroll") for (int j = 0; j < 4; ++j) { \
            ha[rr][j] = *(const u32x2*)(_hb + (size_t)rr * D + (j * 64 + lane) * 4); hm[rr][j] = *(const u32x2*)(_mx + (size_t)rr * D + (j * 64 + lane) * 4); } } while (0)
    if (obid() < T / 16) LN1_LOAD(obid());
    for (int rb = obid(); rb < T / 16; rb += gridDim.x) {
        __syncthreads();
        {
            const int r0 = wid * 4;
            float4 gg[4], b4[4];
#pragma unroll
            for (int j = 0; j < 4; ++j) { gg[j] = *(const float4*)(ln1g + (j * 64 + lane) * 4); b4[j] = *(const float4*)(ln1b + (j * 64 + lane) * 4); }
            float4 v[4][4];
            float sA[4], qA[4];
#pragma unroll
            for (int rr = 0; rr < 4; ++rr) {
                float sx = 0.f;
#pragma unroll
                for (int j = 0; j < 4; ++j) {
                    float4 x;
                    x.x = bflo(ha[rr][j].x) * ALPHA + bflo(hm[rr][j].x); x.y = bfhi(ha[rr][j].x) * ALPHA + bfhi(hm[rr][j].x);
                    x.z = bflo(ha[rr][j].y) * ALPHA + bflo(hm[rr][j].y); x.w = bfhi(ha[rr][j].y) * ALPHA + bfhi(hm[rr][j].y);
                    v[rr][j] = x; sx += (x.x + x.y) + (x.z + x.w);
                }
                sA[rr] = sx;
            }
            if (rb + (int)gridDim.x < T / 16) LN1_LOAD(rb + gridDim.x);
#pragma unroll
            for (int rr = 0; rr < 4; ++rr) sA[rr] = wave_sum(sA[rr]) * (1.f / D);
#pragma unroll
            for (int rr = 0; rr < 4; ++rr) {
                float q = 0.f;
#pragma unroll
                for (int j = 0; j < 4; ++j) {
                    v[rr][j].x -= sA[rr]; v[rr][j].y -= sA[rr]; v[rr][j].z -= sA[rr]; v[rr][j].w -= sA[rr];
                    q += (v[rr][j].x * v[rr][j].x + v[rr][j].y * v[rr][j].y) + (v[rr][j].z * v[rr][j].z + v[rr][j].w * v[rr][j].w);
                }
                qA[rr] = q;
            }
#pragma unroll
            for (int rr = 0; rr < 4; ++rr) qA[rr] = 1.f / sqrtf(wave_sum(qA[rr]) * (1.f / D) + LN_EPS);
#pragma unroll
            for (int rr = 0; rr < 4; ++rr) {
                const int r = r0 + rr;
#pragma unroll
                for (int j = 0; j < 4; ++j) {
                    float4 x = v[rr][j];
                    x.x = x.x * qA[rr] * gg[j].x + b4[j].x; x.y = x.y * qA[rr] * gg[j].y + b4[j].y;
                    x.z = x.z * qA[rr] * gg[j].z + b4[j].z; x.w = x.w * qA[rr] * gg[j].w + b4[j].w;
                    u32x2 w; w.x = pk2(x.x, x.y); w.y = pk2(x.z, x.w);
                    *(u32x2*)(x1b + (size_t)(rb * 16 + r) * D + (j * 64 + lane) * 4) = w;
                    *(float4*)(xs + r * 1024 + (((j * 64 + lane) ^ r) << 2)) = x;
                }
            }
        }
        __syncthreads();
        {
            f32x4 c0 = (f32x4){0.f, 0.f, 0.f, 0.f}, c1 = c0, c2 = c0;
            const float* ax = xs + lr * 1024 + wid * 256 + lq;
            const int sw = lr << 2;
#pragma unroll 4
            for (int g = 0; g < 16; ++g) {
                const f32x4 b0 = bq[g * 64], b1 = bq[(16 + g) * 64], b2 = bq[(32 + g) * 64];
#pragma unroll
                for (int e = 0; e < 4; ++e) {
                    const float a = ax[(4 * (4 * g + e)) ^ sw];
                    c0 = __builtin_amdgcn_mfma_f32_16x16x4f32(a, b0[e], c0, 0, 0, 0);
                    c1 = __builtin_amdgcn_mfma_f32_16x16x4f32(a, b1[e], c1, 0, 0, 0);
                    c2 = __builtin_amdgcn_mfma_f32_16x16x4f32(a, b2[e], c2, 0, 0, 0);
                }
            }
#pragma unroll
            for (int r = 0; r < 4; ++r) {
                float* pr = part + (wid * 16 + 4 * lq + r) * 40;
                pr[lr] = c0[r]; pr[16 + lr] = c1[r]; if (lr < 4) pr[32 + lr] = c2[r];
            }
        }
        __syncthreads();
        for (int i = tid; i < 576; i += NT) {
            const int r = i / 36, o = i % 36;
            const float bias = o < 4 ? bg[o] : be[o - 4];
            lgs[r * 40 + o] = ((part[(0 * 16 + r) * 40 + o] + part[(1 * 16 + r) * 40 + o]) + (part[(2 * 16 + r) * 40 + o] + part[(3 * 16 + r) * 40 + o])) + bias;
        }
        __syncthreads();
        if (tid < 16) {
            const float* L = lgs + tid * 40;
            const int row = rb * 16 + tid;
            int gs = 0; float gm = L[0];
            for (int g = 1; g < 4; ++g) if (L[g] > gm) { gm = L[g]; gs = g; }
            float den = 0.f;
            for (int g = 0; g < 4; ++g) den += expf(L[g] - gm);
            const float ggate = 1.f / den;
            const float* el = L + 4 + gs * 8;
            int i1 = 0; float m1 = el[0];
            for (int j = 1; j < 8; ++j) if (el[j] > m1) { m1 = el[j]; i1 = j; }
            int i2 = -1; float m2 = -3.0e38f;
            for (int j = 0; j < 8; ++j) if (j != i1 && el[j] > m2) { m2 = el[j]; i2 = j; }
            const float p2 = expf(m2 - m1);
            const float wt1 = ggate / (1.f + p2), wt2 = ggate * p2 / (1.f + p2);
            const int e1 = gs * 8 + i1, e2 = gs * 8 + i2;
            const int pos1 = atomicAdd(&cnt[e1 * CS], 1);
            const int pos2 = atomicAdd(&cnt[e2 * CS], 1);
            list[(size_t)e1 * T + pos1] = row;
            list[(size_t)e2 * T + pos2] = row;
            tinfo[row * 4 + 0] = e1; tinfo[row * 4 + 1] = pos1; tinfo[row * 4 + 2] = e2; tinfo[row * 4 + 3] = pos2;
            tw[row * 2 + 0] = wt1; tw[row * 2 + 1] = wt2;
        }
    }
#undef LN1_LOAD
}

template <int MT>
DEVI void moe_tile(float* sm, int which, int e, int mi, int ni, int off, int mvalid, const int* list, const bf16_t* x1b, bf16_t* hid, bf16_t* out2,
                   const bf16_t* wgu, const bf16_t* wd, int wr, int wc, int fr, int fq) {
    f32x4 acc[MT][4];
    if (which == 0) {
        gemm_core_mt<MT>((LAS char*)sm, x1b, D, list + (size_t)e * T + mi * 128, mvalid,
                         wgu + ((size_t)e * 1024 + ni * 128) * D, D, D, acc);
#pragma unroll
        for (int m = 0; m < MT; ++m) {
            const int r = wr * 16 * MT + m * 16 + fr;
            if (r < mvalid) {
                bf16_t* o = hid + (size_t)(off + mi * 128 + r) * DE + ni * 64 + wc * 32 + fq * 4;
#pragma unroll
                for (int n = 0; n < 2; ++n) {
                    u32x2 w;
                    w.x = pk2(siluf_(acc[m][n][0]) * acc[m][n + 2][0], siluf_(acc[m][n][1]) * acc[m][n + 2][1]);
                    w.y = pk2(siluf_(acc[m][n][2]) * acc[m][n + 2][2], siluf_(acc[m][n][3]) * acc[m][n + 2][3]);
                    *(u32x2*)(o + n * 16) = w;
                }
            }
        }
    } else {
        gemm_core_mt<MT>((LAS char*)sm, hid + (size_t)(off + mi * 128) * DE, DE, nullptr, mvalid,
                         wd + ((size_t)e * D + ni * 128) * DE, DE, DE, acc);
#pragma unroll
        for (int m = 0; m < MT; ++m) {
            const int r = wr * 16 * MT + m * 16 + fr;
            if (r < mvalid) {
                bf16_t* o = out2 + (size_t)(off + mi * 128 + r) * D + ni * 128 + wc * 64 + fq * 4;
#pragma unroll
                for (int n = 0; n < 4; ++n) { u32x2 w; w.x = pk2(acc[m][n][0], acc[m][n][1]); w.y = pk2(acc[m][n][2], acc[m][n][3]); *(u32x2*)(o + n * 16) = w; }
            }
        }
    }
}
DEVI void ph_moe(const P& p, int l, float* sm, int which) {
    char* ws = ows(p);
    const int* cnt = (const int*)(ws + WS_CNT) + l * NE * CS;
    const int* list = (const int*)(ws + WS_LIST);
    const bf16_t* x1b = (const bf16_t*)(ws + WS_X1B);
    bf16_t* hid = (bf16_t*)(ws + WS_HID);
    bf16_t* out2 = (bf16_t*)(ws + WS_OUT2);
    const bf16_t* wgu = (const bf16_t*)(ws + WS_WGUT);
    const bf16_t* wd = (const bf16_t*)(ws + WS_WDT);
    const int tid = otid(), lane = tid & 63, wid = tid >> 6, wr = wid >> 1, wc = wid & 1, fr = lane & 15, fq = lane >> 4;
    int* tab = (int*)(sm + 16384);
    int* cn = tab; int* of = tab + 32; int* fb = tab + 64; int* ord = tab + 104; int* nrp = tab + 136;
    __syncthreads();
    if (tid < NE) cn[tid] = cnt[tid * CS];
    __syncthreads();
    if (tid < NE) {
        int o = 0, f = 0, rk = 0, nr = 0;
        const int mine = cn[tid] & 127;
        for (int j = 0; j < NE; ++j) {
            const int cj = cn[j], rj = cj & 127;
            if (j < tid) { o += cj; f += (cj >> 7) * 8; }
            if (rj > 0) { ++nr; if (rj > mine || (rj == mine && j < tid)) ++rk; }
        }
        of[tid] = o; fb[tid] = f;
        if (tid == NE - 1) { fb[NE] = f + (cn[tid] >> 7) * 8; nrp[0] = nr; }
        if (mine > 0) ord[rk] = tid;
    }
    __syncthreads();
    const int TTA = fb[NE], TT = TTA + 8 * nrp[0];
    for (int q = vblock(); q < TT; q += gridDim.x) {
        if (q < TTA) {
            int e = 0;
            while (q >= fb[e + 1]) ++e;
            const int lt = q - fb[e];
            moe_tile<4>(sm, which, e, lt >> 3, lt & 7, of[e], 128, list, x1b, hid, out2, wgu, wd, wr, wc, fr, fq);
        } else {
            const int k = (q - TTA) >> 3, ni = (q - TTA) & 7, e = ord[k], mi = cn[e] >> 7, mvalid = cn[e] & 127, off = of[e];
            if (mvalid <= 32) moe_tile<1>(sm, which, e, mi, ni, off, mvalid, list, x1b, hid, out2, wgu, wd, wr, wc, fr, fq);
            else if (mvalid <= 64) moe_tile<2>(sm, which, e, mi, ni, off, mvalid, list, x1b, hid, out2, wgu, wd, wr, wc, fr, fq);
            else moe_tile<4>(sm, which, e, mi, ni, off, mvalid, list, x1b, hid, out2, wgu, wd, wr, wc, fr, fq);
        }
    }
}

DEVI void ph_ln2(const P& p, int l, float* sm) {
    char* ws = ows(p);
    const int* cnt = (const int*)(ws + WS_CNT) + l * NE * CS;
    const int* tinfo = (const int*)(ws + WS_TINFO);
    const float* tw = (const float*)(ws + WS_TW);
    const bf16_t* x1 = (const bf16_t*)(ws + WS_X1B);
    const bf16_t* out2 = (const bf16_t*)(ws + WS_OUT2);
    bf16_t* hb = (bf16_t*)(ws + WS_HB);
    const float* ln2g = pin(p, I_LN2G) + l * D; const float* ln2b = pin(p, I_LN2B) + l * D;
    float* outp = const_cast<float*>(pin(p, 34));
    int* offs = (int*)sm;
    const int tid = otid(), lane = tid & 63;
    __syncthreads();
    if (tid < NE) offs[64 + tid] = cnt[tid * CS];
    __syncthreads();
    if (tid == 0) { int o = 0; for (int e = 0; e < NE; ++e) { offs[e] = o; o += offs[64 + e]; } }
    __syncthreads();
    const int gw = (obid() * NT + tid) >> 6, nw = gridDim.x * (NT / 64);
    for (int row = gw; row < T; row += nw) {
        const int e1 = tinfo[row * 4], p1 = tinfo[row * 4 + 1], e2 = tinfo[row * 4 + 2], p2 = tinfo[row * 4 + 3];
        const bf16_t* o0 = out2 + (size_t)(offs[e1] + p1) * D;
        const bf16_t* o1 = out2 + (size_t)(offs[e2] + p2) * D;
        float4 v[4];
        ln_row<true>(x1 + (size_t)row * D, ALPHA, nullptr, o0, tw[row * 2], o1, tw[row * 2 + 1],
               ln2g, ln2b, v, lane);
        if (l == 0) store_row_bf(hb + (size_t)row * D, v, lane);
        else store_row(outp + (size_t)row * D, v, lane);
    }
}

#define XB_TMO      128
#define XB_XCNT(j)  (256  + 64 * (j))
#define XB_XSUB(j)  (1280 + 64 * (j))
#define XB_XGEN(j)  (2304 + 64 * (j))
#define XB_TOP      3328
#define XB_TOPGEN   3392
#define XCD_BAR_WORDS 3456
#define XB_SPIN_CAP (1u << 18)
DEVI unsigned xb_ld(unsigned* p)              { return __hip_atomic_load(p, __ATOMIC_RELAXED, __HIP_MEMORY_SCOPE_AGENT); }
DEVI unsigned xb_add(unsigned* p, unsigned v) { return __hip_atomic_fetch_add(p, v, __ATOMIC_RELAXED, __HIP_MEMORY_SCOPE_AGENT); }
DEVI unsigned xb_xcc_id() { return (unsigned)__builtin_amdgcn_s_getreg((3 << 11) | 20) & 0xFu; }
#define XB_SPIN(cond, bar) do { unsigned _sp = 0; while (cond) { __builtin_amdgcn_s_sleep(1); \
    if ((++_sp & 255u) == 0u) { if (xb_ld(&(bar)[XB_TMO])) break; if (_sp > XB_SPIN_CAP) { atomicAdd(&(bar)[XB_TMO], 1u); break; } } } } while (0)
struct XcdBarrier { unsigned* bar; unsigned x; volatile LAS unsigned* st; };
DEVI XcdBarrier xcd_barrier_post(unsigned* bar, volatile LAS unsigned* st) {
    XcdBarrier b; b.bar = bar; b.x = xb_xcc_id(); b.st = st;
    if (threadIdx.x == 0) (void)xb_add(&bar[XB_XCNT(b.x)], 1u);
    return b;
}
DEVI void xcd_barrier_complete(unsigned* bar, unsigned x, unsigned& nloc, unsigned& nx) {
    const unsigned G = gridDim.x * gridDim.y * gridDim.z;
    unsigned sum, cnt, mine, sp = 0u;
    for (;;) {
        sum = 0u; cnt = 0u; mine = 0u;
#pragma unroll
        for (unsigned j = 0; j < 16; ++j) { const unsigned c = xb_ld(&bar[XB_XCNT(j)]); sum += c; cnt += (c > 0u) ? 1u : 0u; mine = (j == x) ? c : mine; }
        if (sum == G) break;
        __builtin_amdgcn_s_sleep(1);
        if ((++sp & 255u) == 0u) { if (xb_ld(&bar[XB_TMO])) break; if (sp > XB_SPIN_CAP) { atomicAdd(&bar[XB_TMO], 1u); break; } }
    }
    nloc = mine > 0u ? mine : 1u; nx = cnt > 0u ? cnt : 1u;
}
template <bool FIRST> DEVI void xcd_barrier(const XcdBarrier& b) {
    asm volatile("s_waitcnt vmcnt(0)" ::: "memory");
    __syncthreads();
    if (threadIdx.x == 0) {
        unsigned* bar = b.bar;
        __builtin_amdgcn_s_waitcnt(0);
        unsigned nloc = b.st[0], nx = b.st[1];
        if (FIRST) { if (nloc == 0u) { xcd_barrier_complete(bar, b.x, nloc, nx); b.st[0] = nloc; b.st[1] = nx; } }
        const unsigned old = xb_add(&bar[XB_XSUB(b.x)], 1u);
        const unsigned gen = old / nloc;
        if (old + 1u == (gen + 1u) * nloc) {
            __builtin_amdgcn_fence(__ATOMIC_RELEASE, "agent");
            asm volatile("s_waitcnt vmcnt(0)" ::: "memory");
            const unsigned og = xb_add(&bar[XB_TOP], 1u);
            const unsigned tg = og / nx;
            if (og + 1u == (tg + 1u) * nx) xb_add(&bar[XB_TOPGEN], 1u);
            else XB_SPIN(xb_ld(&bar[XB_TOPGEN]) == tg, bar);
            __builtin_amdgcn_fence(__ATOMIC_ACQUIRE, "agent");
            xb_add(&bar[XB_XGEN(b.x)], 1u);
            asm volatile("s_waitcnt vmcnt(0)" ::: "memory");
        } else {
            XB_SPIN(xb_ld(&bar[XB_XGEN(b.x)]) == gen, bar);
            __builtin_amdgcn_fence(__ATOMIC_ACQUIRE, "agent");
            asm volatile("s_waitcnt vmcnt(0)" ::: "memory");
        }
    }
    __syncthreads();
}

#ifndef PROBE
#define PROBE 0
#endif
constexpr int LDS_BYTES = CTLF * 4 + 256;

__global__ void __launch_bounds__(NT, 2) k_mega(P p) {
    extern __shared__ __attribute__((aligned(16))) float sm[];
    volatile LAS unsigned* ctl = (volatile LAS unsigned*)((LAS char*)sm + CTLF * 4);
    if (threadIdx.x < 16) ctl[threadIdx.x] = 0u;
    __syncthreads();
    const XcdBarrier bar = xcd_barrier_post((unsigned*)(ows(p) + WS_BAR), ctl);
#define GSYNC() xcd_barrier<false>(bar)
    ph_ln_in(p);
    ph_wprep_dense(p, sm);
    xcd_barrier<true>(bar);
    if (PROBE & 128) { ph_ln_in(p); GSYNC(); }
    if (PROBE & 256) { ph_wprep_dense(p, sm); GSYNC(); }
    int l0 = 0;
    asm volatile("" : "+s"(l0));
    for (int l = l0; l < 2; ++l) {
        ph_inproj(p, l, sm); GSYNC();
        if (PROBE & 1) { ph_inproj(p, l, sm); GSYNC(); }
        ph_rwkv_prep(p, l, sm);
        ph_lru_prep(p, l, sm);
        ph_ret_kv(p, sm, 0); GSYNC();
        if (PROBE & 2) { ph_rwkv_prep(p, l, sm); GSYNC(); }
        if (PROBE & 2048) { ph_lru_prep(p, l, sm); GSYNC(); }
        if (PROBE & 4096) { ph_ret_kv(p, sm, 0); GSYNC(); }
        if (PROBE & 4) { ph_rwkv_chunk_wy(p, l, sm); GSYNC(); }
        if (PROBE & 8) { ph_wprep_moe(p, l, sm, 0); GSYNC(); }
        ph_rwkv_chunk_wy(p, l, sm);
        ph_wprep_moe(p, l, sm, gridDim.x >> 1);
        ph_ret_scan(p, gridDim.x >> 1);
        ph_lru_carry(p, (gridDim.x * 7) >> 3); GSYNC();
        ph_rwkv_seq(p, sm);
        ph_ret_out(p, sm, 48);
        ph_lru_out(p, 48); GSYNC();
        if (PROBE & 16) { ph_rwkv_seq(p, sm); ph_ret_out(p, sm, 48); ph_lru_out(p, 48); GSYNC(); }
        if (PROBE & 8192) { ph_rwkv_seq(p, sm); GSYNC(); }
        if (PROBE & 16384) { ph_ret_out(p, sm, 48); GSYNC(); }
        if (PROBE & 32768) { ph_lru_out(p, 48); GSYNC(); }
        ph_rwkv_post(p, l, sm); GSYNC();
        if (PROBE & 32) { ph_rwkv_post(p, l, sm); GSYNC(); }
        ph_outproj(p, l, sm); GSYNC();
        if (PROBE & 1) { ph_outproj(p, l, sm); GSYNC(); }
        ph_ln1_router(p, l, sm); GSYNC();
        ph_moe(p, l, sm, 0); GSYNC();
        if (PROBE & 1) { ph_moe(p, l, sm, 0); GSYNC(); }
        ph_moe(p, l, sm, 1); GSYNC();
        if (PROBE & 1) { ph_moe(p, l, sm, 1); GSYNC(); }
        ph_ln2(p, l, sm); GSYNC();
        if (PROBE & 64) { ph_ln2(p, l, sm); GSYNC(); }
        if (PROBE & 512) { for (int i = 0; i < 10; ++i) GSYNC(); }
        if (PROBE & 1024) { ph_ret_scan(p, gridDim.x >> 1); ph_lru_carry(p, (gridDim.x * 7) >> 3); GSYNC(); ph_ret_scan(p, gridDim.x >> 1); ph_lru_carry(p, (gridDim.x * 7) >> 3); GSYNC(); }
    }
#undef GSYNC
}

extern "C" void kernel_launch(void* const* d_in, const int* in_sizes, int n_in, void* d_out, int out_size,
                              void* d_ws, size_t ws_size, hipStream_t stream) {
    if (n_in != 34 || ws_size < WS_END) { fprintf(stderr, "kernel_launch: bad args n_in=%d ws=%zu need %zu\n", n_in, ws_size, (size_t)WS_END); return; }
    P p{};
    for (int i = 0; i < 34; ++i) p.in[i] = (const float*)d_in[i];
    p.in[34] = (const float*)d_out; p.in[35] = (const float*)d_ws;
    static int grid_blocks = 0;
    if (!grid_blocks) {
        int dev = 0, cus = 0, per_cu = 0;
        (void)hipGetDevice(&dev);
        (void)hipDeviceGetAttribute(&cus, hipDeviceAttributeMultiprocessorCount, dev);
        (void)hipFuncSetAttribute((const void*)k_mega, hipFuncAttributeMaxDynamicSharedMemorySize, LDS_BYTES);
        (void)hipOccupancyMaxActiveBlocksPerMultiprocessor(&per_cu, k_mega, NT, LDS_BYTES);
        if (per_cu < 1) per_cu = 1;
        if (per_cu > 2) per_cu = 2;
        grid_blocks = cus * per_cu;
        fprintf(stderr, "kernel_launch: cus=%d per_cu=%d grid=%d\n", cus, per_cu, grid_blocks);
    }
    (void)hipMemsetAsync((char*)d_ws + WS_CTL, 0, CTL_BYTES, stream);
    void* args[] = {&p};
    hipError_t e = hipLaunchCooperativeKernel((void*)k_mega, dim3(grid_blocks), dim3(NT), args, LDS_BYTES, stream);
    if (e != hipSuccess) fprintf(stderr, "cooperative launch failed: %s (grid %d)\n", hipGetErrorString(e), grid_blocks);
}
```
